# Optimizing an MI355X kernel written in HIP

```python
import jax, jax.numpy as jnp
from jax import lax
import numpy as np

D_MODEL = 1024
BATCH = 16
SEQ = 2048
DEPTH = 4

CHUNK = 64
Q_BLOCK = 128
DSA_HEADS = 8
DSA_HEAD_DIM = 64
DSA_WIDTH = DSA_HEADS * DSA_HEAD_DIM
Q_LORA = 256
KV_LORA = 128
IDX_HEADS = 4
IDX_DIM = 64
TOPK_MAX = 256
RWKV_HEADS = 8
RWKV_HEAD_DIM = 64
RWKV_WIDTH = RWKV_HEADS * RWKV_HEAD_DIM
DECAY_LORA = 64
AAA_LORA = 64
MV_LORA = 32
GATE_LORA = 160
MIX_WIDTH = DSA_WIDTH + RWKV_WIDTH
D_FF = ((8 * D_MODEL + 3 * 256 - 1) // (3 * 256)) * 256
NORM_EPS = 1e-6
LNX_EPS = 64e-5
DSA_COLS = [Q_LORA, KV_LORA, IDX_DIM, IDX_HEADS]
RWKV_COLS = [RWKV_WIDTH, RWKV_WIDTH, RWKV_WIDTH, DECAY_LORA, AAA_LORA, GATE_LORA]
N_DSA_COLS = sum(DSA_COLS)
N_RWKV_COLS = sum(RWKV_COLS)

kernel_name = 'hybrid_dsa_rwkv7_sandwich_adaln'


def rms_norm(x, g):
    xf = x.astype(jnp.float32)
    y = xf * lax.rsqrt(jnp.mean(xf * xf, axis=-1, keepdims=True) + NORM_EPS)
    return y.astype(x.dtype) * g


def layer_norm(x, g, b):
    xf = x.astype(jnp.float32)
    mu = jnp.mean(xf, axis=-1, keepdims=True)
    var = jnp.mean(jnp.square(xf - mu), axis=-1, keepdims=True)
    return ((xf - mu) * lax.rsqrt(var + NORM_EPS)).astype(x.dtype) * g + b


def split_cols(a, sizes):
    return jnp.split(a, np.cumsum(sizes)[:-1].tolist(), axis=-1)


def token_shift(u, mu):
    prev = jnp.pad(u, ((0, 0), (1, 0), (0, 0)))[:, :-1]
    return u + (prev - u) * mu


def dsa_mixer(c_q, c_kv, k_idx_raw, w_idx, q_norm_g, kv_norm_g, w_q_up, w_qi_up,
              w_k_up, w_v_up, kidx_ln_g, kidx_ln_b):
    B, S, _ = c_q.shape
    top_k = min(TOPK_MAX, S // 4)
    nblk = S // Q_BLOCK
    cq = rms_norm(c_q, q_norm_g)
    ckv = rms_norm(c_kv, kv_norm_g)
    q = jnp.einsum('bsl,lhd->bshd', cq, w_q_up)
    q_abs = jnp.einsum('bshd,rhd->bshr', q, w_k_up) * (DSA_HEAD_DIM ** -0.5)
    q_idx = jnp.einsum('bsl,lhd->bshd', cq, w_qi_up)
    k_idx = layer_norm(k_idx_raw, kidx_ln_g, kidx_ln_b)
    w_head = w_idx * ((IDX_HEADS ** -0.5) * (IDX_DIM ** -0.5))
    key_chunk = jnp.arange(S) // CHUNK

    def to_blocks(a):
        return a.reshape((B, nblk, Q_BLOCK) + a.shape[2:]).swapaxes(0, 1)

    def block_fn(args):
        qa, qi, wi, start = args
        q_chunk = (start + jnp.arange(Q_BLOCK)) // CHUNK
        admissible = key_chunk[None, :] <= q_chunk[:, None]
        logits = jnp.einsum('bthd,bsd->bths', qi, k_idx)
        score = jnp.einsum('bths,bth->bts', jax.nn.relu(logits), wi).astype(jnp.float32)
        score = jnp.where(admissible[None], score, -jnp.inf)
        top_val, top_idx = lax.top_k(score, top_k)
        valid = jnp.isfinite(top_val)
        kv_sel = jax.vmap(lambda lat, idx: lat[idx])(ckv, top_idx)
        att = jnp.einsum('bthr,btkr->bthk', qa, kv_sel).astype(jnp.float32)
        att = jnp.where(valid[:, :, None, :], att, -jnp.inf)
        p = jax.nn.softmax(att, axis=-1).astype(kv_sel.dtype)
        return jnp.einsum('bthk,btkr->bthr', p, kv_sel)

    starts = jnp.arange(nblk, dtype=jnp.int32) * Q_BLOCK
    o_lat = lax.map(block_fn, (to_blocks(q_abs), to_blocks(q_idx), to_blocks(w_head), starts))
    o_lat = o_lat.swapaxes(0, 1).reshape(B, S, DSA_HEADS, KV_LORA)
    o = jnp.einsum('bshr,rhd->bshd', o_lat, w_v_up)
    return o.reshape(B, S, DSA_WIDTH)


def rwkv7_mixer(r, k, v, w_lo, a_lo, g_lo, w0, w2, a0, a2, g2, k_k, k_a, r_k, lnx_g, lnx_b):
    B, S, _ = r.shape
    H, N = RWKV_HEADS, RWKV_HEAD_DIM
    f32 = jnp.float32

    def heads(t):
        return t.reshape(B, S, H, N)

    w_log = -jax.nn.softplus(-(w0 + jnp.tanh(w_lo) @ w2)) - 0.5
    decay = jnp.exp(-jnp.exp(w_log.astype(f32)))
    a = jax.nn.sigmoid(a0 + a_lo @ a2)
    g = jax.nn.sigmoid(g_lo) @ g2
    kk = heads(k * k_k).astype(f32)
    kk = kk / jnp.maximum(jnp.linalg.norm(kk, axis=-1, keepdims=True), 1e-12)
    k = k * (1 + (a - 1) * k_a)
    r_h, k_h, v_h, a_h = heads(r), heads(k), heads(v), heads(a)
    xs = [jnp.moveaxis(t.astype(f32), 1, 0) for t in (r_h, heads(decay), k_h, v_h, kk, a_h)]

    def step(state, inp):
        r_t, w_t, k_t, v_t, kk_t, a_t = inp
        sa = jnp.einsum('bhvk,bhk->bhv', state, kk_t)
        state = (state * w_t[:, :, None, :]
                 - sa[..., None] * (kk_t * a_t)[:, :, None, :]
                 + v_t[..., None] * k_t[:, :, None, :])
        return state, jnp.einsum('bhvk,bhk->bhv', state, r_t)

    state0 = jnp.zeros((B, H, N, N), f32)
    _, y = lax.scan(step, state0, (xs[0], xs[1], xs[2], xs[3], xs[4], xs[5]))
    y = jnp.moveaxis(y, 0, 1)
    mu = jnp.mean(y, axis=-1, keepdims=True)
    var = jnp.mean(jnp.square(y - mu), axis=-1, keepdims=True)
    y = ((y - mu) * lax.rsqrt(var + LNX_EPS)).reshape(B, S, RWKV_WIDTH).astype(r.dtype)
    y = y * lnx_g + lnx_b
    bonus = (jnp.sum(r_h * k_h * r_k, axis=-1, keepdims=True) * v_h).reshape(B, S, RWKV_WIDTH)
    return (y + bonus) * g


def setup_inputs(seed: int = 0) -> dict:
    key = jax.random.key(seed)
    keys = jax.random.split(key, 40)
    f32 = jnp.float32

    def nrm(i, shape, scale):
        return jax.random.normal(keys[i], shape, f32) * scale

    def gain(i, shape):
        return 1.0 + nrm(i, shape, 0.05)

    def unif(i, shape, lo, hi):
        return jax.random.uniform(keys[i], shape, f32, lo, hi)

    L, Lv, D, RW = DEPTH, DEPTH - 1, D_MODEL, RWKV_WIDTH
    P = N_DSA_COLS + N_RWKV_COLS
    return {
        'x': nrm(0, (BATCH, SEQ, D), 1.0),
        'c': nrm(1, (BATCH, D), 1.0),
        'ada_w': nrm(2, (L, D, 6 * D), 0.5 * D ** -0.5),
        'ada_b': nrm(3, (L, 6 * D), 0.02),
        'pre_g_mix': gain(4, (L, D)),
        'post_g_mix': gain(5, (L, D)),
        'pre_g_ffn': gain(6, (L, D)),
        'post_g_ffn': gain(7, (L, D)),
        'w_in': nrm(8, (L, D, P), D ** -0.5),
        'w_in_vres': nrm(9, (Lv, D, MV_LORA), D ** -0.5),
        'mu_shift': unif(10, (L, N_RWKV_COLS), 0.0, 1.0),
        'mu_vres': unif(11, (Lv, MV_LORA), 0.0, 1.0),
        'w_out': nrm(12, (L, MIX_WIDTH, D), MIX_WIDTH ** -0.5),
        'q_norm_g': gain(13, (L, Q_LORA)),
        'kv_norm_g': gain(14, (L, KV_LORA)),
        'w_q_up': nrm(15, (L, Q_LORA, DSA_HEADS, DSA_HEAD_DIM), Q_LORA ** -0.5),
        'w_qi_up': nrm(16, (L, Q_LORA, IDX_HEADS, IDX_DIM), Q_LORA ** -0.5),
        'w_k_up': nrm(17, (L, KV_LORA, DSA_HEADS, DSA_HEAD_DIM), KV_LORA ** -0.5),
        'w_v_up': nrm(18, (L, KV_LORA, DSA_HEADS, DSA_HEAD_DIM), KV_LORA ** -0.5),
        'kidx_ln_g': gain(19, (L, IDX_DIM)),
        'kidx_ln_b': nrm(20, (L, IDX_DIM), 0.02),
        'w0': unif(21, (L, RW), -3.0, 1.0),
        'w2': nrm(22, (L, DECAY_LORA, RW), 0.1),
        'a0': nrm(23, (L, RW), 0.1),
        'a2': nrm(24, (L, AAA_LORA, RW), 0.5 * AAA_LORA ** -0.5),
        'g2': nrm(25, (L, GATE_LORA, RW), GATE_LORA ** -0.5),
        'v0': nrm(26, (Lv, RW), 0.5),
        'v2': nrm(27, (Lv, MV_LORA, RW), 0.5 * MV_LORA ** -0.5),
        'k_k': 0.85 + nrm(28, (L, RW), 0.05),
        'k_a': gain(29, (L, RW)),
        'r_k': nrm(30, (L, RWKV_HEADS, RWKV_HEAD_DIM), 0.1),
        'lnx_g': gain(31, (L, RW)),
        'lnx_b': nrm(32, (L, RW), 0.02),
        'w_fc': nrm(33, (L, D, 2 * D_FF), D ** -0.5),
        'w_down': nrm(34, (L, D_FF, D), D_FF ** -0.5),
    }


def reference(x, c, ada_w, ada_b, pre_g_mix, post_g_mix, pre_g_ffn, post_g_ffn,
              w_in, w_in_vres, mu_shift, mu_vres, w_out,
              q_norm_g, kv_norm_g, w_q_up, w_qi_up, w_k_up, w_v_up, kidx_ln_g, kidx_ln_b,
              w0, w2, a0, a2, g2, v0, v2, k_k, k_a, r_k, lnx_g, lnx_b,
              w_fc, w_down):
    cond = jax.nn.silu(c)
    v_first = None
    for l in range(DEPTH):
        mod = cond @ ada_w[l] + ada_b[l]
        sh_a, sc_a, gt_a, sh_f, sc_f, gt_f = [m[:, None, :] for m in jnp.split(mod, 6, axis=-1)]

        h = rms_norm(x, pre_g_mix[l]) * (1 + sc_a) + sh_a
        if l == 0:
            w_proj, mu = w_in[l], mu_shift[l]
        else:
            w_proj = jnp.concatenate([w_in[l], w_in_vres[l - 1]], axis=-1)
            mu = jnp.concatenate([mu_shift[l], mu_vres[l - 1]], axis=-1)
        cols = h @ w_proj
        dsa_cols = cols[..., :N_DSA_COLS]
        rwkv_cols = token_shift(cols[..., N_DSA_COLS:], mu)
        c_q, c_kv, k_idx_raw, w_idx = split_cols(dsa_cols, DSA_COLS)
        if l == 0:
            r, k, v, w_lo, a_lo, g_lo = split_cols(rwkv_cols, RWKV_COLS)
            v_first = v
        else:
            r, k, v, w_lo, a_lo, g_lo, mv_lo = split_cols(rwkv_cols, RWKV_COLS + [MV_LORA])
            v = v + (v_first - v) * jax.nn.sigmoid(v0[l - 1] + mv_lo @ v2[l - 1])
        y_dsa = dsa_mixer(c_q, c_kv, k_idx_raw, w_idx, q_norm_g[l], kv_norm_g[l], w_q_up[l],
                          w_qi_up[l], w_k_up[l], w_v_up[l], kidx_ln_g[l], kidx_ln_b[l])
        y_rwkv = rwkv7_mixer(r, k, v, w_lo, a_lo, g_lo, w0[l], w2[l], a0[l], a2[l], g2[l],
                             k_k[l], k_a[l], r_k[l], lnx_g[l], lnx_b[l])
        y = jnp.concatenate([y_dsa, y_rwkv], axis=-1) @ w_out[l]
        x = x + gt_a * rms_norm(y, post_g_mix[l])

        h = rms_norm(x, pre_g_ffn[l]) * (1 + sc_f) + sh_f
        gate, up = jnp.split(h @ w_fc[l], 2, axis=-1)
        y = (jax.nn.silu(gate) * up) @ w_down[l]
        x = x + gt_f * rms_norm(y, post_g_ffn[l])
    return x
```

```cpp
#include <hip/hip_runtime.h>
#include <cstdio>
#include <cstdint>

#ifndef MK_PER_STEP_LAUNCH
#define MK_PER_STEP_LAUNCH 0
#endif

#define DI __device__ __forceinline__
#define LAS __attribute__((address_space(3)))
typedef _Float16 h16;
typedef h16 h16x8 __attribute__((ext_vector_type(8)));
typedef h16 h16x4 __attribute__((ext_vector_type(4)));
typedef h16 h16x2 __attribute__((ext_vector_type(2)));
typedef float f32x2 __attribute__((ext_vector_type(2)));
typedef float f32x4 __attribute__((ext_vector_type(4)));
typedef float f32x16 __attribute__((ext_vector_type(16)));
typedef unsigned u32x2 __attribute__((ext_vector_type(2)));
typedef unsigned u32x4 __attribute__((ext_vector_type(4)));

constexpr int NB = 16, SEQ = 2048, DM = 1024, NL = 4, MT = NB * SEQ;
constexpr int PIN = 2276;
constexpr int NCA = 768, NRKV = 1536, NIN = NCA + NRKV;
constexpr int NQ = 1280, KLORA = 384, NLORA = 2048, KOUT = 1024, NFC = 5632, DFF = 2816;
constexpr float NORM_EPS = 1e-6f, LNX_EPS = 64e-5f;

constexpr size_t MiB = 1u << 20;
constexpr size_t WS_CTL = 0, CTL_BYTES = 64 * 1024;
constexpr size_t WS_MOD = 1 * MiB;
constexpr size_t WS_WIDX = 3 * MiB;
constexpr size_t WS_KIDX = 4 * MiB;
constexpr size_t WS_CKV = 8 * MiB;
constexpr size_t WS_CKVT = 16 * MiB;
constexpr size_t WS_V1ST = 24 * MiB;
constexpr size_t WS_WTS = 56 * MiB;
constexpr size_t WT_IN = WS_WTS, WT_Q = WT_IN + (size_t)NIN * DM * 2, WT_LORA = WT_Q + (size_t)NQ * 256 * 2, WT_OUT = WT_LORA + (size_t)NLORA * KLORA * 2,
                 WT_VUP = WT_OUT + (size_t)DM * KOUT * 2  , WT_FC = WT_OUT + (size_t)DM * 1536 * 2, WT_DOWN = WT_FC + (size_t)NFC * DM * 2, WT_END = WT_DOWN + (size_t)DM * DFF * 2;
static_assert(WT_END <= 84 * MiB, "weights region");
constexpr size_t WS_H = 84 * MiB;
constexpr size_t WS_CQ = 148 * MiB;
constexpr size_t WS_ALORA = 164 * MiB;
constexpr size_t WS_AOUT = 84 * MiB;
constexpr size_t WS_RKV = 188 * MiB;
constexpr size_t WS_COLSA = 284 * MiB;
constexpr size_t WS_LORAO = 284 * MiB;
constexpr size_t WS_X16 = 412 * MiB;
constexpr size_t WS_Y = 188 * MiB;
constexpr size_t WS_HID = 188 * MiB;
constexpr size_t WS_Y2 = 84 * MiB;
constexpr size_t WS_MASK = 476 * MiB;
constexpr size_t WS_WTS2 = 484 * MiB;
constexpr size_t WS_NEED = 484 * MiB + (84 - 56) * MiB;
DI size_t wofs(int l) { return (l & 1) ? (WS_WTS2 - WS_WTS) : 0; }

constexpr int LDS_BYTES = 147456;
constexpr int LDS_MISC = LDS_BYTES - 256;
constexpr int NTHR = 512;

DI unsigned pkh(float a, float b) { h16x2 v; v.x = (h16)a; v.y = (h16)b; return __builtin_bit_cast(unsigned, v); }
DI unsigned pkb(float lo, float hi) { unsigned r; asm("v_cvt_pk_bf16_f32 %0, %1, %2" : "=v"(r) : "v"(lo), "v"(hi)); return r; }
DI float hlo(unsigned u) { h16x2 v = __builtin_bit_cast(h16x2, u); return (float)v.x; }
DI float hhi(unsigned u) { h16x2 v = __builtin_bit_cast(h16x2, u); return (float)v.y; }
DI float h2f(unsigned short s) { return (float)__builtin_bit_cast(h16, s); }
DI unsigned short f2h(float f) { return __builtin_bit_cast(unsigned short, (h16)f); }
template <int CTRL> DI float dppf(float x) { return __builtin_bit_cast(float, __builtin_amdgcn_update_dpp(0, __builtin_bit_cast(int, x), CTRL, 0xf, 0xf, false)); }
template <int CTRL> DI unsigned dppu(unsigned x) { return (unsigned)__builtin_amdgcn_update_dpp(0, (int)x, CTRL, 0xf, 0xf, false); }
DI float sum4(float x) { x += dppf<0xB1>(x); x += dppf<0x4E>(x); return x; }
DI float sum8(float x) { x = sum4(x); x += dppf<0x141>(x); return x; }
DI float sum16(float x) { x = sum8(x); x += dppf<0x140>(x); return x; }
DI unsigned usum16(unsigned x) { x += dppu<0xB1>(x); x += dppu<0x4E>(x); x += dppu<0x141>(x); x += dppu<0x140>(x); return x; }
DI float sum64(float x) { x = sum16(x); x += __shfl_xor(x, 16); x += __shfl_xor(x, 32); return x; }
DI int lane_id() { int l; asm volatile("v_mbcnt_lo_u32_b32 %0, -1, 0\n\tv_mbcnt_hi_u32_b32 %0, -1, %0" : "=v"(l)); return l; }
DI float sigmoidf_(float z) { return 1.0f / (1.0f + __expf(-z)); }

#define XB_TMO      128
#define XB_XCNT(j)  (256  + 64 * (j))
#define XB_XSUB(j)  (1280 + 64 * (j))
#define XB_XGEN(j)  (2304 + 64 * (j))
#define XB_TOP      3328
#define XB_TOPGEN   3392
#define XCD_BAR_WORDS 3456
#define XB_SPIN_CAP (1u << 18)
DI unsigned xb_ld(unsigned* p)              { return __hip_atomic_load(p, __ATOMIC_RELAXED, __HIP_MEMORY_SCOPE_AGENT); }
DI unsigned xb_add(unsigned* p, unsigned v) { return __hip_atomic_fetch_add(p, v, __ATOMIC_RELAXED, __HIP_MEMORY_SCOPE_AGENT); }
DI unsigned xb_xcc_id() { return (unsigned)__builtin_amdgcn_s_getreg((3 << 11) | 20) & 0xFu; }
#define XB_SPIN(cond, bar) do { unsigned _sp = 0; while (cond) { __builtin_amdgcn_s_sleep(1); \
    if ((++_sp & 255u) == 0u) { if (xb_ld(&(bar)[XB_TMO])) break; if (_sp > XB_SPIN_CAP) { atomicAdd(&(bar)[XB_TMO], 1u); break; } } } } while (0)
struct XcdBarrier { unsigned* bar; unsigned x; volatile LAS unsigned* st; };
DI XcdBarrier xcd_barrier_post(unsigned* bar, volatile LAS unsigned* st, int wave) {
    XcdBarrier b; b.bar = bar; b.x = xb_xcc_id(); b.st = st;
    if (wave == 0 && lane_id() == 0) (void)xb_add(&bar[XB_XCNT(b.x)], 1u);
    return b;
}
DI void xcd_barrier_complete(unsigned* bar, unsigned x, unsigned& nloc, unsigned& nx) {
    const unsigned G = gridDim.x * gridDim.y * gridDim.z;
    unsigned sum, cnt, mine, sp = 0u;
    for (;;) {
        sum = 0u; cnt = 0u; mine = 0u;
#pragma unroll
        for (unsigned j = 0; j < 16; ++j) { const unsigned c = xb_ld(&bar[XB_XCNT(j)]); sum += c; cnt += (c > 0u) ? 1u : 0u; mine = (j == x) ? c : mine; }
        if (sum == G) break;
        __builtin_amdgcn_s_sleep(1);
        if ((++sp & 255u) == 0u) { if (xb_ld(&bar[XB_TMO])) break; if (sp > XB_SPIN_CAP) { atomicAdd(&bar[XB_TMO], 1u); break; } }
    }
    nloc = mine > 0u ? mine : 1u; nx = cnt > 0u ? cnt : 1u;
}
DI void xcd_barrier(const XcdBarrier& b, int wave) {
    asm volatile("s_waitcnt vmcnt(0)" ::: "memory");
    __syncthreads();
    if (wave == 0 && lane_id() == 0) {
        unsigned* bar = b.bar;
        __builtin_amdgcn_s_waitcnt(0);
        unsigned nloc = b.st[0], nx = b.st[1];
        if (nloc == 0u) { xcd_barrier_complete(bar, b.x, nloc, nx); b.st[0] = nloc; b.st[1] = nx; }
        const unsigned old = xb_add(&bar[XB_XSUB(b.x)], 1u);
        const unsigned gen = old / nloc;
        if (old + 1u == (gen + 1u) * nloc) {
            __builtin_amdgcn_fence(__ATOMIC_RELEASE, "agent");
            asm volatile("s_waitcnt vmcnt(0)" ::: "memory");
            const unsigned og = xb_add(&bar[XB_TOP], 1u);
            const unsigned tg = og / nx;
            if (og + 1u == (tg + 1u) * nx) xb_add(&bar[XB_TOPGEN], 1u);
            else XB_SPIN(xb_ld(&bar[XB_TOPGEN]) == tg, bar);
            __builtin_amdgcn_fence(__ATOMIC_ACQUIRE, "agent");
            xb_add(&bar[XB_XGEN(b.x)], 1u);
            asm volatile("s_waitcnt vmcnt(0)" ::: "memory");
        } else {
            XB_SPIN(xb_ld(&bar[XB_XGEN(b.x)]) == gen, bar);
            __builtin_amdgcn_fence(__ATOMIC_ACQUIRE, "agent");
            asm volatile("s_waitcnt vmcnt(0)" ::: "memory");
        }
    }
    __syncthreads();
}

namespace pg8 {
constexpr int BM = 256, BK = 64, HALF = 128, HTB = HALF * BK * 2, STAGE_BYTES = 8 * HTB, NXCD = 8, WGM = 8;
DI int lds_byte(int r, int c) { const int st = (r >> 4) * 2 + (c >> 5), rr = r & 15, cc = c & 31, ob = rr * 64 + cc * 2; return st * 1024 + (ob ^ (((ob >> 9) & 1) << 5)); }
DI void stage_rc(int b, int& R, int& C) { const int st = b / 1024, sb = b % 1024, swz = sb ^ (((sb >> 9) & 1) << 5); R = (st >> 1) * 16 + swz / 64; C = (st & 1) * 32 + (swz % 64) / 2; }
DI int perm32(int rho) { const int n = rho >> 4, i = rho & 15; return 8 * (i >> 2) + 4 * n + (i & 3); }
struct Unit { int pm, pn; };
struct Gemm { const h16* A; const h16* Bt; int M, N, K, lda, ldb; };
struct StaticOrder {
    int nM, nN, nwg, G, c;
    DI void init(int M, int N, int G_, int c_) { nM = M / BM; nN = N / BM; nwg = nM * nN; G = G_; c = c_; }
    DI bool next(int i, Unit& u) const {
        const long L = (long)i * G + c; if (L >= nwg) return false;
        int wgid = (int)L; { const int q = nwg / NXCD, r = nwg % NXCD, xcd = wgid % NXCD, off = wgid / NXCD; wgid = (xcd < r ? xcd * (q + 1) : r * (q + 1) + (xcd - r) * q) + off; }
        const int nig = WGM * nN, gid = wgid / nig, fm = gid * WGM, gsz = (nM - fm) < WGM ? (nM - fm) : WGM;
        u.pm = fm + ((wgid % nig) % gsz); u.pn = (wgid % nig) / gsz; return true;
    }
};
struct EpiF32 {
    static constexpr bool PERM = false;
    float* C; int ldc;
    DI void operator()(const f32x4 (&acc)[2][2][4][2], const Unit& u, int wr, int wc, int fr, int fq) const {
        const int row0 = u.pm * BM + wr * 64 + fr, col0 = u.pn * BM + wc * 32 + 4 * fq;
#pragma unroll
        for (int ai = 0; ai < 2; ++ai)
#pragma unroll
            for (int m = 0; m < 4; ++m) { float* rowp = C + (size_t)(row0 + ai * HALF + m * 16) * ldc + col0;
#pragma unroll
                for (int bj = 0; bj < 2; ++bj)
#pragma unroll
                    for (int n = 0; n < 2; ++n) *(f32x4*)(rowp + bj * HALF + n * 16) = acc[ai][bj][m][n]; }
    }
};
struct EpiH16 {
    static constexpr bool PERM = true;
    h16* O0; int ld0; int nsplit; h16* O1; int ld1;
    DI void operator()(const f32x4 (&acc)[2][2][4][2], const Unit& u, int wr, int wc, int fr, int fq) const {
        const int row0 = u.pm * BM + wr * 64 + fr;
        h16* base; int ld, colt;
        if (u.pn < nsplit) { base = O0; ld = ld0; colt = u.pn * BM; } else { base = O1; ld = ld1; colt = (u.pn - nsplit) * BM; }
        const int col0 = colt + wc * 32 + 8 * fq;
#pragma unroll
        for (int ai = 0; ai < 2; ++ai)
#pragma unroll
            for (int m = 0; m < 4; ++m) { h16* rowp = base + (size_t)(row0 + ai * HALF + m * 16) * ld + col0;
#pragma unroll
                for (int bj = 0; bj < 2; ++bj) { const f32x4 v0 = acc[ai][bj][m][0], v1 = acc[ai][bj][m][1];
                    u32x4 w; w.x = pkh(v0[0], v0[1]); w.y = pkh(v0[2], v0[3]); w.z = pkh(v1[0], v1[1]); w.w = pkh(v1[2], v1[3]);
                    *(u32x4*)(rowp + bj * HALF) = w; } }
    }
};
struct EpiQ {
    static constexpr bool PERM = true;
    h16* O;
    DI void operator()(const f32x4 (&acc)[2][2][4][2], const Unit& u, int wr, int wc, int fr, int fq) const {
        const int row0 = u.pm * BM + wr * 64 + fr, col0 = u.pn * BM + wc * 32 + 8 * fq; const bool bf = u.pn < 4;
#pragma unroll
        for (int ai = 0; ai < 2; ++ai)
#pragma unroll
            for (int m = 0; m < 4; ++m) { h16* rowp = O + (size_t)(row0 + ai * HALF + m * 16) * NQ + col0;
#pragma unroll
                for (int bj = 0; bj < 2; ++bj) { const f32x4 v0 = acc[ai][bj][m][0], v1 = acc[ai][bj][m][1]; u32x4 w;
                    if (bf) { w.x = pkb(v0[0], v0[1]); w.y = pkb(v0[2], v0[3]); w.z = pkb(v1[0], v1[1]); w.w = pkb(v1[2], v1[3]); }
                    else { w.x = pkh(v0[0], v0[1]); w.y = pkh(v0[2], v0[3]); w.z = pkh(v1[0], v1[1]); w.w = pkh(v1[2], v1[3]); }
                    *(u32x4*)(rowp + bj * HALF) = w; } }
    }
};
struct EpiLora {
    static constexpr bool PERM = true;
    h16* O; const float* w0; const float* a0; const float* v0; int has_v; int pn_off;
    DI void operator()(const f32x4 (&acc)[2][2][4][2], const Unit& u, int wr, int wc, int fr, int fq) const {
        const int pnt = u.pn + pn_off; const int row0 = u.pm * BM + wr * 64 + fr; const int type = pnt >> 1;
        const int col0 = pnt * BM + wc * 32 + 8 * fq, j0 = (pnt & 1) * BM + wc * 32 + 8 * fq;
        float bias[2][8];
#pragma unroll
        for (int bj = 0; bj < 2; ++bj)
#pragma unroll
            for (int e = 0; e < 8; ++e) { const int j = j0 + bj * HALF + e; bias[bj][e] = type == 0 ? w0[j] : type == 1 ? a0[j] : (type == 3 && has_v) ? v0[j] : 0.f; }
#pragma unroll
        for (int ai = 0; ai < 2; ++ai)
#pragma unroll
            for (int m = 0; m < 4; ++m) { h16* rowp = O + (size_t)(row0 + ai * HALF + m * 16) * NLORA + col0;
#pragma unroll
                for (int bj = 0; bj < 2; ++bj) { float v[8];
#pragma unroll
                    for (int e = 0; e < 8; ++e) { const float z = acc[ai][bj][m][e >> 2][e & 3] + bias[bj][e];
                        float o;
                        if (type == 0) { const float ee = 0.6065306597126334f * sigmoidf_(z); o = 1.0f - __expf(-ee); }
                        else if (type == 2) o = z;
                        else o = sigmoidf_(z);
                        v[e] = o; }
                    u32x4 w; w.x = pkh(v[0], v[1]); w.y = pkh(v[2], v[3]); w.z = pkh(v[4], v[5]); w.w = pkh(v[6], v[7]);
                    *(u32x4*)(rowp + bj * HALF) = w; asm volatile("" ::: "memory"); } }
    }
};
struct EpiSwiglu {
    static constexpr bool PERM = true;
    h16* O;
    DI void operator()(const f32x4 (&acc)[2][2][4][2], const Unit& u, int wr, int wc, int fr, int fq) const {
        const int row0 = u.pm * BM + wr * 64 + fr, col0 = u.pn * HALF + wc * 32 + 8 * fq;
#pragma unroll
        for (int ai = 0; ai < 2; ++ai)
#pragma unroll
            for (int m = 0; m < 4; ++m) { h16* rowp = O + (size_t)(row0 + ai * HALF + m * 16) * DFF + col0; float v[8];
#pragma unroll
                for (int e = 0; e < 8; ++e) { const float g = acc[ai][0][m][e >> 2][e & 3], up = acc[ai][1][m][e >> 2][e & 3]; v[e] = g * sigmoidf_(g) * up; }
                u32x4 w; w.x = pkh(v[0], v[1]); w.y = pkh(v[2], v[3]); w.z = pkh(v[4], v[5]); w.w = pkh(v[6], v[7]);
                *(u32x4*)rowp = w; }
    }
};

template <class Epi>
DI void gemm_phase(LAS unsigned char* lds, const Gemm g, const StaticOrder& S, const Epi& E, const int wid) {
    const int lane = lane_id(), tid = wid * 64 + lane, wr = wid >> 2, wc = wid & 3, fr = lane & 15, fq = lane >> 4;
    const int K = g.K, nt = K / BK;
    unsigned voffA[2], voffB[2];
#pragma unroll
    for (int i = 0; i < 2; ++i) { int R, C; stage_rc(tid * 16 + i * 8192, R, C); const int Rb = Epi::PERM ? ((R & ~31) + perm32(R & 31)) : R;
        voffA[i] = (unsigned)(R * g.lda + C) * 2u; voffB[i] = (unsigned)(Rb * g.ldb + C) * 2u; }
    const size_t kstep = (size_t)(BK * 2);
    const size_t hstepA = (size_t)HALF * g.lda * 2, hstepB = (size_t)HALF * g.ldb * 2;
    const size_t tstepA = 2 * hstepA, tstepB = 2 * hstepB;
    const unsigned ldsw = (unsigned)wid * 1024u;
    const int aoff = lds_byte(wr * 64 + fr, fq * 8), boff = lds_byte(wc * 32 + fr, fq * 8);
#define PG8_SA(b, h) (((b) * 2 + (h)) * HTB)
#define PG8_SB(b, h) ((4 + (b) * 2 + (h)) * HTB)
#define PG8_STAGE(bufoff, gbase, voff) do { _Pragma("unroll") for (int _i = 0; _i < 2; ++_i) \
        __builtin_amdgcn_global_load_lds((const unsigned*)((const char*)(gbase) + (voff)[_i]), (LAS unsigned*)(lds + (bufoff) + ldsw + _i * 8192), 16, 0, 0); } while (0)
#define PG8_LDA(dst, b, h) do { _Pragma("unroll") for (int m = 0; m < 4; ++m) _Pragma("unroll") for (int k = 0; k < 2; ++k) dst[m][k] = *(const LAS h16x8*)(lds + PG8_SA(b, h) + aoff + m * 2048 + k * 1024); } while (0)
#define PG8_LDB(dst, b, h) do { _Pragma("unroll") for (int n = 0; n < 2; ++n) _Pragma("unroll") for (int k = 0; k < 2; ++k) dst[n][k] = *(const LAS h16x8*)(lds + PG8_SB(b, h) + boff + n * 2048 + k * 1024); } while (0)
#define PG8_MMA(ai, bj, At, Bt) do { __builtin_amdgcn_s_setprio(1); _Pragma("unroll") for (int m = 0; m < 4; ++m) _Pragma("unroll") for (int n = 0; n < 2; ++n) _Pragma("unroll") for (int k = 0; k < 2; ++k) \
        acc[ai][bj][m][n] = __builtin_amdgcn_mfma_f32_16x16x32_f16(Bt[n][k], At[m][k], acc[ai][bj][m][n], 0, 0, 0); __builtin_amdgcn_s_setprio(0); } while (0)
#define PG8_WAIT_V(n) asm volatile("s_waitcnt vmcnt(" #n ")" ::: "memory")
#define PG8_WAIT_L(n) asm volatile("s_waitcnt lgkmcnt(" #n ")" ::: "memory")
#define PG8_BAR __builtin_amdgcn_s_barrier()
#define PG8_SCHED __builtin_amdgcn_sched_barrier(0)
    Unit cur, nxt; int ui = 0;
    if (!S.next(0, cur)) return;
    f32x4 acc[2][2][4][2];
#pragma unroll
    for (int a = 0; a < 2; ++a)
#pragma unroll
        for (int b = 0; b < 2; ++b)
#pragma unroll
            for (int m = 0; m < 4; ++m)
#pragma unroll
                for (int n = 0; n < 2; ++n) acc[a][b][m][n] = (f32x4){0.f, 0.f, 0.f, 0.f};
    h16x8 At[4][2], B0[2][2], B1[2][2];
    const char* cA = (const char*)g.A + (size_t)cur.pm * tstepA; const char* cB = (const char*)g.Bt + (size_t)cur.pn * tstepB;
    PG8_STAGE(PG8_SB(0, 0), cB, voffB); PG8_STAGE(PG8_SB(0, 1), cB + hstepB, voffB); PG8_STAGE(PG8_SA(0, 0), cA, voffA); PG8_STAGE(PG8_SA(0, 1), cA + hstepA, voffA);
    if (wr == 1) PG8_BAR;
    PG8_WAIT_V(2); PG8_BAR;
    PG8_STAGE(PG8_SB(1, 0), cB + kstep, voffB); PG8_STAGE(PG8_SA(1, 0), cA + kstep, voffA); PG8_STAGE(PG8_SB(1, 1), cB + hstepB + kstep, voffB);
    PG8_WAIT_V(6); PG8_BAR;
    for (;;) {
        const bool has_next = S.next(ui + 1, nxt);
        const char* nA = has_next ? (const char*)g.A + (size_t)nxt.pm * tstepA : cA; const char* nB = has_next ? (const char*)g.Bt + (size_t)nxt.pn * tstepB : cB;
        for (int t = 0; t < nt; t += 2) {
            const bool last = (t == nt - 2);
            const char* a1 = cA + (size_t)(t + 1) * kstep;
            const char* a2 = last ? nA : cA + (size_t)(t + 2) * kstep; const char* b2 = last ? nB : cB + (size_t)(t + 2) * kstep;
            const char* a3 = a2 + kstep; const char* b3 = b2 + kstep;
            PG8_LDB(B0, 0, 0); PG8_LDB(B1, 0, 1); PG8_SCHED; PG8_LDA(At, 0, 0); PG8_STAGE(PG8_SA(1, 1), a1 + hstepA, voffA);
            PG8_WAIT_V(8); PG8_WAIT_L(0); PG8_BAR; PG8_MMA(0, 0, At, B0); PG8_MMA(0, 1, At, B1); PG8_BAR; PG8_SCHED;
            PG8_LDA(At, 0, 1); PG8_STAGE(PG8_SB(0, 0), b2, voffB); PG8_STAGE(PG8_SB(0, 1), b2 + hstepB, voffB); PG8_STAGE(PG8_SA(0, 0), a2, voffA);
            PG8_WAIT_V(8); PG8_WAIT_L(0); PG8_BAR; PG8_MMA(1, 0, At, B0); PG8_MMA(1, 1, At, B1); PG8_BAR; PG8_SCHED;
            PG8_LDB(B0, 1, 0); PG8_LDB(B1, 1, 1); PG8_SCHED; PG8_LDA(At, 1, 0); PG8_STAGE(PG8_SA(0, 1), a2 + hstepA, voffA);
            PG8_WAIT_V(8); PG8_WAIT_L(0); PG8_BAR; PG8_MMA(0, 0, At, B0); PG8_MMA(0, 1, At, B1); PG8_BAR; PG8_SCHED;
            PG8_LDA(At, 1, 1); PG8_STAGE(PG8_SB(1, 0), b3, voffB); PG8_STAGE(PG8_SB(1, 1), b3 + hstepB, voffB); PG8_STAGE(PG8_SA(1, 0), a3, voffA);
            PG8_WAIT_V(8); PG8_WAIT_L(0); PG8_BAR; PG8_MMA(1, 0, At, B0); PG8_MMA(1, 1, At, B1); PG8_BAR; PG8_SCHED;
        }
        if (wr == 0) PG8_BAR;
        { const int l2 = lane_id(); E(acc, cur, wr, wc, l2 & 15, l2 >> 4); }
        if (!has_next) break;
#pragma unroll
        for (int a = 0; a < 2; ++a)
#pragma unroll
            for (int b = 0; b < 2; ++b)
#pragma unroll
                for (int m = 0; m < 4; ++m)
#pragma unroll
                    for (int n = 0; n < 2; ++n) acc[a][b][m][n] = (f32x4){0.f, 0.f, 0.f, 0.f};
        cur = nxt; cA = nA; cB = nB; ++ui;
        if (wr == 1) PG8_BAR;
    }
    PG8_WAIT_V(0);
    PG8_BAR;
#undef PG8_SA
#undef PG8_SB
#undef PG8_STAGE
#undef PG8_LDA
#undef PG8_LDB
#undef PG8_MMA
#undef PG8_WAIT_V
#undef PG8_WAIT_L
#undef PG8_BAR
#undef PG8_SCHED
}
}

struct Params {
    const float* in[35];
    float* out;
    unsigned char* ws;
    int step_lo, step_hi;
};
enum { I_X = 0, I_C, I_ADAW, I_ADAB, I_PREMIX, I_POSTMIX, I_PREFFN, I_POSTFFN, I_WIN, I_WINV, I_MU, I_MUV, I_WOUT, I_QNG, I_KVNG, I_WQUP, I_WQIUP, I_WKUP, I_WVUP,
       I_KLNG, I_KLNB, I_W0, I_W2, I_A0, I_A2, I_G2, I_V0, I_V2, I_KK, I_KA, I_RK, I_LNXG, I_LNXB, I_WFC, I_WDOWN };

template <int OFF> DI unsigned long long ka_load64() {
    unsigned long long v;
    asm volatile("s_load_dwordx2 %0, %1, %2\n\ts_waitcnt lgkmcnt(0)" : "=s"(v) : "s"(__builtin_amdgcn_kernarg_segment_ptr()), "n"(OFF));
    return v;
}
#define GAS __attribute__((address_space(1)))
template <int I> DI const float* kin() { return (const float*)(const GAS float*)ka_load64<8 * I>(); }
DI float* kout() { return (float*)(GAS float*)ka_load64<8 * 35>(); }
DI unsigned char* kws() { return (unsigned char*)(GAS unsigned char*)ka_load64<8 * 36>(); }

struct Ctx {
    LAS unsigned char* lds;
    int wave, gw, ngw, G;
};

DI void phase_mod(const Params& p, const Ctx& c) {
    const int lane = lane_id(), tid = c.wave * 64 + lane; (void)tid;
    unsigned char* const ws = kws();
    LAS float* cond = (LAS float*)c.lds;
    LAS float* red = (LAS float*)(c.lds + 65536);
    const float* cin = kin<I_C>();
    for (int i = tid; i < 16384; i += NTHR) { const int b = i & 15, k = i >> 4; const float cv = cin[b * 1024 + k]; cond[k * 16 + b] = cv * sigmoidf_(cv); }
    __syncthreads();
    float* MOD = (float*)(ws + WS_MOD);
    for (int item = blockIdx.x; item < 384; item += c.G) {
        const int l = item / 96, n0 = (item % 96) * 64;
        const float* W = kin<I_ADAW>() + (size_t)l * 1024 * 6144 + n0 + lane;
        float acc[16];
#pragma unroll
        for (int b = 0; b < 16; ++b) acc[b] = 0.f;
        const int k0 = c.wave * 128;
#pragma unroll 8
        for (int k = k0; k < k0 + 128; ++k) {
            const float wv = W[(size_t)k * 6144];
            const LAS f32x4* cb = (const LAS f32x4*)(cond + k * 16);
            const f32x4 c0 = cb[0], c1 = cb[1], c2 = cb[2], c3 = cb[3];
            acc[0] += c0[0] * wv; acc[1] += c0[1] * wv; acc[2] += c0[2] * wv; acc[3] += c0[3] * wv;
            acc[4] += c1[0] * wv; acc[5] += c1[1] * wv; acc[6] += c1[2] * wv; acc[7] += c1[3] * wv;
            acc[8] += c2[0] * wv; acc[9] += c2[1] * wv; acc[10] += c2[2] * wv; acc[11] += c2[3] * wv;
            acc[12] += c3[0] * wv; acc[13] += c3[1] * wv; acc[14] += c3[2] * wv; acc[15] += c3[3] * wv;
        }
#pragma unroll
        for (int b = 0; b < 16; ++b) red[(c.wave * 16 + b) * 64 + lane] = acc[b];
        __syncthreads();
        for (int idx = tid; idx < 1024; idx += NTHR) { const int b = idx >> 6, n = idx & 63; float s = kin<I_ADAB>()[l * 6144 + n0 + n];
#pragma unroll
            for (int w = 0; w < 8; ++w) s += red[(w * 16 + b) * 64 + n];
            MOD[(size_t)(l * 16 + b) * 6144 + n0 + n] = s; }
        __syncthreads();
    }
}

DI void tr_item(const float* src, int ldsrc, h16* dst, int ldd, LAS float* scr, int lane, bool zero) {
#pragma unroll
    for (int hb = 0; hb < 2; ++hb) { float tv[16];
#pragma unroll
        for (int i = 0; i < 16; ++i) { const int kk = 2 * (16 * hb + i) + (lane >> 5); tv[i] = zero ? 0.f : src[(size_t)kk * ldsrc + (lane & 31)]; }
#pragma unroll
        for (int i = 0; i < 16; ++i) { const int kk = 2 * (16 * hb + i) + (lane >> 5); scr[kk * 33 + (lane & 31)] = tv[i]; } }
    asm volatile("s_waitcnt lgkmcnt(0)" ::: "memory");
    const int cc = lane & 7;
#pragma unroll
    for (int j = 0; j < 4; ++j) { const int n = (lane >> 3) + 8 * j; const LAS float* s = scr + (8 * cc) * 33 + n;
        u32x4 o; o.x = pkh(s[0 * 33], s[1 * 33]); o.y = pkh(s[2 * 33], s[3 * 33]); o.z = pkh(s[4 * 33], s[5 * 33]); o.w = pkh(s[6 * 33], s[7 * 33]);
        *(u32x4*)(dst + (size_t)n * ldd + 8 * cc) = o; }
    asm volatile("s_waitcnt lgkmcnt(0)" ::: "memory");
}
DI void phase_wconv(const Params& p, const Ctx& c, int l, const int parts = 3) {
    const int lane = lane_id(), tid = c.wave * 64 + lane; (void)tid;
    unsigned char* const ws = kws();
    LAS float* scr = (LAS float*)(c.lds + c.wave * 16384);
    unsigned char* const wb = ws + wofs(l);
    h16* Win = (h16*)(wb + WT_IN); h16* Wq = (h16*)(wb + WT_Q); h16* Wlo = (h16*)(wb + WT_LORA); h16* Wout = (h16*)(wb + WT_OUT); h16* Wfc = (h16*)(wb + WT_FC); h16* Wdn = (h16*)(wb + WT_DOWN);
    const float* w_in = kin<I_WIN>() + (size_t)l * DM * PIN;
    const float* w_vr = kin<I_WINV>() + (size_t)(l > 0 ? l - 1 : 0) * DM * 32;
    const float* w_fc = kin<I_WFC>() + (size_t)l * DM * NFC;
    const float* w_dn = kin<I_WDOWN>() + (size_t)l * DFF * DM;
    const float* w_out = kin<I_WOUT>() + (size_t)l * 1024 * DM;
    constexpr int IT_IN = 16 * (NIN / 32), IT_FC = 16 * (NFC / 32), IT_DN = (DFF / 64) * (DM / 32), IT_O2 = 16 * (DM / 32);
    constexpr int NIT = IT_IN + IT_FC + IT_DN + IT_O2;
    constexpr int NSPLIT = 2048;
    for (int it = ((parts & 1) ? 0 : NSPLIT) + c.gw; it < ((parts & 2) ? NIT : NSPLIT); it += c.ngw) {
        int r = it;
        if (r < IT_IN) { const int nb = r % (NIN / 32), kb = r / (NIN / 32), nd = nb * 32, k0 = kb * 64;
            int sc; const float* sp = w_in; int ld = PIN; bool zero = false;
            if (nd < 448) sc = nd;
            else if (nd < 736) sc = 1988 + (nd - 448);
            else if (nd < 768) { if (l > 0) { sp = w_vr; ld = 32; sc = 0; } else { zero = true; sc = 0; } }
            else sc = 452 + (nd - 768);
            tr_item(sp + (size_t)k0 * ld + sc, ld, Win + (size_t)nd * DM + k0, DM, scr, lane, zero); continue; }
        r -= IT_IN;
        if (r < IT_FC) { const int nb = r % (NFC / 32), kb = r / (NFC / 32), nd = nb * 32, k0 = kb * 64;
            const int pn = nd >> 8, i = nd & 255; const int sc = (i < 128) ? (128 * pn + i) : (DFF + 128 * pn + (i - 128));
            tr_item(w_fc + (size_t)k0 * NFC + sc, NFC, Wfc + (size_t)nd * DM + k0, DM, scr, lane, false); continue; }
        r -= IT_FC;
        if (r < IT_DN) { const int nb = r % (DM / 32), kb = r / (DM / 32), nd = nb * 32, k0 = kb * 64;
            tr_item(w_dn + (size_t)k0 * DM + nd, DM, Wdn + (size_t)nd * DFF + k0, DFF, scr, lane, false); continue; }
        r -= IT_DN;
        { const int nb = r % (DM / 32), kb = r / (DM / 32), nd = nb * 32, k0 = kb * 64;
            tr_item(w_out + (size_t)k0 * DM + nd, DM, Wout + (size_t)nd * KOUT + k0, KOUT, scr, lane, false); }
    }
    if (!(parts & 2)) return;
    const int gt = c.gw * 64 + lane, ngt = c.ngw * 64;
    const float* wq = kin<I_WQUP>() + (size_t)l * 256 * 512; const float* wk = kin<I_WKUP>() + (size_t)l * 128 * 512; const float* wqi = kin<I_WQIUP>() + (size_t)l * 256 * 256;
    const float* wv = kin<I_WVUP>() + (size_t)l * 128 * 512;
    const float qscl = 0.125f * 1.4426950408889634f;
    for (int it = c.gw; it < 8 * 8 * 4; it += c.ngw) {
        const int h = it >> 5, rb = (it >> 2) & 7, cb = it & 3, cc = cb * 64 + lane;
        f32x4 qv[16];
#pragma unroll
        for (int d4 = 0; d4 < 16; ++d4) qv[d4] = *(const f32x4*)(wq + cc * 512 + h * 64 + 4 * d4);
#pragma unroll 2
        for (int r = 0; r < 16; ++r) { const float* kr = wk + (rb * 16 + r) * 512 + h * 64; float sacc = 0.f;
#pragma unroll
            for (int d4 = 0; d4 < 16; ++d4) { const f32x4 kv = *(const f32x4*)(kr + 4 * d4); sacc += (qv[d4][0] * kv[0] + qv[d4][1] * kv[1]) + (qv[d4][2] * kv[2] + qv[d4][3] * kv[3]); }
            Wq[(size_t)(h * 128 + rb * 16 + r) * 256 + cc] = (h16)(sacc * qscl); }
    }
    for (int idx = gt; idx < 256 * 256; idx += ngt) { const int n = idx >> 8, cc = idx & 255; Wq[(size_t)(1024 + n) * 256 + cc] = (h16)wqi[cc * 256 + n]; }
    const float* w2 = kin<I_W2>() + (size_t)l * 64 * 512; const float* a2 = kin<I_A2>() + (size_t)l * 64 * 512; const float* g2 = kin<I_G2>() + (size_t)l * 160 * 512;
    const float* v2 = kin<I_V2>() + (size_t)(l > 0 ? l - 1 : 0) * 32 * 512;
    for (int idx = gt; idx < 1024 * 128; idx += ngt) {
        const int n = idx >> 7, k = idx & 127, j = n & 511; float o = 0.f;
        if (n < 512) { if (k < 64) o = w2[k * 512 + j]; } else { if (k >= 64) o = a2[(k - 64) * 512 + j]; }
        Wlo[idx] = (h16)o; }
    for (int idx = gt; idx < 1024 * 256; idx += ngt) {
        const int n = idx >> 8, k = idx & 255, j = n & 511; float o = 0.f;
        if (n < 512) { if (k < 160) o = g2[k * 512 + j]; } else { if (l > 0 && k >= 160 && k < 192) o = v2[(k - 160) * 512 + j]; }
        Wlo[1024 * 128 + idx] = (h16)o; }
    { h16* WVt = (h16*)(wb + WT_VUP);
      for (int idx = gt; idx < 8 * 64 * 128; idx += ngt) { const int k = idx & 127, n = (idx >> 7) & 63, h = idx >> 13; WVt[idx] = (h16)wv[k * 512 + h * 64 + n]; } }
}

template <int MODE, bool HAS_NEXT, bool WIDX_>
DI void phase_rows(const Params& p, const Ctx& c, const h16* Y, const float* postg, int gate_off, int mod_l_gate,
                   const float* preg, int sh_off, int sc_off, int mod_l_next, int widx_l) {
    const int lane = lane_id(), tid = c.wave * 64 + lane; (void)tid;
    unsigned char* const ws = kws();
    h16* X = (h16*)(ws + WS_X16); float* OUT = kout(); h16* H = (h16*)(ws + WS_H); const float* MOD = (const float*)(ws + WS_MOD); float* WIDX = (float*)(ws + WS_WIDX);
    for (int rg = c.gw; rg < MT / 16; rg += c.ngw) {
        const int m0 = rg * 16, b = m0 / SEQ;
        f32x4 gp[4], ps[4], shv[4], wi[4][4];
#pragma unroll
        for (int j = 0; j < 4; ++j) { const int col = 4 * lane + 256 * j;
            if (MODE == 1) gp[j] = *(const f32x4*)(MOD + (size_t)(mod_l_gate * 16 + b) * 6144 + gate_off + col) * *(const f32x4*)(postg + col);
            if (HAS_NEXT) { shv[j] = *(const f32x4*)(MOD + (size_t)(mod_l_next * 16 + b) * 6144 + sh_off + col);
                ps[j] = *(const f32x4*)(preg + col) * (*(const f32x4*)(MOD + (size_t)(mod_l_next * 16 + b) * 6144 + sc_off + col) + 1.0f); }
            if (WIDX_) {
#pragma unroll
                for (int e = 0; e < 4; ++e) wi[j][e] = *(const f32x4*)(kin<I_WIN>() + ((size_t)widx_l * DM + col + e) * PIN + 448); }
        }
        for (int rr = 0; rr < 16; ++rr) {
            const size_t m = (size_t)(m0 + rr);
            f32x4 xv[4];
            if (MODE == 0) {
#pragma unroll
                for (int j = 0; j < 4; ++j) xv[j] = *(const f32x4*)(kin<I_X>() + m * DM + 4 * lane + 256 * j);
            } else {
                f32x4 yv[4]; float ss = 0.f;
#pragma unroll
                for (int j = 0; j < 4; ++j) { const u32x2 yr = *(const u32x2*)(Y + m * DM + 4 * lane + 256 * j); yv[j] = (f32x4){hlo(yr.x), hhi(yr.x), hlo(yr.y), hhi(yr.y)}; const u32x2 xr = *(const u32x2*)(X + m * DM + 4 * lane + 256 * j); xv[j] = (f32x4){hlo(xr.x), hhi(xr.x), hlo(xr.y), hhi(xr.y)};
                    ss += (yv[j][0] * yv[j][0] + yv[j][1] * yv[j][1]) + (yv[j][2] * yv[j][2] + yv[j][3] * yv[j][3]); }
                const float rn = rsqrtf(sum64(ss) * (1.0f / DM) + NORM_EPS);
#pragma unroll
                for (int j = 0; j < 4; ++j) xv[j] = xv[j] + (yv[j] * rn) * gp[j];
            }
            if (HAS_NEXT) {
#pragma unroll
                for (int j = 0; j < 4; ++j) { u32x2 w; w.x = pkh(xv[j][0], xv[j][1]); w.y = pkh(xv[j][2], xv[j][3]); *(u32x2*)(X + m * DM + 4 * lane + 256 * j) = w; }
            } else {
#pragma unroll
                for (int j = 0; j < 4; ++j) *(f32x4*)(OUT + m * DM + 4 * lane + 256 * j) = xv[j];
            }
            if (HAS_NEXT) {
                float ss = 0.f;
#pragma unroll
                for (int j = 0; j < 4; ++j) ss += (xv[j][0] * xv[j][0] + xv[j][1] * xv[j][1]) + (xv[j][2] * xv[j][2] + xv[j][3] * xv[j][3]);
                const float rn = rsqrtf(sum64(ss) * (1.0f / DM) + NORM_EPS);
                float d0 = 0.f, d1 = 0.f, d2 = 0.f, d3 = 0.f;
#pragma unroll
                for (int j = 0; j < 4; ++j) { const f32x4 hv = (xv[j] * rn) * ps[j] + shv[j];
                    u32x2 w; w.x = pkh(hv[0], hv[1]); w.y = pkh(hv[2], hv[3]);
                    *(u32x2*)(H + m * DM + 4 * lane + 256 * j) = w;
                    if (WIDX_) {
#pragma unroll
                        for (int e = 0; e < 4; ++e) { d0 += hv[e] * wi[j][e][0]; d1 += hv[e] * wi[j][e][1]; d2 += hv[e] * wi[j][e][2]; d3 += hv[e] * wi[j][e][3]; } } }
                if (WIDX_) { d0 = sum64(d0); d1 = sum64(d1); d2 = sum64(d2); d3 = sum64(d3);
                    if (lane == 0) *(f32x4*)(WIDX + m * 4) = (f32x4){d0 * 0.0625f, d1 * 0.0625f, d2 * 0.0625f, d3 * 0.0625f}; }
            }
        }
    }
}

DI void phase_prep(const Params& p, const Ctx& c, int l) {
    unsigned char* const ws = kws();
    const int lane = lane_id();
    const h16* CA = (const h16*)(ws + WS_COLSA);
    h16* CQ = (h16*)(ws + WS_CQ); h16* CKV = (h16*)(ws + WS_CKV); h16* KIDX = (h16*)(ws + WS_KIDX); h16* AL = (h16*)(ws + WS_ALORA);
    const f32x4 qg = *(const f32x4*)(kin<I_QNG>() + l * 256 + 4 * lane);
    const f32x2 kvg = *(const f32x2*)(kin<I_KVNG>() + l * 128 + 2 * lane);
    const float lg = kin<I_KLNG>()[l * 64 + lane], lb = kin<I_KLNB>()[l * 64 + lane];
    float mu[5];
#pragma unroll
    for (int i = 0; i < 5; ++i) { const int j = lane + 64 * i;
        mu[i] = (j < 288) ? kin<I_MU>()[l * 1824 + 1536 + j] : (l > 0 ? kin<I_MUV>()[(l - 1) * 32 + (j - 288)] : 0.f); }
    for (int rg = c.gw; rg < MT / 16; rg += c.ngw) {
        const int m0 = rg * 16, b = m0 / SEQ, t0 = m0 % SEQ;
        float prevv[5];
#pragma unroll
        for (int i = 0; i < 5; ++i) prevv[i] = (t0 > 0) ? (float)CA[(size_t)(m0 - 1) * NCA + 448 + lane + 64 * i] : 0.f;
#pragma unroll
        for (int rr = 0; rr < 16; ++rr) {
            const size_t m = (size_t)(m0 + rr); const h16* row = CA + m * NCA;
            const u32x2 cqr = *(const u32x2*)(row + 4 * lane);
            const unsigned ckr = *(const unsigned*)(row + 256 + 2 * lane);
            const float kir = (float)row[384 + lane];
            float cur[5];
#pragma unroll
            for (int i = 0; i < 5; ++i) cur[i] = (float)row[448 + lane + 64 * i];
            const float q0 = hlo(cqr.x), q1 = hhi(cqr.x), q2 = hlo(cqr.y), q3 = hhi(cqr.y);
            const float rq = rsqrtf(sum64((q0 * q0 + q1 * q1) + (q2 * q2 + q3 * q3)) * (1.0f / 256.0f) + NORM_EPS);
            u32x2 qo; qo.x = pkh(q0 * rq * qg[0], q1 * rq * qg[1]); qo.y = pkh(q2 * rq * qg[2], q3 * rq * qg[3]);
            *(u32x2*)(CQ + m * 256 + 4 * lane) = qo;
            const float k0 = hlo(ckr), k1 = hhi(ckr);
            const float rk = rsqrtf(sum64(k0 * k0 + k1 * k1) * (1.0f / 128.0f) + NORM_EPS);
            const float o0 = k0 * rk * kvg[0], o1 = k1 * rk * kvg[1];
            *(unsigned*)(CKV + m * 128 + 2 * lane) = pkb(o0, o1);
            const float mean = sum64(kir) * (1.0f / 64.0f); const float dv = kir - mean; const float var = sum64(dv * dv) * (1.0f / 64.0f);
            KIDX[m * 64 + lane] = (h16)(dv * rsqrtf(var + NORM_EPS) * lg + lb);
#pragma unroll
            for (int i = 0; i < 5; ++i) { const float sh = cur[i] + (prevv[i] - cur[i]) * mu[i]; prevv[i] = cur[i]; const int j = lane + 64 * i; float o;
                if (i == 0) o = tanhf(sh); else if (i == 1) o = sh; else if (j < 288) o = sigmoidf_(sh); else o = (l > 0) ? sh : 0.f;
                AL[m * KLORA + j] = (h16)o; }
            AL[m * KLORA + 320 + lane] = (h16)0.f;
        }
    }
}

constexpr int AT_KSTR = 272, AT_VSTR = 144;
constexpr int AT_KB = 64 * AT_KSTR, AT_VB = 128 * AT_VSTR, AT_BUF = AT_KB + AT_VB;
constexpr int AT_MASK = 131072 + 1024;
DI unsigned okey(float s) { const unsigned u = __builtin_bit_cast(unsigned, s); return (u & 0x80000000u) ? ~u : (u | 0x80000000u); }
DI float ikeyf(unsigned k) { return __builtin_bit_cast(float, (k & 0x80000000u) ? (k & 0x7FFFFFFFu) : ~k); }
template <int CTRL, int RM> DI unsigned dppu_rm(unsigned x) { return (unsigned)__builtin_amdgcn_update_dpp(0, (int)x, CTRL, RM, 0xf, false); }
DI unsigned umax_(unsigned a, unsigned b) { return a > b ? a : b; }
DI unsigned max64u(unsigned x) {
    x = umax_(x, dppu<0xB1>(x)); x = umax_(x, dppu<0x4E>(x)); x = umax_(x, dppu<0x141>(x)); x = umax_(x, dppu<0x140>(x));
    x = umax_(x, dppu_rm<0x142, 0xA>(x)); x = umax_(x, dppu_rm<0x143, 0xC>(x)); return (unsigned)__builtin_amdgcn_readlane((int)x, 63);
}

template <int NRM>
DI void select_query(const LAS float* SCq, unsigned long long* mkq, const int nr, const int lane) {

                        unsigned key[NRM];
                        float sraw[NRM];
#pragma unroll
                        for (int r = 0; r < NRM; ++r) sraw[r] = SCq[64 * (r < nr ? r : 0) + lane];
#pragma unroll
                        for (int r = 0; r < NRM; ++r) key[r] = okey(sraw[r]) & (unsigned)((r - nr) >> 31);
                        auto count_ge = [&](const unsigned cand) -> unsigned { unsigned cnt = 0u;
#pragma unroll
                            for (int r = 0; r < NRM; r += 4) {
                                const unsigned long long m0 = __ballot(key[r] >= cand), m1 = __ballot(key[r + 1] >= cand), m2 = __ballot(key[r + 2] >= cand), m3 = __ballot(key[r + 3] >= cand);
                                cnt += (unsigned)(__popcll(m0) + __popcll(m1)) + (unsigned)(__popcll(m2) + __popcll(m3)); }
                            return cnt; };
                        unsigned thr = 0u; bool exact = false, found = false, neg = false;
                        unsigned klo = 0u, khi = 0u, clo = 0u, chi = 0u;
                        { const unsigned c1 = count_ge(0x80000001u);
                          if (c1 == 256u) { thr = 0x80000001u; exact = true; found = true; }
                          else if (c1 > 256u) { unsigned mx = 0u;
#pragma unroll
                              for (int r = 0; r < NRM; ++r) mx = key[r] > mx ? key[r] : mx;
                              klo = 0x80000001u; clo = c1; khi = max64u(mx) + 1u; chi = 0u; }
                          else { const unsigned c3 = count_ge(0x7FFFFFFFu);
                              if (c3 >= 256u) { found = true;
                                  if (c3 == 256u) { thr = 0x7FFFFFFFu; exact = true; }
                                  else { const unsigned c2 = count_ge(0x80000000u);
                                      if (c2 >= 256u) { thr = 0x80000000u; exact = (c2 == 256u); } else thr = 0x7FFFFFFFu; } }
                              else { unsigned mx = 0u;
#pragma unroll
                                  for (int r = 0; r < NRM; ++r) { const unsigned kc = ~key[r] & (unsigned)((r - nr) >> 31); mx = kc > mx ? kc : mx; }
                                  klo = ~max64u(mx); clo = 64u * (unsigned)nr; khi = 0x7FFFFFFFu; chi = c3; neg = true; } } }
                        if (!found) { float wlo = 1.f, whi = 1.f; int last = 0, it = 0;
#pragma unroll 1
                            for (;;) {
                                if (khi - klo <= 1u) { thr = klo; break; }
                                ++it;
                                const float vlo = ikeyf(klo), vhi = ikeyf(khi);
                                const float a = ((float)clo - 255.5f) * wlo, b = (255.5f - (float)chi) * whi;
                                float frac = a * __builtin_amdgcn_rcpf(a + b);
                                if ((it & 7) == 0) frac = 0.5f;
                                if (it == 1) {
                                    if (!neg) { const float lc = __builtin_amdgcn_logf((float)clo); frac = __builtin_amdgcn_exp2f(0.75f * __builtin_amdgcn_logf((lc - 8.f) * __builtin_amdgcn_rcpf(lc))); }
                                    else { const float lm = __builtin_amdgcn_logf((float)(clo - chi)), lb = __builtin_amdgcn_logf((float)(clo - 256u));
                                           frac = 1.f - __builtin_amdgcn_exp2f(0.8f * __builtin_amdgcn_logf((lm - lb) * __builtin_amdgcn_rcpf(lm))); } }
                                unsigned kp = (unsigned)__builtin_amdgcn_readfirstlane((int)okey(vlo + (vhi - vlo) * frac));
                                if (!(kp > klo && kp < khi)) kp = klo + ((khi - klo) >> 1);
                                const unsigned cn = count_ge(kp);
                                if (cn == 256u) { thr = kp; exact = true; break; }
                                if (cn > 256u) { klo = kp; clo = cn; whi = (last == 1) ? whi * 0.7f : 1.f; wlo = 1.f; last = 1; }
                                else { khi = kp; chi = cn; wlo = (last == -1) ? wlo * 0.7f : 1.f; whi = 1.f; last = -1; }
                            } }
                        unsigned need = 0u;
                        if (!exact) { unsigned cgt = 0u;
#pragma unroll
                            for (int r = 0; r < NRM; ++r) cgt += (unsigned)__popcll(__ballot(key[r] > thr));
                            need = 256u - cgt; }
                        unsigned base = 0u;
                        const unsigned long long lowmask = (1ull << lane) - 1ull;
#pragma unroll
                        for (int r = 0; r < NRM; ++r) {
                            bool sel = key[r] >= thr;
                            if (!exact) { const bool eq = key[r] == thr; const unsigned long long em = __ballot(eq);
                                const unsigned pre = __popcll(em & lowmask); sel = (key[r] > thr) || (eq && (base + pre < need)); base += __popcll(em); }
                            const unsigned long long sm = __ballot(sel);
                            if (lane == 0) mkq[r] = sm;
                        }
                    }

DI void phase_select(const Params& p, const Ctx& c, unsigned* qctr) {
    unsigned char* const ws = kws();
    const h16* QALL = (const h16*)kout(); const h16* KIDX = (const h16*)(ws + WS_KIDX);
    const float* WIDX = (const float*)(ws + WS_WIDX); unsigned long long* MASKG = (unsigned long long*)(ws + WS_MASK);
    const int wave = c.wave;
    LAS unsigned char* lds = c.lds;
    volatile LAS unsigned* qw = (volatile LAS unsigned*)(c.lds + LDS_MISC + 64);
    {
        for (;;) {
            const int lane = lane_id(), tid = wave * 64 + lane;
            if (wave == 0 && lane == 0) *qw = __hip_atomic_fetch_add(qctr, 1u, __ATOMIC_RELAXED, __HIP_MEMORY_SCOPE_AGENT);
            __syncthreads();
            const int unit = (int)*qw;
            __syncthreads();
            if (unit >= 1024) break;
            const int chv = 31 - (unit >> 5), subv = unit & 31;
            const int b = subv >> 1, half = subv & 1;
            const int nadm = 64 * (chv + 1), nkt = chv + 1;
            const int kbase = b * SEQ;
            const int tqu = b * SEQ + chv * 64 + half * 32;
            unsigned long long* mk64 = MASKG + (size_t)tqu * 32;
            if (nadm <= 256) {
                if (lane < 16) mk64[(4 * wave + (lane >> 2)) * 32 + (lane & 3)] = ((lane & 3) < nkt) ? ~0ull : 0ull;
            } else {
                LAS float* SC = (LAS float*)lds;
                const int q4 = lane >> 4, c16 = lane & 15;
#pragma unroll 1
                for (int rnd = 0; rnd < 2; ++rnd) {
                    {
                        h16x8 a0[4], a1[4]; f32x4 wv[4];
#pragma unroll
                        for (int g = 0; g < 4; ++g) { const int tqr = tqu + 16 * rnd + 4 * g;
                            const h16* ap = QALL + (size_t)(tqr + (c16 >> 2)) * NQ + 1024 + (c16 & 3) * 64 + 8 * q4; a0[g] = *(const h16x8*)ap; a1[g] = *(const h16x8*)(ap + 32);
                            wv[g] = *(const f32x4*)(WIDX + (size_t)(tqr + q4) * 4); }
                        const int nt16 = nadm >> 4;
                        const h16* kp = KIDX + (size_t)(kbase + c16) * 64 + 8 * q4;
#pragma unroll 1
                        for (int tb = wave; tb < nt16; tb += 64) {
                            h16x8 b0[8], b1[8];
#pragma unroll
                            for (int u = 0; u < 8; ++u) { int tt = tb + 8 * u; tt = tt < nt16 ? tt : tb; b0[u] = *(const h16x8*)(kp + (size_t)tt * 1024); b1[u] = *(const h16x8*)(kp + (size_t)tt * 1024 + 32); }
#pragma unroll
                            for (int u = 0; u < 8; ++u) { const int tt = tb + 8 * u;
                                if (tt < nt16) {
#pragma unroll
                                    for (int g = 0; g < 4; ++g) { f32x4 acc = (f32x4){0.f, 0.f, 0.f, 0.f};
                                        acc = __builtin_amdgcn_mfma_f32_16x16x32_f16(a0[g], b0[u], acc, 0, 0, 0); acc = __builtin_amdgcn_mfma_f32_16x16x32_f16(a1[g], b1[u], acc, 0, 0, 0);
                                        SC[(4 * g + q4) * 2048 + 16 * tt + c16] = ((fmaxf(acc[0], 0.f) * wv[g][0] + fmaxf(acc[1], 0.f) * wv[g][1]) + fmaxf(acc[2], 0.f) * wv[g][2]) + fmaxf(acc[3], 0.f) * wv[g][3]; }
                                }
                            }
                        }
                    }
                    __syncthreads();
                    const int nr = nadm >> 6;
#pragma unroll 1
                    for (int qi = 0; qi < 2; ++qi) {
                        const int ql = 2 * wave + qi; const LAS float* SCq = SC + ql * 2048; unsigned long long* mkq = mk64 + (16 * rnd + ql) * 32;
                        if (nr <= 8) select_query<8>(SCq, mkq, nr, lane); else if (nr <= 16) select_query<16>(SCq, mkq, nr, lane);
                        else if (nr <= 24) select_query<24>(SCq, mkq, nr, lane); else select_query<32>(SCq, mkq, nr, lane);
                    }
                    __syncthreads();
                }
            }
            __syncthreads();
        }
    }
}

namespace ab {
typedef short bf16x8 __attribute__((ext_vector_type(8)));
typedef short s16x4 __attribute__((ext_vector_type(4)));
constexpr int SHM_V = 64 * 128 * 2, SHM_K = 64 * 128 * 2;
constexpr int LDS_RED = 2 * SHM_V + 2 * SHM_K;
constexpr int LDS_MK = LDS_RED + 8 * 256;
constexpr int LDS_END = LDS_MK + 8 * 8192;
constexpr float THRL = 8.0f;
#define AB_KSWZ(row, colB) ((row) * 256 + ((colB) ^ (((row) & 7) << 4)))
#define AB_SBAR() __builtin_amdgcn_sched_barrier(0)
DI int crow(int r, int hi) { return (r & 3) + 8 * (r >> 2) + 4 * hi; }
DI unsigned cvtpk(float lo, float hi) { unsigned r; asm volatile("v_cvt_pk_bf16_f32 %0, %1, %2" : "=v"(r) : "v"(lo), "v"(hi)); return r; }
DI void partialSM(f32x16& p0, f32x16& p1, float& m_reg, float& mn, float& alpha, unsigned wlo, unsigned whi) {
#pragma unroll
    for (int r = 0; r < 16; ++r) { const int o = (r & 3) + 8 * (r >> 2); p0[r] = ((wlo >> o) & 1u) ? p0[r] : -__builtin_inff(); p1[r] = ((whi >> o) & 1u) ? p1[r] : -__builtin_inff(); }
    float pmax = p0[0];
#pragma unroll
    for (int r = 1; r < 16; ++r) pmax = fmaxf(pmax, p0[r]);
#pragma unroll
    for (int r = 0; r < 16; ++r) pmax = fmaxf(pmax, p1[r]);
    { auto rr = __builtin_amdgcn_permlane32_swap(__float_as_uint(pmax), __float_as_uint(pmax), false, false);
      pmax = fmaxf(__uint_as_float(rr[0]), __uint_as_float(rr[1])); }
    if (__builtin_expect(__all(pmax - m_reg <= THRL), 1)) { mn = m_reg; alpha = 1.f; }
    else { mn = fmaxf(m_reg, pmax); alpha = __builtin_amdgcn_exp2f(m_reg - mn); m_reg = mn; }
#pragma unroll
    for (int r = 0; r < 16; ++r) { p0[r] = p0[r] - mn; p1[r] = p1[r] - mn; }
#pragma unroll
    for (int r = 0; r < 16; ++r) p0[r] = __builtin_amdgcn_exp2f(p0[r]);
}
DI void finishSM(f32x16& p0, f32x16& p1, float alpha, float& l_reg, bf16x8& pa0, bf16x8& pa1, bf16x8& pa2, bf16x8& pa3) {
#pragma unroll
    for (int r = 0; r < 16; ++r) p1[r] = __builtin_amdgcn_exp2f(p1[r]);
    float ps = 0;
#pragma unroll
    for (int r = 0; r < 16; ++r) ps += p0[r];
#pragma unroll
    for (int r = 0; r < 16; ++r) ps += p1[r];
    { auto rr = __builtin_amdgcn_permlane32_swap(__float_as_uint(ps), __float_as_uint(ps), false, false);
      ps = __uint_as_float(rr[0]) + __uint_as_float(rr[1]); }
    l_reg = l_reg * alpha + ps;
#define AB_PK4(P, BASE, OUT) do { unsigned a0 = cvtpk(P[BASE + 0], P[BASE + 1]), a1 = cvtpk(P[BASE + 2], P[BASE + 3]);   \
    unsigned b0 = cvtpk(P[BASE + 4], P[BASE + 5]), b1 = cvtpk(P[BASE + 6], P[BASE + 7]);                              \
    auto r0 = __builtin_amdgcn_permlane32_swap(a0, b0, false, false); auto r1 = __builtin_amdgcn_permlane32_swap(a1, b1, false, false); \
    u32x4 w = {r0[0], r1[0], r0[1], r1[1]}; OUT = __builtin_bit_cast(bf16x8, w); } while (0)
    AB_PK4(p0, 0, pa0); AB_PK4(p0, 8, pa1); AB_PK4(p1, 0, pa2); AB_PK4(p1, 8, pa3);
#undef AB_PK4
}
DI void qkt(f32x16& p0, f32x16& p1, const LAS unsigned char* Ks, const bf16x8* qr, int r32, int hi) {
#pragma unroll
    for (int e = 0; e < 16; ++e) { p0[e] = 0.f; p1[e] = 0.f; }
#pragma unroll
    for (int d0 = 0; d0 < 8; ++d0) { const int cb = (d0 * 16 + hi * 8) * 2;
        const bf16x8 b0 = *(const LAS bf16x8*)(Ks + AB_KSWZ(r32, cb));
        const bf16x8 b1 = *(const LAS bf16x8*)(Ks + AB_KSWZ(32 + r32, cb));
        p0 = __builtin_amdgcn_mfma_f32_32x32x16_bf16(b0, qr[d0], p0, 0, 0, 0);
        p1 = __builtin_amdgcn_mfma_f32_32x32x16_bf16(b1, qr[d0], p1, 0, 0, 0); }
}
DI int v_st(int k, int c) { const int kk = (k & ~0xC) | ((k & 4) << 1) | ((k & 8) >> 1); return ((kk >> 3) * 4 + (c >> 5)) * 512 + ((kk & 7) * 32 + (c & 31)) * 2; }
DI int v_rd_base(int lane) { return ((lane & 3) << 3) | (((lane >> 2) & 3) << 6) | (((lane >> 4) & 1) << 5) | (((lane >> 5) & 1) << 8); }
constexpr int v_rd_off(int d0, int ks, int half) { return d0 * 512 + ks * 4096 + half * 2048; }
template <int OFF> DI s16x4 tr_read(int vb) { s16x4 r; asm volatile("ds_read_b64_tr_b16 %0, %1 offset:%2" : "=&v"(r) : "v"(vb), "i"(OFF) : "memory"); return r; }
template <int D0> DI void pv_one(f32x16& od, int vb, bf16x8 pa0, bf16x8 pa1, bf16x8 pa2, bf16x8 pa3) {
    const s16x4 l0 = tr_read<v_rd_off(D0, 0, 0)>(vb), h0 = tr_read<v_rd_off(D0, 0, 1)>(vb), l1 = tr_read<v_rd_off(D0, 1, 0)>(vb), h1 = tr_read<v_rd_off(D0, 1, 1)>(vb);
    const s16x4 l2 = tr_read<v_rd_off(D0, 2, 0)>(vb), h2 = tr_read<v_rd_off(D0, 2, 1)>(vb), l3 = tr_read<v_rd_off(D0, 3, 0)>(vb), h3 = tr_read<v_rd_off(D0, 3, 1)>(vb);
    asm volatile("s_waitcnt lgkmcnt(0)" ::: "memory"); AB_SBAR();
#define AB_PK(L, H) (bf16x8){L[0], L[1], L[2], L[3], H[0], H[1], H[2], H[3]}
    od = __builtin_amdgcn_mfma_f32_32x32x16_bf16(pa0, AB_PK(l0, h0), od, 0, 0, 0);
    od = __builtin_amdgcn_mfma_f32_32x32x16_bf16(pa1, AB_PK(l1, h1), od, 0, 0, 0);
    od = __builtin_amdgcn_mfma_f32_32x32x16_bf16(pa2, AB_PK(l2, h2), od, 0, 0, 0);
    od = __builtin_amdgcn_mfma_f32_32x32x16_bf16(pa3, AB_PK(l3, h3), od, 0, 0, 0);
#undef AB_PK
}
DI void pv_d0(f32x16* o, int vb, bf16x8 pa0, bf16x8 pa1, bf16x8 pa2, bf16x8 pa3) {
    pv_one<0>(o[0], vb, pa0, pa1, pa2, pa3); pv_one<1>(o[1], vb, pa0, pa1, pa2, pa3); pv_one<2>(o[2], vb, pa0, pa1, pa2, pa3); pv_one<3>(o[3], vb, pa0, pa1, pa2, pa3);
}
DI void body(const unsigned short* Qb, const unsigned short* Kh, h16* Ob, const h16* Wv, const unsigned long long* Mb, const int NT, LAS unsigned char* lds, const int wid, const int lane) {
    const int tid = wid * 64 + lane, r32 = lane & 31, hi = lane >> 5;
    LAS unsigned char* V_lds = lds; LAS unsigned char* K_lds = lds + 2 * SHM_V;
    LAS float* wsf = (LAS float*)(lds + LDS_RED) + wid * 64; LAS float* li_l = wsf; LAS float* al_l = wsf + 32;
    LAS unsigned long long* mkl = (LAS unsigned long long*)(lds + LDS_MK) + wid * 1024;
    float m_reg = -1e30f, l_reg = 0;
    f32x16 o[4];
#pragma unroll
    for (int d = 0; d < 4; ++d)
#pragma unroll
        for (int e = 0; e < 16; ++e) o[d][e] = 0.f;
    bf16x8 qr[8];
    const unsigned short* Qw = Qb + (size_t)(wid * 32 + r32) * NQ + hi * 8;
#pragma unroll
    for (int d0 = 0; d0 < 8; ++d0) qr[d0] = *(const bf16x8*)(Qw + d0 * 16);
    {
        const unsigned long long* mrow = Mb + (size_t)(wid * 32 + r32) * 32 + 2 * hi;
        for (int i = 0; i < (NT >> 2); ++i) { const u32x4 w = *(const u32x4*)(mrow + 4 * i);
            mkl[(4 * i + 2 * hi) * 32 + r32] = ((unsigned long long)w.y << 32) | w.x; mkl[(4 * i + 2 * hi + 1) * 32 + r32] = ((unsigned long long)w.w << 32) | w.z; }
    }
    const int sr = tid >> 4, sc = (tid & 15) * 8, vst0 = v_st(sr, sc), vst1 = v_st(32 + sr, sc);
    const int vb0 = (int)(unsigned)(uintptr_t)V_lds + v_rd_base(lane);
    bf16x8 st0[2], st1[2];
#define AB_SLOAD(i, k0) do { st0[i] = *(const bf16x8*)(Kh + (size_t)((k0) + sr) * 128 + sc); st1[i] = *(const bf16x8*)(Kh + (size_t)((k0) + 32 + sr) * 128 + sc); } while (0)
#define AB_SWRITE(b, i) do { *(LAS bf16x8*)(V_lds + (b) * SHM_V + vst0) = st0[i]; *(LAS bf16x8*)(V_lds + (b) * SHM_V + vst1) = st1[i]; const int kc = sc * 2; \
    *(LAS bf16x8*)(K_lds + (b) * SHM_K + AB_KSWZ(sr, kc)) = st0[i]; *(LAS bf16x8*)(K_lds + (b) * SHM_K + AB_KSWZ(32 + sr, kc)) = st1[i]; } while (0)
#define AB_SWAIT() asm volatile("s_waitcnt vmcnt(2)" ::: "memory")
#define AB_RESC(a) do { if (__any((a) < 1.f)) { if (hi == 0) al_l[r32] = (a); asm volatile("s_waitcnt lgkmcnt(0)" ::: "memory"); \
    _Pragma("unroll") for (int d = 0; d < 4; ++d) _Pragma("unroll") for (int r = 0; r < 16; ++r) o[d][r] *= al_l[crow(r, hi)]; } } while (0)
#define AB_MASK(j, WLO, WHI) const unsigned long long mw_##WLO = mkl[(j) * 32 + r32]; const unsigned WLO = (unsigned)mw_##WLO >> (4 * hi), WHI = (unsigned)(mw_##WLO >> 32) >> (4 * hi)
    f32x16 pA0, pA1, pB0, pB1; float mnA, mnB, alA, alB; bf16x8 pa0, pa1, pa2, pa3;
    AB_SLOAD(0, 0); asm volatile("s_waitcnt vmcnt(0)" ::: "memory"); AB_SWRITE(0, 0); __syncthreads();
    qkt(pA0, pA1, K_lds, qr, r32, hi); { AB_MASK(0, wl, wh); partialSM(pA0, pA1, m_reg, mnA, alA, wl, wh); }
    AB_SLOAD(1, 64); if (2 < NT) AB_SLOAD(0, 128);
    AB_SWAIT(); AB_SWRITE(1, 1); __syncthreads();
    for (int j = 1; j + 1 < NT; j += 2) {
        AB_SBAR(); qkt(pB0, pB1, K_lds + SHM_K, qr, r32, hi);
        finishSM(pA0, pA1, alA, l_reg, pa0, pa1, pa2, pa3); AB_SBAR();
        AB_SLOAD(1, (j + 2) * 64); AB_SBAR();
        pv_d0(o, vb0, pa0, pa1, pa2, pa3); { AB_MASK(j, wl, wh); partialSM(pB0, pB1, m_reg, mnB, alB, wl, wh); }
        __syncthreads(); AB_SWAIT(); AB_SWRITE(0, 0);
        AB_RESC(alB); __syncthreads();
        AB_SBAR(); qkt(pA0, pA1, K_lds, qr, r32, hi);
        finishSM(pB0, pB1, alB, l_reg, pa0, pa1, pa2, pa3); AB_SBAR();
        if (j + 3 < NT) AB_SLOAD(0, (j + 3) * 64); AB_SBAR();
        pv_d0(o, vb0 + SHM_V, pa0, pa1, pa2, pa3); { AB_MASK(j + 1, wl, wh); partialSM(pA0, pA1, m_reg, mnA, alA, wl, wh); }
        __syncthreads(); AB_SWAIT(); AB_SWRITE(1, 1);
        AB_RESC(alA); __syncthreads();
    }
    AB_SBAR(); qkt(pB0, pB1, K_lds + SHM_K, qr, r32, hi);
    finishSM(pA0, pA1, alA, l_reg, pa0, pa1, pa2, pa3); AB_SBAR();
    pv_d0(o, vb0, pa0, pa1, pa2, pa3); { AB_MASK(NT - 1, wl, wh); partialSM(pB0, pB1, m_reg, mnB, alB, wl, wh); }
    __syncthreads(); AB_RESC(alB);
    finishSM(pB0, pB1, alB, l_reg, pa0, pa1, pa2, pa3); AB_SBAR();
    pv_d0(o, vb0 + SHM_V, pa0, pa1, pa2, pa3);
    if (hi == 0) li_l[r32] = l_reg;
    asm volatile("s_waitcnt lgkmcnt(0)" ::: "memory");
    __syncthreads();
    LAS unsigned char* ob = lds + wid * 8192;
    const int le_ = lane_id(), r32e = le_ & 31, hie = le_ >> 5;
#pragma unroll
    for (int r = 0; r < 16; ++r) { const int orow = crow(r, hie); const float rli = __builtin_amdgcn_rcpf(li_l[orow]);
#pragma unroll
        for (int d0 = 0; d0 < 4; ++d0) { const int col = d0 * 32 + r32e; *(LAS h16*)(ob + orow * 256 + ((((col >> 3) ^ (orow & 15)) << 4) | ((col & 7) * 2))) = (h16)(o[d0][r] * rli); } }
    asm volatile("s_waitcnt lgkmcnt(0)" ::: "memory");
    f32x16 yv[2];
#pragma unroll
    for (int e = 0; e < 16; ++e) { yv[0][e] = 0.f; yv[1][e] = 0.f; }
#pragma unroll
    for (int s8 = 0; s8 < 8; ++s8) { const h16x8 af = *(const LAS h16x8*)(ob + r32e * 256 + (((2 * s8 + hie) ^ (r32e & 15)) << 4));
#pragma unroll
        for (int nt = 0; nt < 2; ++nt) { const h16x8 bf = *(const h16x8*)(Wv + (size_t)(32 * nt + r32e) * 128 + 16 * s8 + 8 * hie);
            yv[nt] = __builtin_amdgcn_mfma_f32_32x32x16_f16(af, bf, yv[nt], 0, 0, 0); } }
#pragma unroll
    for (int nt = 0; nt < 2; ++nt)
#pragma unroll
        for (int r = 0; r < 16; ++r) Ob[(size_t)(wid * 32 + crow(r, hie)) * KOUT + 32 * nt + r32e] = (h16)yv[nt][r];
#undef AB_SLOAD
#undef AB_SWRITE
#undef AB_SWAIT
#undef AB_RESC
#undef AB_MASK
}
}

DI void phase_attn(const Params& p, const Ctx& c, unsigned* qctr, const int l) {
    unsigned char* const ws = kws();
    const unsigned short* QALL = (const unsigned short*)kout(); const unsigned short* CKV = (const unsigned short*)(ws + WS_CKV);
    const unsigned long long* MASKG = (const unsigned long long*)(ws + WS_MASK); h16* AOUT = (h16*)(ws + WS_AOUT);
    const int wave = c.wave;
    volatile LAS unsigned* qw = (volatile LAS unsigned*)(c.lds + LDS_MISC + 64);
    for (;;) {
        const int lane = lane_id();
        if (wave == 0 && lane == 0) *qw = __hip_atomic_fetch_add(qctr, 1u, __ATOMIC_RELAXED, __HIP_MEMORY_SCOPE_AGENT);
        __syncthreads();
        const int unit = (int)*qw;
        __syncthreads();
        if (unit >= NB * 8 * 8) break;
        const int qb = 7 - (unit >> 7), b = (unit >> 3) & 15, h = unit & 7;
        const size_t row0 = (size_t)b * SEQ + 256 * qb;
        ab::body(QALL + row0 * NQ + h * 128, CKV + (size_t)b * SEQ * 128, AOUT + row0 * KOUT + h * 64, (const h16*)(ws + wofs(l) + WT_VUP) + h * 64 * 128, MASKG + row0 * 32, 4 * (qb + 1), c.lds, wave, lane);
        __syncthreads();
    }
}

DI int sw128(int row, int boff) { return row * 128 + ((((boff >> 4) ^ ((row >> 1) & 7)) << 4) | (boff & 15)); }
DI int sw64(int row, int boff)  { return row * 64 + ((((boff >> 4) ^ ((row >> 2) & 3)) << 4) | (boff & 15)); }
DI int sw32(int row, int boff)  { return row * 32 + ((((boff >> 4) ^ ((row >> 3) & 1)) << 4) | (boff & 15)); }
constexpr int SL_A1 = 0, SL_A4 = 4096, SL_WY = 8192, SL_VT = 12288, SL_A23 = 14336, SL_A5 = 15360, SL_P16 = 16384, SLOT = 16640;
DI float rl(float x, int l) { return __builtin_bit_cast(float, __builtin_amdgcn_readlane(__builtin_bit_cast(int, x), l)); }
template <int CTRL, int RM> DI float dppf_rm(float x) { return __builtin_bit_cast(float, __builtin_amdgcn_update_dpp(0, __builtin_bit_cast(int, x), CTRL, RM, 0xf, false)); }
DI float sum64u(float x) { x = sum16(x); x += dppf_rm<0x142, 0xA>(x); x += dppf_rm<0x143, 0xC>(x); return rl(x, 63); }
DI u32x4 pk8(float a, float b, float c, float d, float e, float f, float g, float h) { u32x4 w; w.x = pkh(a, b); w.y = pkh(c, d); w.z = pkh(e, f); w.w = pkh(g, h); return w; }

DI void phase_scan2(const Params& p, const Ctx& c, int l) {
    unsigned char* const ws = kws();
    const h16* RKV = (const h16*)(ws + WS_RKV); const h16* LO = (const h16*)(ws + WS_LORAO); h16* V1 = (h16*)(ws + WS_V1ST); h16* AOUT = (h16*)(ws + WS_AOUT);
    const int wave = c.wave;
    LAS unsigned char* const slot = c.lds + wave * SLOT;
    for (int u = blockIdx.x; u < NB * 8; u += c.G) {
        const int b = u >> 3, h = u & 7; const int col0 = h * 64 + lane_id();
        const float mur = kin<I_MU>()[l * 1824 + col0], muk = kin<I_MU>()[l * 1824 + 512 + col0], muv = kin<I_MU>()[l * 1824 + 1024 + col0];
        const float kkw = kin<I_KK>()[l * 512 + col0], kaw = kin<I_KA>()[l * 512 + col0], rkw = kin<I_RK>()[l * 512 + col0];
        const float lng = kin<I_LNXG>()[l * 512 + col0], lnb = kin<I_LNXB>()[l * 512 + col0];
        f32x16 Sg[2]; h16x8 sfrag[4];
#pragma unroll
        for (int i = 0; i < 16; ++i) { Sg[0][i] = 0.f; Sg[1][i] = 0.f; }
#pragma unroll
        for (int i = 0; i < 4; ++i) sfrag[i] = (h16x8){0, 0, 0, 0, 0, 0, 0, 0};
        h16 wd[16], xr[2][8], xk[2][8], xv[2][8], xa[2][8], xg[2][8], xs[2][8], xf[2][8], pr_h, pk_h, pv_h;
#define SC_LOAD_HALF(hb, M0, COL) { _Pragma("unroll") for (int tt = 0; tt < 8; ++tt) { const size_t m = (M0) + 8 * (hb) + tt; const h16* q = RKV + m * NRKV + (COL); const h16* lp = LO + m * NLORA + (COL); \
                        xr[hb][tt] = q[0]; xk[hb][tt] = q[512]; xv[hb][tt] = q[1024]; xa[hb][tt] = lp[512]; xg[hb][tt] = lp[1024]; \
                        if (l != 0) { xs[hb][tt] = lp[1536]; xf[hb][tt] = V1[m * 512 + (COL)]; } else { xs[hb][tt] = (h16)0.f; xf[hb][tt] = (h16)0.f; } } }
#define SC_LOAD_FIRST(M0, HASPREV, COL) { _Pragma("unroll") for (int t = 0; t < 16; ++t) wd[t] = LO[((M0) + t) * NLORA + (COL)]; \
                        const h16* qprev = RKV + ((M0) - ((HASPREV) ? 1 : 0)) * NRKV + (COL); pr_h = qprev[0]; pk_h = qprev[512]; pv_h = qprev[1024]; SC_LOAD_HALF(0, M0, COL) }
        { const int colp = h * 64 + lane_id(); const size_t m0p = (size_t)b * SEQ + 16 * wave; SC_LOAD_FIRST(m0p, wave > 0, colp) }
#pragma unroll 1
        for (int ss = 0; ss < SEQ / 128; ++ss) {
            const int lane = lane_id(), n = lane & 31, hh = lane >> 5, col = h * 64 + lane;
            const int t0 = 128 * ss + 16 * wave; const size_t m0 = (size_t)b * SEQ + t0;
            unsigned g12[16];
            {
                float Pin[16], vv[16];
                const float zprev = (t0 > 0) ? 1.0f : 0.0f;
#pragma unroll
                for (int t = 0; t < 16; ++t) { const float wt = 1.0f - (float)wd[t]; Pin[t] = (t == 0) ? wt : Pin[t - 1] * wt; }
                const float P8 = Pin[7], iP8 = __builtin_amdgcn_rcpf(P8), P16 = Pin[15];
                const int q15 = lane & 15, pos = 16 * (lane >> 4) + 8 * ((q15 >> 2) & 1) + 4 * (q15 >> 3) + (q15 & 3);
                int xbL[8], xbP[8], xa4[4];
#pragma unroll
                for (int e = 0; e < 8; ++e) { xbL[e] = ((((2 * lane) >> 4) ^ e) << 4) | ((2 * lane) & 15); xbP[e] = ((((2 * pos) >> 4) ^ e) << 4) | ((2 * pos) & 15); }
#pragma unroll
                for (int e = 0; e < 4; ++e) xa4[e] = lane * 64 + ((e ^ ((lane >> 2) & 3)) << 4);
                {
                    float pr = (float)pr_h * zprev, pk = (float)pk_h * zprev, pv = (float)pv_h * zprev;
#pragma unroll
                    for (int hb = 0; hb < 2; ++hb) {
                    if (hb == 0) { SC_LOAD_HALF(1, m0, col) asm volatile("" ::: "memory"); }
#pragma unroll
                    for (int tt = 0; tt < 8; ++tt) {
                        const int t = 8 * hb + tt; const size_t m = m0 + t;
                        const float r0 = (float)xr[hb][tt], k0 = (float)xk[hb][tt], v0 = (float)xv[hb][tt];
                        const float aa = (float)xa[hb][tt], gg = (float)xg[hb][tt], sg = (float)xs[hb][tt];
                        const float r = r0 + (pr - r0) * mur, k = k0 + (pk - k0) * muk; float v = v0 + (pv - v0) * muv;
                        pr = r0; pk = k0; pv = v0;
                        if (l == 0) V1[m * 512 + col] = (h16)v; else { const float vf = (float)xf[hb][tt]; v = v + (vf - v) * sg; }
                        const float kkr = k * kkw, kpv = k * (1.0f + (aa - 1.0f) * kaw);
                        const float ssq = sum64u(kkr * kkr), bon = sum64u(r * kpv * rkw);
                        const float kn = kkr / fmaxf(sqrtf(ssq), 1e-12f), bt = kn * aa;
                        vv[t] = v; g12[t] = pkh(lng * gg, (lnb + bon * v) * gg);
                        const float iPt = __builtin_amdgcn_rcpf(Pin[t]);
                        const float gin = Pin[t] * iP8, pex = (t == 0) ? 1.0f : Pin[t - 1], gex = pex * iP8, ig = P8 * iPt, sfx = P16 * iPt;
                        *(LAS h16*)(slot + SL_WY + t * 128 + xbL[(t >> 1) & 7]) = (h16)(bt * ig);
                        *(LAS h16*)(slot + SL_WY + (16 + t) * 128 + xbL[(t >> 1) & 7]) = (h16)(kpv * ig);
                        *(LAS h16*)(slot + SL_WY + 4096 + t * 128 + xbL[(t >> 1) & 7]) = (h16)(kn * gex);
                        *(LAS h16*)(slot + SL_WY + 4096 + (16 + t) * 128 + xbL[(t >> 1) & 7]) = (h16)(r * gin);
                        *(LAS h16*)(slot + SL_A1 + t * 128 + xbP[(t >> 1) & 7]) = (h16)(kn * pex);
                        *(LAS h16*)(slot + SL_A1 + (16 + t) * 128 + xbP[(t >> 1) & 7]) = (h16)(r * Pin[t]);
                        const int ps = 8 * ((t >> 2) & 1) + 4 * (t >> 3) + (t & 3);
                        *(LAS h16*)(slot + SL_A4 + xa4[(2 * ps) >> 4] + ((2 * ps) & 15)) = (h16)(bt * sfx);
                        *(LAS h16*)(slot + SL_A4 + xa4[2 + ((2 * ps) >> 4)] + ((2 * ps) & 15)) = (h16)(kpv * sfx);
                    }
                    }
                }
                *(LAS float*)(slot + SL_P16 + 4 * lane) = P16;
                asm volatile("s_waitcnt lgkmcnt(0)" ::: "memory");
                f32x16 G;
#pragma unroll
                for (int i = 0; i < 16; ++i) G[i] = 0.f;
#pragma unroll
                for (int ks = 0; ks < 4; ++ks) { const h16x8 af = *(const LAS h16x8*)(slot + SL_WY + sw128(n, (16 * ks + 8 * hh) * 2)), bf = *(const LAS h16x8*)(slot + SL_WY + 4096 + sw128(n, (16 * ks + 8 * hh) * 2));
                    G = __builtin_amdgcn_mfma_f32_32x32x16_f16(af, bf, G, 0, 0, 0); }
                {
                    const int t = n & 15; const bool isR = n >= 16;
                    float top[8], bot[8];
#pragma unroll
                    for (int i = 0; i < 8; ++i) { const int ip = (i & 3) + 8 * (i >> 2) + 4 * hh; const bool keep = isR ? (ip <= t) : (ip < t);
                        top[i] = keep ? G[i] : 0.f; bot[i] = keep ? (isR ? G[8 + i] : -G[8 + i]) : 0.f; }
                    asm volatile("s_waitcnt lgkmcnt(0)" ::: "memory");
                    if (isR) *(LAS u32x4*)(slot + SL_A23 + sw32(n, 16 * hh)) = pk8(top[0], top[1], top[2], top[3], top[4], top[5], top[6], top[7]);
                    *(LAS u32x4*)(slot + SL_A5 + sw32(n, 16 * hh)) = pk8(bot[0], bot[1], bot[2], bot[3], bot[4], bot[5], bot[6], bot[7]);
                    {
                        const int r16 = lane & 15; float Tr[16];
#pragma unroll
                        for (int j = 0; j < 16; ++j) { float acc = (j == r16) ? 1.0f : 0.0f;
#pragma unroll
                            for (int i = 0; i < j; ++i) acc -= rl(top[(i & 3) + 4 * (i >> 3)], j + 32 * ((i >> 2) & 1)) * Tr[i];
                            Tr[j] = acc; }
                        const int ps2 = 2 * (8 * ((r16 >> 2) & 1) + 4 * (r16 >> 3) + (r16 & 3));
                        if (lane < 16) {
#pragma unroll
                            for (int t2 = 0; t2 < 16; ++t2) *(LAS h16*)(slot + SL_A23 + sw32(t2, ps2)) = (h16)Tr[t2];
                        }
                    }
                }
                *(LAS u32x4*)(slot + SL_VT + sw32(lane, 0)) = pk8(vv[0], vv[1], vv[2], vv[3], vv[8], vv[9], vv[10], vv[11]);
                *(LAS u32x4*)(slot + SL_VT + sw32(lane, 16)) = pk8(vv[4], vv[5], vv[6], vv[7], vv[12], vv[13], vv[14], vv[15]);
                asm volatile("s_waitcnt lgkmcnt(0)" ::: "memory");
                {
                    const h16x8 a5 = *(const LAS h16x8*)(slot + SL_A5 + sw32(n, 16 * hh));
#pragma unroll
                    for (int vt = 0; vt < 2; ++vt) { const h16x8 vf = *(const LAS h16x8*)(slot + SL_VT + sw32(32 * vt + n, 16 * hh));
                        f32x16 Wm;
#pragma unroll
                        for (int i = 0; i < 16; ++i) Wm[i] = 0.f;
                        Wm = __builtin_amdgcn_mfma_f32_32x32x16_f16(a5, vf, Wm, 0, 0, 0);
                        *(LAS u32x4*)(slot + SL_WY + vt * 2048 + sw32(lane, 0)) = pk8(Wm[0], Wm[1], Wm[2], Wm[3], Wm[4], Wm[5], Wm[6], Wm[7]);
                        *(LAS u32x4*)(slot + SL_WY + vt * 2048 + sw32(lane, 16)) = pk8(Wm[8], Wm[9], Wm[10], Wm[11], Wm[12], Wm[13], Wm[14], Wm[15]); }
                }
            }
            __syncthreads();
            if (wave < 2) {
                const int vt = wave;
#pragma unroll 1
                for (int j = 0; j < 8; ++j) {
                    const LAS unsigned char* sb = c.lds + j * SLOT;
                    h16x8 a1[4], a4[2][2];
#pragma unroll
                    for (int ks = 0; ks < 4; ++ks) a1[ks] = *(const LAS h16x8*)(sb + SL_A1 + sw128(n, (16 * ks + 8 * hh) * 2));
                    const u32x4 wy0 = *(const LAS u32x4*)(sb + SL_WY + vt * 2048 + sw32(lane, 0)), wy1 = *(const LAS u32x4*)(sb + SL_WY + vt * 2048 + sw32(lane, 16));
                    const h16x8 a23 = *(const LAS h16x8*)(sb + SL_A23 + sw32(n, 16 * hh));
#pragma unroll
                    for (int kt = 0; kt < 2; ++kt)
#pragma unroll
                        for (int s2 = 0; s2 < 2; ++s2) a4[kt][s2] = *(const LAS h16x8*)(sb + SL_A4 + sw64(32 * kt + n, 32 * s2 + 16 * hh));
                    const h16x8 vf = *(const LAS h16x8*)(sb + SL_VT + sw32(32 * vt + n, 16 * hh));
                    f32x16 D1;
#pragma unroll
                    for (int i = 0; i < 16; ++i) D1[i] = 0.f;
#pragma unroll
                    for (int ks = 0; ks < 4; ++ks) D1 = __builtin_amdgcn_mfma_f32_32x32x16_f16(a1[ks], sfrag[ks], D1, 0, 0, 0);
                    const float w0v[8] = {hlo(wy0.x), hhi(wy0.x), hlo(wy0.y), hhi(wy0.y), hlo(wy0.z), hhi(wy0.z), hlo(wy0.w), hhi(wy0.w)};
                    const float y0v[8] = {hlo(wy1.x), hhi(wy1.x), hlo(wy1.y), hhi(wy1.y), hlo(wy1.z), hhi(wy1.z), hlo(wy1.w), hhi(wy1.w)};
                    const u32x4 ubw = pk8(w0v[0] - D1[0], w0v[1] - D1[1], w0v[2] - D1[2], w0v[3] - D1[3], w0v[4] - D1[4], w0v[5] - D1[5], w0v[6] - D1[6], w0v[7] - D1[7]);
                    f32x16 D2;
#pragma unroll
                    for (int i = 0; i < 16; ++i) D2[i] = 0.f;
                    D2 = __builtin_amdgcn_mfma_f32_32x32x16_f16(a23, __builtin_bit_cast(h16x8, ubw), D2, 0, 0, 0);
                    const h16x8 uf = __builtin_bit_cast(h16x8, pk8(D2[0], D2[1], D2[2], D2[3], D2[4], D2[5], D2[6], D2[7]));
                    D1 = __builtin_amdgcn_mfma_f32_32x32x16_f16(a23, uf, D1, 0, 0, 0);
#pragma unroll
                    for (int kt = 0; kt < 2; ++kt) {
                        f32x4 p16[4];
#pragma unroll
                        for (int g = 0; g < 4; ++g) p16[g] = *(const LAS f32x4*)(sb + SL_P16 + (32 * kt + 8 * g + 4 * hh) * 4);
#pragma unroll
                        for (int i = 0; i < 16; ++i) Sg[kt][i] *= p16[i >> 2][i & 3];
                        Sg[kt] = __builtin_amdgcn_mfma_f32_32x32x16_f16(a4[kt][0], uf, Sg[kt], 0, 0, 0);
                        Sg[kt] = __builtin_amdgcn_mfma_f32_32x32x16_f16(a4[kt][1], vf, Sg[kt], 0, 0, 0);
                    }
                    LAS float* yo = (LAS float*)(c.lds + j * SLOT + SL_WY + vt * 2048);
#pragma unroll
                    for (int i = 0; i < 8; ++i) { const int t = (i & 3) + 8 * (i >> 2) + 4 * hh; yo[t * 32 + n] = D1[8 + i] + y0v[i]; }
#pragma unroll
                    for (int kt = 0; kt < 2; ++kt)
#pragma unroll
                        for (int s = 0; s < 2; ++s) sfrag[2 * kt + s] = __builtin_bit_cast(h16x8, pk8(Sg[kt][8 * s], Sg[kt][8 * s + 1], Sg[kt][8 * s + 2], Sg[kt][8 * s + 3], Sg[kt][8 * s + 4], Sg[kt][8 * s + 5], Sg[kt][8 * s + 6], Sg[kt][8 * s + 7]));
                }
            }
            __syncthreads();
            {
                const LAS float* yi = (const LAS float*)(slot + SL_WY + hh * 2048);
                { const size_t m0n = (ss + 1 < SEQ / 128) ? m0 + 128 : m0; SC_LOAD_FIRST(m0n, true, col) asm volatile("" ::: "memory"); }
                float yv[16];
#pragma unroll
                for (int t = 0; t < 16; ++t) yv[t] = yi[t * 32 + n];
#pragma unroll
                for (int t = 0; t < 16; ++t) {
                    const float mean = sum64u(yv[t]) * (1.0f / 64.0f), dv = yv[t] - mean, var = sum64u(dv * dv) * (1.0f / 64.0f);
                    const float o = dv * rsqrtf(var + LNX_EPS) * hlo(g12[t]) + hhi(g12[t]);
                    AOUT[(m0 + t) * KOUT + 512 + col] = (h16)o;
                }
            }
            asm volatile("s_waitcnt lgkmcnt(0)" ::: "memory");
        }
        __syncthreads();
    }
}

constexpr int STEPS_PER_LAYER = 10, NSTEPS = 2 + NL * STEPS_PER_LAYER;
#define IN(k) (lo <= (k) && (k) < hi)
#define SEAM(k) do { if (IN(k) && IN((k) + 1)) xcd_barrier(bar, c.wave); } while (0)
template <int l>
DI void layer_steps(const Params& p, const Ctx& c, const XcdBarrier& bar, const int lo, const int hi) {
        const int s0 = 2 + l * STEPS_PER_LAYER;
        if (IN(s0 + 0)) { unsigned char* const ws = kws();
            pg8::Gemm g{(const h16*)(ws + WS_H), (const h16*)(ws + wofs(l) + WT_IN), MT, NIN, DM, DM, DM}; pg8::StaticOrder S; S.init(MT, NIN, c.G, (int)blockIdx.x);
            pg8::EpiH16 E{(h16*)(ws + WS_COLSA), NCA, 3, (h16*)(ws + WS_RKV), NRKV};
            pg8::gemm_phase(c.lds, g, S, E, c.wave);
            if (l + 1 < NL && c.G > NB * 8 && blockIdx.x >= NB * 8) { __syncthreads(); Ctx c2 = c; c2.gw = (blockIdx.x - NB * 8) * 8 + c.wave; c2.ngw = (c.G - NB * 8) * 8; phase_wconv(p, c2, l + 1, 1); }
        }
        SEAM(s0 + 0);
        if (IN(s0 + 1)) phase_prep(p, c, l);
        SEAM(s0 + 1);
        if (IN(s0 + 2)) { unsigned char* const ws = kws();
            { pg8::Gemm g{(const h16*)(ws + WS_CQ), (const h16*)(ws + wofs(l) + WT_Q), MT, NQ, 256, 256, 256}; pg8::StaticOrder S; S.init(MT, NQ, c.G, (int)blockIdx.x);
              pg8::EpiQ E{(h16*)kout()};
              pg8::gemm_phase(c.lds, g, S, E, c.wave); }
            {
              pg8::Gemm g{(const h16*)(ws + WS_ALORA), (const h16*)(ws + wofs(l) + WT_LORA), MT, 1024, 128, KLORA, 128}; pg8::StaticOrder S; S.init(MT, 1024, c.G, (int)blockIdx.x);
              pg8::EpiLora E{(h16*)(ws + WS_LORAO), kin<I_W0>() + l * 512, kin<I_A0>() + l * 512, kin<I_V0>() + (l > 0 ? l - 1 : 0) * 512, l > 0 ? 1 : 0, 0};
              pg8::gemm_phase(c.lds, g, S, E, c.wave); }
            {
              constexpr int N2 = (l > 0) ? 1024 : 512;
              pg8::Gemm g{(const h16*)(ws + WS_ALORA) + 128, (const h16*)(ws + wofs(l) + WT_LORA) + 1024 * 128, MT, N2, 256, KLORA, 256}; pg8::StaticOrder S; S.init(MT, N2, c.G, (int)blockIdx.x);
              pg8::EpiLora E{(h16*)(ws + WS_LORAO), kin<I_W0>() + l * 512, kin<I_A0>() + l * 512, kin<I_V0>() + (l > 0 ? l - 1 : 0) * 512, l > 0 ? 1 : 0, 4};
              pg8::gemm_phase(c.lds, g, S, E, c.wave); }
        }
        SEAM(s0 + 2);
        if (IN(s0 + 3)) { unsigned char* const ws = kws(); if (blockIdx.x < NB * 8) { phase_scan2(p, c, l); __syncthreads(); }
            else if (l + 1 < NL) { Ctx c2 = c; c2.gw = (blockIdx.x - NB * 8) * 8 + c.wave; c2.ngw = (c.G - NB * 8) * 8; phase_wconv(p, c2, l + 1, 2); __syncthreads(); }
            phase_select(p, c, (unsigned*)(ws + WS_CTL) + 8192 + 64 * l); }
        SEAM(s0 + 3);
        if (IN(s0 + 4)) { unsigned char* const ws = kws(); phase_attn(p, c, (unsigned*)(ws + WS_CTL) + 8192 + 64 * l + 16, l); }
        SEAM(s0 + 4);
        if (IN(s0 + 5)) { unsigned char* const ws = kws();
            pg8::Gemm g{(const h16*)(ws + WS_AOUT), (const h16*)(ws + wofs(l) + WT_OUT), MT, DM, KOUT, KOUT, KOUT}; pg8::StaticOrder S; S.init(MT, DM, c.G, (int)blockIdx.x);
            pg8::EpiH16 E{(h16*)(ws + WS_Y), DM, 1000, nullptr, 0};
            pg8::gemm_phase(c.lds, g, S, E, c.wave);
        }
        SEAM(s0 + 5);
        if (IN(s0 + 6)) phase_rows<1, true, false>(p, c, (const h16*)(kws() + WS_Y), kin<I_POSTMIX>() + l * DM, 2048, l, kin<I_PREFFN>() + l * DM, 3072, 4096, l, -1);
        SEAM(s0 + 6);
        if (IN(s0 + 7)) { unsigned char* const ws = kws();
            pg8::Gemm g{(const h16*)(ws + WS_H), (const h16*)(ws + wofs(l) + WT_FC), MT, NFC, DM, DM, DM}; pg8::StaticOrder S; S.init(MT, NFC, c.G, (int)blockIdx.x);
            pg8::EpiSwiglu E{(h16*)(ws + WS_HID)};
            pg8::gemm_phase(c.lds, g, S, E, c.wave);
        }
        SEAM(s0 + 7);
        if (IN(s0 + 8)) { unsigned char* const ws = kws();
            pg8::Gemm g{(const h16*)(ws + WS_HID), (const h16*)(ws + wofs(l) + WT_DOWN), MT, DM, DFF, DFF, DFF}; pg8::StaticOrder S; S.init(MT, DM, c.G, (int)blockIdx.x);
            pg8::EpiH16 E{(h16*)(ws + WS_Y2), DM, 1000, nullptr, 0};
            pg8::gemm_phase(c.lds, g, S, E, c.wave);
        }
        SEAM(s0 + 8);
        if (IN(s0 + 9)) { unsigned char* const ws = kws();
            if (l + 1 < NL) { phase_rows<1, true, true>(p, c, (const h16*)(ws + WS_Y2), kin<I_POSTFFN>() + l * DM, 5120, l, kin<I_PREMIX>() + (l + 1) * DM, 0, 1024, l + 1, l + 1);
                              if (c.G <= NB * 8) { __syncthreads(); phase_wconv(p, c, l + 1); } }
            else phase_rows<1, false, false>(p, c, (const h16*)(ws + WS_Y2), kin<I_POSTFFN>() + l * DM, 5120, l, nullptr, 0, 0, 0, -1);
        }
        SEAM(s0 + 9);
    }
#undef IN
#undef SEAM

__global__ void __launch_bounds__(NTHR, 2) fwd_kernel(Params p) {
    extern __shared__ __attribute__((aligned(16))) unsigned char lds_raw[];
    Ctx c; c.lds = (LAS unsigned char*)lds_raw; c.wave = __builtin_amdgcn_readfirstlane((int)threadIdx.x >> 6);
    c.G = gridDim.x; c.gw = blockIdx.x * 8 + c.wave; c.ngw = c.G * 8;
    volatile LAS unsigned* misc = (volatile LAS unsigned*)(c.lds + LDS_MISC);
    if (c.wave == 0) misc[lane_id()] = 0u;
    __syncthreads();
    unsigned* ctl = (unsigned*)(kws() + WS_CTL);
    XcdBarrier bar; bar.bar = ctl; bar.x = 0; bar.st = nullptr;
    const bool multi = (p.step_hi - p.step_lo) > 1;
    if (multi) bar = xcd_barrier_post(ctl, misc + 8, c.wave);
    const int lo = p.step_lo, hi = p.step_hi;
#define IN(k) (lo <= (k) && (k) < hi)
#define SEAM(k) do { if (IN(k) && IN((k) + 1)) xcd_barrier(bar, c.wave); } while (0)

    if (IN(0)) { phase_mod(p, c); __syncthreads(); phase_wconv(p, c, 0); }
    SEAM(0);
    if (IN(1)) phase_rows<0, true, true>(p, c, nullptr, nullptr, 0, 0, kin<I_PREMIX>(), 0, 1024, 0, 0);
    SEAM(1);
    layer_steps<0>(p, c, bar, lo, hi);
    layer_steps<1>(p, c, bar, lo, hi);
    layer_steps<2>(p, c, bar, lo, hi);
    layer_steps<3>(p, c, bar, lo, hi);
#undef IN
#undef SEAM
}

extern "C" void kernel_launch(void* const* d_in, const int* in_sizes, int n_in, void* d_out, int out_size, void* d_ws, size_t ws_size, hipStream_t stream) {
    static int grid = 0;
    if (grid == 0) {
        if (n_in != 35 || out_size != MT * DM || ws_size < WS_NEED) { fprintf(stderr, "kernel_launch: unexpected problem (n_in %d out %d ws %zu)\n", n_in, out_size, ws_size); grid = -1; return; }
        int dev = 0, cus = 0, per_cu = 0;
        if (hipGetDevice(&dev) != hipSuccess || hipDeviceGetAttribute(&cus, hipDeviceAttributeMultiprocessorCount, dev) != hipSuccess) { grid = -1; return; }
        if (hipFuncSetAttribute((const void*)fwd_kernel, hipFuncAttributeMaxDynamicSharedMemorySize, LDS_BYTES) != hipSuccess) { fprintf(stderr, "kernel_launch: hipFuncSetAttribute failed\n"); grid = -1; return; }
        if (hipOccupancyMaxActiveBlocksPerMultiprocessor(&per_cu, (const void*)fwd_kernel, NTHR, LDS_BYTES) != hipSuccess || per_cu < 1) { fprintf(stderr, "kernel_launch: occupancy query says %d\n", per_cu); (void)hipGetLastError(); per_cu = 1; }
        grid = cus;
        if (grid > 256) grid = 256;
    }
    if (grid < 0) return;
    (void)hipMemsetAsync((char*)d_ws + WS_CTL, 0, CTL_BYTES, stream);
    Params p{};
    for (int i = 0; i < 35; ++i) p.in[i] = (const float*)d_in[i];
    p.out = (float*)d_out; p.ws = (unsigned char*)d_ws;
#if MK_PER_STEP_LAUNCH
    for (int s = 0; s < NSTEPS; ++s) { p.step_lo = s; p.step_hi = s + 1; hipLaunchKernelGGL(fwd_kernel, dim3(grid), dim3(NTHR), LDS_BYTES, stream, p); }
#else
    p.step_lo = 0; p.step_hi = NSTEPS;
    hipLaunchKernelGGL(fwd_kernel, dim3(grid), dim3(NTHR), LDS_BYTES, stream, p);
#endif
}
```

```cpp
#include <hip/hip_runtime.h>
#include <cstdio>
#include <cstdint>

#ifndef MK_PER_STEP_LAUNCH
#define MK_PER_STEP_LAUNCH 0
#endif

#define DI __device__ __forceinline__
#define LAS __attribute__((address_space(3)))
typedef _Float16 h16;
typedef h16 h16x8 __attribute__((ext_vector_type(8)));
typedef h16 h16x4 __attribute__((ext_vector_type(4)));
typedef h16 h16x2 __attribute__((ext_vector_type(2)));
typedef float f32x2 __attribute__((ext_vector_type(2)));
typedef float f32x4 __attribute__((ext_vector_type(4)));
typedef float f32x16 __attribute__((ext_vector_type(16)));
typedef unsigned u32x2 __attribute__((ext_vector_type(2)));
typedef unsigned u32x4 __attribute__((ext_vector_type(4)));

constexpr int NB = 16, SEQ = 2048, DM = 1024, NL = 4, MT = NB * SEQ;
constexpr int PIN = 2276;
constexpr int NCA = 768, NRKV = 1536, NIN = NCA + NRKV;
constexpr int NQ = 1280, KLORA = 384, NLORA = 2048, KOUT = 1024, NFC = 5632, DFF = 2816;
constexpr float NORM_EPS = 1e-6f, LNX_EPS = 64e-5f;

constexpr size_t MiB = 1u << 20;
constexpr size_t WS_CTL = 0, CTL_BYTES = 64 * 1024;
constexpr size_t WS_MOD = 1 * MiB;
constexpr size_t WS_WIDX = 3 * MiB;
constexpr size_t WS_KIDX = 4 * MiB;
constexpr size_t WS_CKV = 8 * MiB;
constexpr size_t WS_CKVT = 16 * MiB;
constexpr size_t WS_V1ST = 24 * MiB;
constexpr size_t WS_WTS = 56 * MiB;
constexpr size_t WT_IN = WS_WTS, WT_Q = WT_IN + (size_t)NIN * DM * 2, WT_LORA = WT_Q + (size_t)NQ * 256 * 2, WT_OUT = WT_LORA + (size_t)NLORA * KLORA * 2,
                 WT_VUP = WT_OUT + (size_t)DM * KOUT * 2  , WT_FC = WT_OUT + (size_t)DM * 1536 * 2, WT_DOWN = WT_FC + (size_t)NFC * DM * 2, WT_END = WT_DOWN + (size_t)DM * DFF * 2;
static_assert(WT_END <= 84 * MiB, "weights region");
constexpr size_t WS_H = 84 * MiB;
constexpr size_t WS_CQ = 148 * MiB;
constexpr size_t WS_ALORA = 164 * MiB;
constexpr size_t WS_AOUT = 84 * MiB;
constexpr size_t WS_RKV = 188 * MiB;
constexpr size_t WS_COLSA = 284 * MiB;
constexpr size_t WS_LORAO = 284 * MiB;
constexpr size_t WS_X16 = 412 * MiB;
constexpr size_t WS_Y = 188 * MiB;
constexpr size_t WS_HID = 188 * MiB;
constexpr size_t WS_Y2 = 84 * MiB;
constexpr size_t WS_MASK = 476 * MiB;
constexpr size_t WS_WTS2 = 484 * MiB;
constexpr size_t WS_NEED = 484 * MiB + (84 - 56) * MiB;
DI size_t wofs(int l) { return (l & 1) ? (WS_WTS2 - WS_WTS) : 0; }

constexpr int LDS_BYTES = 147456;
constexpr int LDS_MISC = LDS_BYTES - 256;
constexpr int NTHR = 512;

DI unsigned pkh(float a, float b) { h16x2 v; v.x = (h16)a; v.y = (h16)b; return __builtin_bit_cast(unsigned, v); }
DI unsigned pkb(float lo, float hi) { unsigned r; asm("v_cvt_pk_bf16_f32 %0, %1, %2" : "=v"(r) : "v"(lo), "v"(hi)); return r; }
DI float hlo(unsigned u) { h16x2 v = __builtin_bit_cast(h16x2, u); return (float)v.x; }
DI float hhi(unsigned u) { h16x2 v = __builtin_bit_cast(h16x2, u); return (float)v.y; }
DI float h2f(unsigned short s) { return (float)__builtin_bit_cast(h16, s); }
DI unsigned short f2h(float f) { return __builtin_bit_cast(unsigned short, (h16)f); }
template <int CTRL> DI float dppf(float x) { return __builtin_bit_cast(float, __builtin_amdgcn_update_dpp(0, __builtin_bit_cast(int, x), CTRL, 0xf, 0xf, false)); }
template <int CTRL> DI unsigned dppu(unsigned x) { return (unsigned)__builtin_amdgcn_update_dpp(0, (int)x, CTRL, 0xf, 0xf, false); }
DI float sum4(float x) { x += dppf<0xB1>(x); x += dppf<0x4E>(x); return x; }
DI float sum8(float x) { x = sum4(x); x += dppf<0x141>(x); return x; }
DI float sum16(float x) { x = sum8(x); x += dppf<0x140>(x); return x; }
DI unsigned usum16(unsigned x) { x += dppu<0xB1>(x); x += dppu<0x4E>(x); x += dppu<0x141>(x); x += dppu<0x140>(x); return x; }
DI float sum64(float x) { x = sum16(x); x += __shfl_xor(x, 16); x += __shfl_xor(x, 32); return x; }
DI int lane_id() { int l; asm volatile("v_mbcnt_lo_u32_b32 %0, -1, 0\n\tv_mbcnt_hi_u32_b32 %0, -1, %0" : "=v"(l)); return l; }
DI float sigmoidf_(float z) { return 1.0f / (1.0f + __expf(-z)); }

#define XB_TMO      128
#define XB_XCNT(j)  (256  + 64 * (j))
#define XB_XSUB(j)  (1280 + 64 * (j))
#define XB_XGEN(j)  (2304 + 64 * (j))
#define XB_TOP      3328
#define XB_TOPGEN   3392
#define XCD_BAR_WORDS 3456
#define XB_SPIN_CAP (1u << 18)
DI unsigned xb_ld(unsigned* p)              { return __hip_atomic_load(p, __ATOMIC_RELAXED, __HIP_MEMORY_SCOPE_AGENT); }
DI unsigned xb_add(unsigned* p, unsigned v) { return __hip_atomic_fetch_add(p, v, __ATOMIC_RELAXED, __HIP_MEMORY_SCOPE_AGENT); }
DI unsigned xb_xcc_id() { return (unsigned)__builtin_amdgcn_s_getreg((3 << 11) | 20) & 0xFu; }
#define XB_SPIN(cond, bar) do { unsigned _sp = 0; while (cond) { __builtin_amdgcn_s_sleep(1); \
    if ((++_sp & 255u) == 0u) { if (xb_ld(&(bar)[XB_TMO])) break; if (_sp > XB_SPIN_CAP) { atomicAdd(&(bar)[XB_TMO], 1u); break; } } } } while (0)
struct XcdBarrier { unsigned* bar; unsigned x; volatile LAS unsigned* st; };
DI XcdBarrier xcd_barrier_post(unsigned* bar, volatile LAS unsigned* st, int wave) {
    XcdBarrier b; b.bar = bar; b.x = xb_xcc_id(); b.st = st;
    if (wave == 0 && lane_id() == 0) (void)xb_add(&bar[XB_XCNT(b.x)], 1u);
    return b;
}
DI void xcd_barrier_complete(unsigned* bar, unsigned x, unsigned& nloc, unsigned& nx) {
    const unsigned G = gridDim.x * gridDim.y * gridDim.z;
    unsigned sum, cnt, mine, sp = 0u;
    for (;;) {
        sum = 0u; cnt = 0u; mine = 0u;
#pragma unroll
        for (unsigned j = 0; j < 16; ++j) { const unsigned c = xb_ld(&bar[XB_XCNT(j)]); sum += c; cnt += (c > 0u) ? 1u : 0u; mine = (j == x) ? c : mine; }
        if (sum == G) break;
        __builtin_amdgcn_s_sleep(1);
        if ((++sp & 255u) == 0u) { if (xb_ld(&bar[XB_TMO])) break; if (sp > XB_SPIN_CAP) { atomicAdd(&bar[XB_TMO], 1u); break; } }
    }
    nloc = mine > 0u ? mine : 1u; nx = cnt > 0u ? cnt : 1u;
}
DI void xcd_barrier(const XcdBarrier& b, int wave) {
    asm volatile("s_waitcnt vmcnt(0)" ::: "memory");
    __syncthreads();
    if (wave == 0 && lane_id() == 0) {
        unsigned* bar = b.bar;
        __builtin_amdgcn_s_waitcnt(0);
        unsigned nloc = b.st[0], nx = b.st[1];
        if (nloc == 0u) { xcd_barrier_complete(bar, b.x, nloc, nx); b.st[0] = nloc; b.st[1] = nx; }
        const unsigned old = xb_add(&bar[XB_XSUB(b.x)], 1u);
        const unsigned gen = old / nloc;
        if (old + 1u == (gen + 1u) * nloc) {
            __builtin_amdgcn_fence(__ATOMIC_RELEASE, "agent");
            asm volatile("s_waitcnt vmcnt(0)" ::: "memory");
            const unsigned og = xb_add(&bar[XB_TOP], 1u);
            const unsigned tg = og / nx;
            if (og + 1u == (tg + 1u) * nx) xb_add(&bar[XB_TOPGEN], 1u);
            else XB_SPIN(xb_ld(&bar[XB_TOPGEN]) == tg, bar);
            __builtin_amdgcn_fence(__ATOMIC_ACQUIRE, "agent");
            xb_add(&bar[XB_XGEN(b.x)], 1u);
            asm volatile("s_waitcnt vmcnt(0)" ::: "memory");
        } else {
            XB_SPIN(xb_ld(&bar[XB_XGEN(b.x)]) == gen, bar);
            __builtin_amdgcn_fence(__ATOMIC_ACQUIRE, "agent");
            asm volatile("s_waitcnt vmcnt(0)" ::: "memory");
        }
    }
    __syncthreads();
}

namespace pg8 {
constexpr int BM = 256, BK = 64, HALF = 128, HTB = HALF * BK * 2, STAGE_BYTES = 8 * HTB, NXCD = 8, WGM = 8;
DI int lds_byte(int r, int c) { const int st = (r >> 4) * 2 + (c >> 5), rr = r & 15, cc = c & 31, ob = rr * 64 + cc * 2; return st * 1024 + (ob ^ (((ob >> 9) & 1) << 5)); }
DI void stage_rc(int b, int& R, int& C) { const int st = b / 1024, sb = b % 1024, swz = sb ^ (((sb >> 9) & 1) << 5); R = (st >> 1) * 16 + swz / 64; C = (st & 1) * 32 + (swz % 64) / 2; }
DI int perm32(int rho) { const int n = rho >> 4, i = rho & 15; return 8 * (i >> 2) + 4 * n + (i & 3); }
struct Unit { int pm, pn; };
struct Gemm { const h16* A; const h16* Bt; int M, N, K, lda, ldb; };
struct StaticOrder {
    int nM, nN, nwg, G, c;
    DI void init(int M, int N, int G_, int c_) { nM = M / BM; nN = N / BM; nwg = nM * nN; G = G_; c = c_; }
    DI bool next(int i, Unit& u) const {
        const long L = (long)i * G + c; if (L >= nwg) return false;
        int wgid = (int)L; { const int q = nwg / NXCD, r = nwg % NXCD, xcd = wgid % NXCD, off = wgid / NXCD; wgid = (xcd < r ? xcd * (q + 1) : r * (q + 1) + (xcd - r) * q) + off; }
        const int nig = WGM * nN, gid = wgid / nig, fm = gid * WGM, gsz = (nM - fm) < WGM ? (nM - fm) : WGM;
        u.pm = fm + ((wgid % nig) % gsz); u.pn = (wgid % nig) / gsz; return true;
    }
};
struct EpiF32 {
    static constexpr bool PERM = false;
    float* C; int ldc;
    DI void operator()(const f32x4 (&acc)[2][2][4][2], const Unit& u, int wr, int wc, int fr, int fq) const {
        const int row0 = u.pm * BM + wr * 64 + fr, col0 = u.pn * BM + wc * 32 + 4 * fq;
#pragma unroll
        for (int ai = 0; ai < 2; ++ai)
#pragma unroll
            for (int m = 0; m < 4; ++m) { float* rowp = C + (size_t)(row0 + ai * HALF + m * 16) * ldc + col0;
#pragma unroll
                for (int bj = 0; bj < 2; ++bj)
#pragma unroll
                    for (int n = 0; n < 2; ++n) *(f32x4*)(rowp + bj * HALF + n * 16) = acc[ai][bj][m][n]; }
    }
};
struct EpiH16 {
    static constexpr bool PERM = true;
    h16* O0; int ld0; int nsplit; h16* O1; int ld1;
    DI void operator()(const f32x4 (&acc)[2][2][4][2], const Unit& u, int wr, int wc, int fr, int fq) const {
        const int row0 = u.pm * BM + wr * 64 + fr;
        h16* base; int ld, colt;
        if (u.pn < nsplit) { base = O0; ld = ld0; colt = u.pn * BM; } else { base = O1; ld = ld1; colt = (u.pn - nsplit) * BM; }
        const int col0 = colt + wc * 32 + 8 * fq;
#pragma unroll
        for (int ai = 0; ai < 2; ++ai)
#pragma unroll
            for (int m = 0; m < 4; ++m) { h16* rowp = base + (size_t)(row0 + ai * HALF + m * 16) * ld + col0;
#pragma unroll
                for (int bj = 0; bj < 2; ++bj) { const f32x4 v0 = acc[ai][bj][m][0], v1 = acc[ai][bj][m][1];
                    u32x4 w; w.x = pkh(v0[0], v0[1]); w.y = pkh(v0[2], v0[3]); w.z = pkh(v1[0], v1[1]); w.w = pkh(v1[2], v1[3]);
                    *(u32x4*)(rowp + bj * HALF) = w; } }
    }
};
struct EpiQ {
    static constexpr bool PERM = true;
    h16* O;
    DI void operator()(const f32x4 (&acc)[2][2][4][2], const Unit& u, int wr, int wc, int fr, int fq) const {
        const int row0 = u.pm * BM + wr * 64 + fr, col0 = u.pn * BM + wc * 32 + 8 * fq; const bool bf = u.pn < 4;
#pragma unroll
        for (int ai = 0; ai < 2; ++ai)
#pragma unroll
            for (int m = 0; m < 4; ++m) { h16* rowp = O + (size_t)(row0 + ai * HALF + m * 16) * NQ + col0;
#pragma unroll
                for (int bj = 0; bj < 2; ++bj) { const f32x4 v0 = acc[ai][bj][m][0], v1 = acc[ai][bj][m][1]; u32x4 w;
                    if (bf) { w.x = pkb(v0[0], v0[1]); w.y = pkb(v0[2], v0[3]); w.z = pkb(v1[0], v1[1]); w.w = pkb(v1[2], v1[3]); }
                    else { w.x = pkh(v0[0], v0[1]); w.y = pkh(v0[2], v0[3]); w.z = pkh(v1[0], v1[1]); w.w = pkh(v1[2], v1[3]); }
                    *(u32x4*)(rowp + bj * HALF) = w; } }
    }
};
struct EpiLora {
    static constexpr bool PERM = true;
    h16* O; const float* w0; const float* a0; const float* v0; int has_v; int pn_off;
    DI void operator()(const f32x4 (&acc)[2][2][4][2], const Unit& u, int wr, int wc, int fr, int fq) const {
        const int pnt = u.pn + pn_off; const int row0 = u.pm * BM + wr * 64 + fr; const int type = pnt >> 1;
        const int col0 = pnt * BM + wc * 32 + 8 * fq, j0 = (pnt & 1) * BM + wc * 32 + 8 * fq;
        float bias[2][8];
#pragma unroll
        for (int bj = 0; bj < 2; ++bj)
#pragma unroll
            for (int e = 0; e < 8; ++e) { const int j = j0 + bj * HALF + e; bias[bj][e] = type == 0 ? w0[j] : type == 1 ? a0[j] : (type == 3 && has_v) ? v0[j] : 0.f; }
#pragma unroll
        for (int ai = 0; ai < 2; ++ai)
#pragma unroll
            for (int m = 0; m < 4; ++m) { h16* rowp = O + (size_t)(row0 + ai * HALF + m * 16) * NLORA + col0;
#pragma unroll
                for (int bj = 0; bj < 2; ++bj) { float v[8];
#pragma unroll
                    for (int e = 0; e < 8; ++e) { const float z = acc[ai][bj][m][e >> 2][e & 3] + bias[bj][e];
                        float o;
                        if (type == 0) { const float ee = 0.6065306597126334f * sigmoidf_(z); o = 1.0f - __expf(-ee); }
                        else if (type == 2) o = z;
                        else o = sigmoidf_(z);
                        v[e] = o; }
                    u32x4 w; w.x = pkh(v[0], v[1]); w.y = pkh(v[2], v[3]); w.z = pkh(v[4], v[5]); w.w = pkh(v[6], v[7]);
                    *(u32x4*)(rowp + bj * HALF) = w; asm volatile("" ::: "memory"); } }
    }
};
struct EpiSwiglu {
    static constexpr bool PERM = true;
    h16* O;
    DI void operator()(const f32x4 (&acc)[2][2][4][2], const Unit& u, int wr, int wc, int fr, int fq) const {
        const int row0 = u.pm * BM + wr * 64 + fr, col0 = u.pn * HALF + wc * 32 + 8 * fq;
#pragma unroll
        for (int ai = 0; ai < 2; ++ai)
#pragma unroll
            for (int m = 0; m < 4; ++m) { h16* rowp = O + (size_t)(row0 + ai * HALF + m * 16) * DFF + col0; float v[8];
#pragma unroll
                for (int e = 0; e < 8; ++e) { const float g = acc[ai][0][m][e >> 2][e & 3], up = acc[ai][1][m][e >> 2][e & 3]; v[e] = g * sigmoidf_(g) * up; }
                u32x4 w; w.x = pkh(v[0], v[1]); w.y = pkh(v[2], v[3]); w.z = pkh(v[4], v[5]); w.w = pkh(v[6], v[7]);
                *(u32x4*)rowp = w; }
    }
};

template <class Epi>
DI void gemm_phase(LAS unsigned char* lds, const Gemm g, const StaticOrder& S, const Epi& E, const int wid) {
    const int lane = lane_id(), tid = wid * 64 + lane, wr = wid >> 2, wc = wid & 3, fr = lane & 15, fq = lane >> 4;
    const int K = g.K, nt = K / BK;
    unsigned voffA[2], voffB[2];
#pragma unroll
    for (int i = 0; i < 2; ++i) { int R, C; stage_rc(tid * 16 + i * 8192, R, C); const int Rb = Epi::PERM ? ((R & ~31) + perm32(R & 31)) : R;
        voffA[i] = (unsigned)(R * g.lda + C) * 2u; voffB[i] = (unsigned)(Rb * g.ldb + C) * 2u; }
    const size_t kstep = (size_t)(BK * 2);
    const size_t hstepA = (size_t)HALF * g.lda * 2, hstepB = (size_t)HALF * g.ldb * 2;
    const size_t tstepA = 2 * hstepA, tstepB = 2 * hstepB;
    const unsigned ldsw = (unsigned)wid * 1024u;
    const int aoff = lds_byte(wr * 64 + fr, fq * 8), boff = lds_byte(wc * 32 + fr, fq * 8);
#define PG8_SA(b, h) (((b) * 2 + (h)) * HTB)
#define PG8_SB(b, h) ((4 + (b) * 2 + (h)) * HTB)
#define PG8_STAGE(bufoff, gbase, voff) do { _Pragma("unroll") for (int _i = 0; _i < 2; ++_i) \
        __builtin_amdgcn_global_load_lds((const unsigned*)((const char*)(gbase) + (voff)[_i]), (LAS unsigned*)(lds + (bufoff) + ldsw + _i * 8192), 16, 0, 0); } while (0)
#define PG8_LDA(dst, b, h) do { _Pragma("unroll") for (int m = 0; m < 4; ++m) _Pragma("unroll") for (int k = 0; k < 2; ++k) dst[m][k] = *(const LAS h16x8*)(lds + PG8_SA(b, h) + aoff + m * 2048 + k * 1024); } while (0)
#define PG8_LDB(dst, b, h) do { _Pragma("unroll") for (int n = 0; n < 2; ++n) _Pragma("unroll") for (int k = 0; k < 2; ++k) dst[n][k] = *(const LAS h16x8*)(lds + PG8_SB(b, h) + boff + n * 2048 + k * 1024); } while (0)
#define PG8_MMA(ai, bj, At, Bt) do { __builtin_amdgcn_s_setprio(1); _Pragma("unroll") for (int m = 0; m < 4; ++m) _Pragma("unroll") for (int n = 0; n < 2; ++n) _Pragma("unroll") for (int k = 0; k < 2; ++k) \
        acc[ai][bj][m][n] = __builtin_amdgcn_mfma_f32_16x16x32_f16(Bt[n][k], At[m][k], acc[ai][bj][m][n], 0, 0, 0); __builtin_amdgcn_s_setprio(0); } while (0)
#define PG8_WAIT_V(n) asm volatile("s_waitcnt vmcnt(" #n ")" ::: "memory")
#define PG8_WAIT_L(n) asm volatile("s_waitcnt lgkmcnt(" #n ")" ::: "memory")
#define PG8_BAR __builtin_amdgcn_s_barrier()
#define PG8_SCHED __builtin_amdgcn_sched_barrier(0)
    Unit cur, nxt; int ui = 0;
    if (!S.next(0, cur)) return;
    f32x4 acc[2][2][4][2];
#pragma unroll
    for (int a = 0; a < 2; ++a)
#pragma unroll
        for (int b = 0; b < 2; ++b)
#pragma unroll
            for (int m = 0; m < 4; ++m)
#pragma unroll
                for (int n = 0; n < 2; ++n) acc[a][b][m][n] = (f32x4){0.f, 0.f, 0.f, 0.f};
    h16x8 At[4][2], B0[2][2], B1[2][2];
    const char* cA = (const char*)g.A + (size_t)cur.pm * tstepA; const char* cB = (const char*)g.Bt + (size_t)cur.pn * tstepB;
    PG8_STAGE(PG8_SB(0, 0), cB, voffB); PG8_STAGE(PG8_SB(0, 1), cB + hstepB, voffB); PG8_STAGE(PG8_SA(0, 0), cA, voffA); PG8_STAGE(PG8_SA(0, 1), cA + hstepA, voffA);
    if (wr == 1) PG8_BAR;
    PG8_WAIT_V(2); PG8_BAR;
    PG8_STAGE(PG8_SB(1, 0), cB + kstep, voffB); PG8_STAGE(PG8_SA(1, 0), cA + kstep, voffA); PG8_STAGE(PG8_SB(1, 1), cB + hstepB + kstep, voffB);
    PG8_WAIT_V(6); PG8_BAR;
    for (;;) {
        const bool has_next = S.next(ui + 1, nxt);
        const char* nA = has_next ? (const char*)g.A + (size_t)nxt.pm * tstepA : cA; const char* nB = has_next ? (const char*)g.Bt + (size_t)nxt.pn * tstepB : cB;
        for (int t = 0; t < nt; t += 2) {
            const bool last = (t == nt - 2);
            const char* a1 = cA + (size_t)(t + 1) * kstep;
            const char* a2 = last ? nA : cA + (size_t)(t + 2) * kstep; const char* b2 = last ? nB : cB + (size_t)(t + 2) * kstep;
            const char* a3 = a2 + kstep; const char* b3 = b2 + kstep;
            PG8_LDB(B0, 0, 0); PG8_LDB(B1, 0, 1); PG8_SCHED; PG8_LDA(At, 0, 0); PG8_STAGE(PG8_SA(1, 1), a1 + hstepA, voffA);
            PG8_WAIT_V(8); PG8_WAIT_L(0); PG8_BAR; PG8_MMA(0, 0, At, B0); PG8_MMA(0, 1, At, B1); PG8_BAR; PG8_SCHED;
            PG8_LDA(At, 0, 1); PG8_STAGE(PG8_SB(0, 0), b2, voffB); PG8_STAGE(PG8_SB(0, 1), b2 + hstepB, voffB); PG8_STAGE(PG8_SA(0, 0), a2, voffA);
            PG8_WAIT_V(8); PG8_WAIT_L(0); PG8_BAR; PG8_MMA(1, 0, At, B0); PG8_MMA(1, 1, At, B1); PG8_BAR; PG8_SCHED;
            PG8_LDB(B0, 1, 0); PG8_LDB(B1, 1, 1); PG8_SCHED; PG8_LDA(At, 1, 0); PG8_STAGE(PG8_SA(0, 1), a2 + hstepA, voffA);
            PG8_WAIT_V(8); PG8_WAIT_L(0); PG8_BAR; PG8_MMA(0, 0, At, B0); PG8_MMA(0, 1, At, B1); PG8_BAR; PG8_SCHED;
            PG8_LDA(At, 1, 1); PG8_STAGE(PG8_SB(1, 0), b3, voffB); PG8_STAGE(PG8_SB(1, 1), b3 + hstepB, voffB); PG8_STAGE(PG8_SA(1, 0), a3, voffA);
            PG8_WAIT_V(8); PG8_WAIT_L(0); PG8_BAR; PG8_MMA(1, 0, At, B0); PG8_MMA(1, 1, At, B1); PG8_BAR; PG8_SCHED;
        }
        if (wr == 0) PG8_BAR;
        { const int l2 = lane_id(); E(acc, cur, wr, wc, l2 & 15, l2 >> 4); }
        if (!has_next) break;
#pragma unroll
        for (int a = 0; a < 2; ++a)
#pragma unroll
            for (int b = 0; b < 2; ++b)
#pragma unroll
                for (int m = 0; m < 4; ++m)
#pragma unroll
                    for (int n = 0; n < 2; ++n) acc[a][b][m][n] = (f32x4){0.f, 0.f, 0.f, 0.f};
        cur = nxt; cA = nA; cB = nB; ++ui;
        if (wr == 1) PG8_BAR;
    }
    PG8_WAIT_V(0);
    PG8_BAR;
#undef PG8_SA
#undef PG8_SB
#undef PG8_STAGE
#undef PG8_LDA
#undef PG8_LDB
#undef PG8_MMA
#undef PG8_WAIT_V
#undef PG8_WAIT_L
#undef PG8_BAR
#undef PG8_SCHED
}
}

struct Params {
    const float* in[35];
    float* out;
    unsigned char* ws;
    int step_lo, step_hi;
};
enum { I_X = 0, I_C, I_ADAW, I_ADAB, I_PREMIX, I_POSTMIX, I_PREFFN, I_POSTFFN, I_WIN, I_WINV, I_MU, I_MUV, I_WOUT, I_QNG, I_KVNG, I_WQUP, I_WQIUP, I_WKUP, I_WVUP,
       I_KLNG, I_KLNB, I_W0, I_W2, I_A0, I_A2, I_G2, I_V0, I_V2, I_KK, I_KA, I_RK, I_LNXG, I_LNXB, I_WFC, I_WDOWN };

template <int OFF> DI unsigned long long ka_load64() {
    unsigned long long v;
    asm volatile("s_load_dwordx2 %0, %1, %2\n\ts_waitcnt lgkmcnt(0)" : "=s"(v) : "s"(__builtin_amdgcn_kernarg_segment_ptr()), "n"(OFF));
    return v;
}
#define GAS __attribute__((address_space(1)))
template <int I> DI const float* kin() { return (const float*)(const GAS float*)ka_load64<8 * I>(); }
DI float* kout() { return (float*)(GAS float*)ka_load64<8 * 35>(); }
DI unsigned char* kws() { return (unsigned char*)(GAS unsigned char*)ka_load64<8 * 36>(); }

struct Ctx {
    LAS unsigned char* lds;
    int wave, gw, ngw, G;
};

DI void phase_mod(const Params& p, const Ctx& c) {
    const int lane = lane_id(), tid = c.wave * 64 + lane; (void)tid;
    unsigned char* const ws = kws();
    LAS float* cond = (LAS float*)c.lds;
    LAS float* red = (LAS float*)(c.lds + 65536);
    const float* cin = kin<I_C>();
    for (int i = tid; i < 16384; i += NTHR) { const int b = i & 15, k = i >> 4; const float cv = cin[b * 1024 + k]; cond[k * 16 + b] = cv * sigmoidf_(cv); }
    __syncthreads();
    float* MOD = (float*)(ws + WS_MOD);
    for (int item = blockIdx.x; item < 384; item += c.G) {
        const int l = item / 96, n0 = (item % 96) * 64;
        const float* W = kin<I_ADAW>() + (size_t)l * 1024 * 6144 + n0 + lane;
        float acc[16];
#pragma unroll
        for (int b = 0; b < 16; ++b) acc[b] = 0.f;
        const int k0 = c.wave * 128;
#pragma unroll 8
        for (int k = k0; k < k0 + 128; ++k) {
            const float wv = W[(size_t)k * 6144];
            const LAS f32x4* cb = (const LAS f32x4*)(cond + k * 16);
            const f32x4 c0 = cb[0], c1 = cb[1], c2 = cb[2], c3 = cb[3];
            acc[0] += c0[0] * wv; acc[1] += c0[1] * wv; acc[2] += c0[2] * wv; acc[3] += c0[3] * wv;
            acc[4] += c1[0] * wv; acc[5] += c1[1] * wv; acc[6] += c1[2] * wv; acc[7] += c1[3] * wv;
            acc[8] += c2[0] * wv; acc[9] += c2[1] * wv; acc[10] += c2[2] * wv; acc[11] += c2[3] * wv;
            acc[12] += c3[0] * wv; acc[13] += c3[1] * wv; acc[14] += c3[2] * wv; acc[15] += c3[3] * wv;
        }
#pragma unroll
        for (int b = 0; b < 16; ++b) red[(c.wave * 16 + b) * 64 + lane] = acc[b];
        __syncthreads();
        for (int idx = tid; idx < 1024; idx += NTHR) { const int b = idx >> 6, n = idx & 63; float s = kin<I_ADAB>()[l * 6144 + n0 + n];
#pragma unroll
            for (int w = 0; w < 8; ++w) s += red[(w * 16 + b) * 64 + n];
            MOD[(size_t)(l * 16 + b) * 6144 + n0 + n] = s; }
        __syncthreads();
    }
}

DI void tr_item(const float* src, int ldsrc, h16* dst, int ldd, LAS float* scr, int lane, bool zero) {
#pragma unroll
    for (int hb = 0; hb < 2; ++hb) { float tv[16];
#pragma unroll
        for (int i = 0; i < 16; ++i) { const int kk = 2 * (16 * hb + i) + (lane >> 5); tv[i] = zero ? 0.f : src[(size_t)kk * ldsrc + (lane & 31)]; }
#pragma unroll
        for (int i = 0; i < 16; ++i) { const int kk = 2 * (16 * hb + i) + (lane >> 5); scr[kk * 33 + (lane & 31)] = tv[i]; } }
    asm volatile("s_waitcnt lgkmcnt(0)" ::: "memory");
    const int cc = lane & 7;
#pragma unroll
    for (int j = 0; j < 4; ++j) { const int n = (lane >> 3) + 8 * j; const LAS float* s = scr + (8 * cc) * 33 + n;
        u32x4 o; o.x = pkh(s[0 * 33], s[1 * 33]); o.y = pkh(s[2 * 33], s[3 * 33]); o.z = pkh(s[4 * 33], s[5 * 33]); o.w = pkh(s[6 * 33], s[7 * 33]);
        *(u32x4*)(dst + (size_t)n * ldd + 8 * cc) = o; }
    asm volatile("s_waitcnt lgkmcnt(0)" ::: "memory");
}
DI void phase_wconv(const Params& p, const Ctx& c, int l, const int parts = 3) {
    const int lane = lane_id(), tid = c.wave * 64 + lane; (void)tid;
    unsigned char* const ws = kws();
    LAS float* scr = (LAS float*)(c.lds + c.wave * 16384);
    unsigned char* const wb = ws + wofs(l);
    h16* Win = (h16*)(wb + WT_IN); h16* Wq = (h16*)(wb + WT_Q); h16* Wlo = (h16*)(wb + WT_LORA); h16* Wout = (h16*)(wb + WT_OUT); h16* Wfc = (h16*)(wb + WT_FC); h16* Wdn = (h16*)(wb + WT_DOWN);
    const float* w_in = kin<I_WIN>() + (size_t)l * DM * PIN;
    const float* w_vr = kin<I_WINV>() + (size_t)(l > 0 ? l - 1 : 0) * DM * 32;
    const float* w_fc = kin<I_WFC>() + (size_t)l * DM * NFC;
    const float* w_dn = kin<I_WDOWN>() + (size_t)l * DFF * DM;
    const float* w_out = kin<I_WOUT>() + (size_t)l * 1024 * DM;
    constexpr int IT_IN = 16 * (NIN / 32), IT_FC = 16 * (NFC / 32), IT_DN = (DFF / 64) * (DM / 32), IT_O2 = 16 * (DM / 32);
    constexpr int NIT = IT_IN + IT_FC + IT_DN + IT_O2;
    constexpr int NSPLIT = 2048;
    for (int it = ((parts & 1) ? 0 : NSPLIT) + c.gw; it < ((parts & 2) ? NIT : NSPLIT); it += c.ngw) {
        int r = it;
        if (r < IT_IN) { const int nb = r % (NIN / 32), kb = r / (NIN / 32), nd = nb * 32, k0 = kb * 64;
            int sc; const float* sp = w_in; int ld = PIN; bool zero = false;
            if (nd < 448) sc = nd;
            else if (nd < 736) sc = 1988 + (nd - 448);
            else if (nd < 768) { if (l > 0) { sp = w_vr; ld = 32; sc = 0; } else { zero = true; sc = 0; } }
            else sc = 452 + (nd - 768);
            tr_item(sp + (size_t)k0 * ld + sc, ld, Win + (size_t)nd * DM + k0, DM, scr, lane, zero); continue; }
        r -= IT_IN;
        if (r < IT_FC) { const int nb = r % (NFC / 32), kb = r / (NFC / 32), nd = nb * 32, k0 = kb * 64;
            const int pn = nd >> 8, i = nd & 255; const int sc = (i < 128) ? (128 * pn + i) : (DFF + 128 * pn + (i - 128));
            tr_item(w_fc + (size_t)k0 * NFC + sc, NFC, Wfc + (size_t)nd * DM + k0, DM, scr, lane, false); continue; }
        r -= IT_FC;
        if (r < IT_DN) { const int nb = r % (DM / 32), kb = r / (DM / 32), nd = nb * 32, k0 = kb * 64;
            tr_item(w_dn + (size_t)k0 * DM + nd, DM, Wdn + (size_t)nd * DFF + k0, DFF, scr, lane, false); continue; }
        r -= IT_DN;
        { const int nb = r % (DM / 32), kb = r / (DM / 32), nd = nb * 32, k0 = kb * 64;
            tr_item(w_out + (size_t)k0 * DM + nd, DM, Wout + (size_t)nd * KOUT + k0, KOUT, scr, lane, false); }
    }
    if (!(parts & 2)) return;
    const int gt = c.gw * 64 + lane, ngt = c.ngw * 64;
    const float* wq = kin<I_WQUP>() + (size_t)l * 256 * 512; const float* wk = kin<I_WKUP>() + (size_t)l * 128 * 512; const float* wqi = kin<I_WQIUP>() + (size_t)l * 256 * 256;
    const float* wv = kin<I_WVUP>() + (size_t)l * 128 * 512;
    const float qscl = 0.125f * 1.4426950408889634f;
    for (int it = c.gw; it < 8 * 8 * 4; it += c.ngw) {
        const int h = it >> 5, rb = (it >> 2) & 7, cb = it & 3, cc = cb * 64 + lane;
        f32x4 qv[16];
#pragma unroll
        for (int d4 = 0; d4 < 16; ++d4) qv[d4] = *(const f32x4*)(wq + cc * 512 + h * 64 + 4 * d4);
#pragma unroll 2
        for (int r = 0; r < 16; ++r) { const float* kr = wk + (rb * 16 + r) * 512 + h * 64; float sacc = 0.f;
#pragma unroll
            for (int d4 = 0; d4 < 16; ++d4) { const f32x4 kv = *(const f32x4*)(kr + 4 * d4); sacc += (qv[d4][0] * kv[0] + qv[d4][1] * kv[1]) + (qv[d4][2] * kv[2] + qv[d4][3] * kv[3]); }
            Wq[(size_t)(h * 128 + rb * 16 + r) * 256 + cc] = (h16)(sacc * qscl); }
    }
    for (int idx = gt; idx < 256 * 256; idx += ngt) { const int n = idx >> 8, cc = idx & 255; Wq[(size_t)(1024 + n) * 256 + cc] = (h16)wqi[cc * 256 + n]; }
    const float* w2 = kin<I_W2>() + (size_t)l * 64 * 512; const float* a2 = kin<I_A2>() + (size_t)l * 64 * 512; const float* g2 = kin<I_G2>() + (size_t)l * 160 * 512;
    const float* v2 = kin<I_V2>() + (size_t)(l > 0 ? l - 1 : 0) * 32 * 512;
    for (int idx = gt; idx < 1024 * 128; idx += ngt) {
        const int n = idx >> 7, k = idx & 127, j = n & 511; float o = 0.f;
        if (n < 512) { if (k < 64) o = w2[k * 512 + j]; } else { if (k >= 64) o = a2[(k - 64) * 512 + j]; }
        Wlo[idx] = (h16)o; }
    for (int idx = gt; idx < 1024 * 256; idx += ngt) {
        const int n = idx >> 8, k = idx & 255, j = n & 511; float o = 0.f;
        if (n < 512) { if (k < 160) o = g2[k * 512 + j]; } else { if (l > 0 && k >= 160 && k < 192) o = v2[(k - 160) * 512 + j]; }
        Wlo[1024 * 128 + idx] = (h16)o; }
    { h16* WVt = (h16*)(wb + WT_VUP);
      for (int idx = gt; idx < 8 * 64 * 128; idx += ngt) { const int k = idx & 127, n = (idx >> 7) & 63, h = idx >> 13; WVt[idx] = (h16)wv[k * 512 + h * 64 + n]; } }
}

template <int MODE, bool HAS_NEXT, bool WIDX_>
DI void phase_rows(const Params& p, const Ctx& c, const h16* Y, const float* postg, int gate_off, int mod_l_gate,
                   const float* preg, int sh_off, int sc_off, int mod_l_next, int widx_l) {
    const int lane = lane_id(), tid = c.wave * 64 + lane; (void)tid;
    unsigned char* const ws = kws();
    h16* X = (h16*)(ws + WS_X16); float* OUT = kout(); h16* H = (h16*)(ws + WS_H); const float* MOD = (const float*)(ws + WS_MOD); float* WIDX = (float*)(ws + WS_WIDX);
    for (int rg = c.gw; rg < MT / 16; rg += c.ngw) {
        const int m0 = rg * 16, b = m0 / SEQ;
        f32x4 gp[4], ps[4], shv[4], wi[4][4];
#pragma unroll
        for (int j = 0; j < 4; ++j) { const int col = 4 * lane + 256 * j;
            if (MODE == 1) gp[j] = *(const f32x4*)(MOD + (size_t)(mod_l_gate * 16 + b) * 6144 + gate_off + col) * *(const f32x4*)(postg + col);
            if (HAS_NEXT) { shv[j] = *(const f32x4*)(MOD + (size_t)(mod_l_next * 16 + b) * 6144 + sh_off + col);
                ps[j] = *(const f32x4*)(preg + col) * (*(const f32x4*)(MOD + (size_t)(mod_l_next * 16 + b) * 6144 + sc_off + col) + 1.0f); }
            if (WIDX_) {
#pragma unroll
                for (int e = 0; e < 4; ++e) wi[j][e] = *(const f32x4*)(kin<I_WIN>() + ((size_t)widx_l * DM + col + e) * PIN + 448); }
        }
        for (int rr = 0; rr < 16; ++rr) {
            const size_t m = (size_t)(m0 + rr);
            f32x4 xv[4];
            if (MODE == 0) {
#pragma unroll
                for (int j = 0; j < 4; ++j) xv[j] = *(const f32x4*)(kin<I_X>() + m * DM + 4 * lane + 256 * j);
            } else {
                f32x4 yv[4]; float ss = 0.f;
#pragma unroll
                for (int j = 0; j < 4; ++j) { const u32x2 yr = *(const u32x2*)(Y + m * DM + 4 * lane + 256 * j); yv[j] = (f32x4){hlo(yr.x), hhi(yr.x), hlo(yr.y), hhi(yr.y)}; const u32x2 xr = *(const u32x2*)(X + m * DM + 4 * lane + 256 * j); xv[j] = (f32x4){hlo(xr.x), hhi(xr.x), hlo(xr.y), hhi(xr.y)};
                    ss += (yv[j][0] * yv[j][0] + yv[j][1] * yv[j][1]) + (yv[j][2] * yv[j][2] + yv[j][3] * yv[j][3]); }
                const float rn = rsqrtf(sum64(ss) * (1.0f / DM) + NORM_EPS);
#pragma unroll
                for (int j = 0; j < 4; ++j) xv[j] = xv[j] + (yv[j] * rn) * gp[j];
            }
            if (HAS_NEXT) {
#pragma unroll
                for (int j = 0; j < 4; ++j) { u32x2 w; w.x = pkh(xv[j][0], xv[j][1]); w.y = pkh(xv[j][2], xv[j][3]); *(u32x2*)(X + m * DM + 4 * lane + 256 * j) = w; }
            } else {
#pragma unroll
                for (int j = 0; j < 4; ++j) *(f32x4*)(OUT + m * DM + 4 * lane + 256 * j) = xv[j];
            }
            if (HAS_NEXT) {
                float ss = 0.f;
#pragma unroll
                for (int j = 0; j < 4; ++j) ss += (xv[j][0] * xv[j][0] + xv[j][1] * xv[j][1]) + (xv[j][2] * xv[j][2] + xv[j][3] * xv[j][3]);
                const float rn = rsqrtf(sum64(ss) * (1.0f / DM) + NORM_EPS);
                float d0 = 0.f, d1 = 0.f, d2 = 0.f, d3 = 0.f;
#pragma unroll
                for (int j = 0; j < 4; ++j) { const f32x4 hv = (xv[j] * rn) * ps[j] + shv[j];
                    u32x2 w; w.x = pkh(hv[0], hv[1]); w.y = pkh(hv[2], hv[3]);
                    *(u32x2*)(H + m * DM + 4 * lane + 256 * j) = w;
                    if (WIDX_) {
#pragma unroll
                        for (int e = 0; e < 4; ++e) { d0 += hv[e] * wi[j][e][0]; d1 += hv[e] * wi[j][e][1]; d2 += hv[e] * wi[j][e][2]; d3 += hv[e] * wi[j][e][3]; } } }
                if (WIDX_) { d0 = sum64(d0); d1 = sum64(d1); d2 = sum64(d2); d3 = sum64(d3);
                    if (lane == 0) *(f32x4*)(WIDX + m * 4) = (f32x4){d0 * 0.0625f, d1 * 0.0625f, d2 * 0.0625f, d3 * 0.0625f}; }
            }
        }
    }
}

DI void phase_prep(const Params& p, const Ctx& c, int l) {
    unsigned char* const ws = kws();
    const int lane = lane_id();
    const h16* CA = (const h16*)(ws + WS_COLSA);
    h16* CQ = (h16*)(ws + WS_CQ); h16* CKV = (h16*)(ws + WS_CKV); h16* KIDX = (h16*)(ws + WS_KIDX); h16* AL = (h16*)(ws + WS_ALORA);
    const f32x4 qg = *(const f32x4*)(kin<I_QNG>() + l * 256 + 4 * lane);
    const f32x2 kvg = *(const f32x2*)(kin<I_KVNG>() + l * 128 + 2 * lane);
    const float lg = kin<I_KLNG>()[l * 64 + lane], lb = kin<I_KLNB>()[l * 64 + lane];
    float mu[5];
#pragma unroll
    for (int i = 0; i < 5; ++i) { const int j = lane + 64 * i;
        mu[i] = (j < 288) ? kin<I_MU>()[l * 1824 + 1536 + j] : (l > 0 ? kin<I_MUV>()[(l - 1) * 32 + (j - 288)] : 0.f); }
    for (int rg = c.gw; rg < MT / 16; rg += c.ngw) {
        const int m0 = rg * 16, b = m0 / SEQ, t0 = m0 % SEQ;
        float prevv[5];
#pragma unroll
        for (int i = 0; i < 5; ++i) prevv[i] = (t0 > 0) ? (float)CA[(size_t)(m0 - 1) * NCA + 448 + lane + 64 * i] : 0.f;
#pragma unroll
        for (int rr = 0; rr < 16; ++rr) {
            const size_t m = (size_t)(m0 + rr); const h16* row = CA + m * NCA;
            const u32x2 cqr = *(const u32x2*)(row + 4 * lane);
            const unsigned ckr = *(const unsigned*)(row + 256 + 2 * lane);
            const float kir = (float)row[384 + lane];
            float cur[5];
#pragma unroll
            for (int i = 0; i < 5; ++i) cur[i] = (float)row[448 + lane + 64 * i];
            const float q0 = hlo(cqr.x), q1 = hhi(cqr.x), q2 = hlo(cqr.y), q3 = hhi(cqr.y);
            const float rq = rsqrtf(sum64((q0 * q0 + q1 * q1) + (q2 * q2 + q3 * q3)) * (1.0f / 256.0f) + NORM_EPS);
            u32x2 qo; qo.x = pkh(q0 * rq * qg[0], q1 * rq * qg[1]); qo.y = pkh(q2 * rq * qg[2], q3 * rq * qg[3]);
            *(u32x2*)(CQ + m * 256 + 4 * lane) = qo;
            const float k0 = hlo(ckr), k1 = hhi(ckr);
            const float rk = rsqrtf(sum64(k0 * k0 + k1 * k1) * (1.0f / 128.0f) + NORM_EPS);
            const float o0 = k0 * rk * kvg[0], o1 = k1 * rk * kvg[1];
            *(unsigned*)(CKV + m * 128 + 2 * lane) = pkb(o0, o1);
            const float mean = sum64(kir) * (1.0f / 64.0f); const float dv = kir - mean; const float var = sum64(dv * dv) * (1.0f / 64.0f);
            KIDX[m * 64 + lane] = (h16)(dv * rsqrtf(var + NORM_EPS) * lg + lb);
#pragma unroll
            for (int i = 0; i < 5; ++i) { const float sh = cur[i] + (prevv[i] - cur[i]) * mu[i]; prevv[i] = cur[i]; const int j = lane + 64 * i; float o;
                if (i == 0) o = tanhf(sh); else if (i == 1) o = sh; else if (j < 288) o = sigmoidf_(sh); else o = (l > 0) ? sh : 0.f;
                AL[m * KLORA + j] = (h16)o; }
            AL[m * KLORA + 320 + lane] = (h16)0.f;
        }
    }
}

constexpr int AT_KSTR = 272, AT_VSTR = 144;
constexpr int AT_KB = 64 * AT_KSTR, AT_VB = 128 * AT_VSTR, AT_BUF = AT_KB + AT_VB;
constexpr int AT_MASK = 131072 + 1024;
DI unsigned okey(float s) { const unsigned u = __builtin_bit_cast(unsigned, s); return (u & 0x80000000u) ? ~u : (u | 0x80000000u); }
DI float ikeyf(unsigned k) { return __builtin_bit_cast(float, (k & 0x80000000u) ? (k & 0x7FFFFFFFu) : ~k); }
template <int CTRL, int RM> DI unsigned dppu_rm(unsigned x) { return (unsigned)__builtin_amdgcn_update_dpp(0, (int)x, CTRL, RM, 0xf, false); }
DI unsigned umax_(unsigned a, unsigned b) { return a > b ? a : b; }
DI unsigned max64u(unsigned x) {
    x = umax_(x, dppu<0xB1>(x)); x = umax_(x, dppu<0x4E>(x)); x = umax_(x, dppu<0x141>(x)); x = umax_(x, dppu<0x140>(x));
    x = umax_(x, dppu_rm<0x142, 0xA>(x)); x = umax_(x, dppu_rm<0x143, 0xC>(x)); return (unsigned)__builtin_amdgcn_readlane((int)x, 63);
}

template <int NRM>
DI void select_query(const LAS float* SCq, unsigned long long* mkq, const int nr, const int lane) {

                        unsigned key[NRM];
                        float sraw[NRM];
#pragma unroll
                        for (int r = 0; r < NRM; ++r) sraw[r] = SCq[64 * (r < nr ? r : 0) + lane];
#pragma unroll
                        for (int r = 0; r < NRM; ++r) key[r] = okey(sraw[r]) & (unsigned)((r - nr) >> 31);
                        auto count_ge = [&](const unsigned cand) -> unsigned { unsigned cnt = 0u;
#pragma unroll
                            for (int r = 0; r < NRM; r += 4) {
                                const unsigned long long m0 = __ballot(key[r] >= cand), m1 = __ballot(key[r + 1] >= cand), m2 = __ballot(key[r + 2] >= cand), m3 = __ballot(key[r + 3] >= cand);
                                cnt += (unsigned)(__popcll(m0) + __popcll(m1)) + (unsigned)(__popcll(m2) + __popcll(m3)); }
                            return cnt; };
                        unsigned thr = 0u; bool exact = false, found = false, neg = false;
                        unsigned klo = 0u, khi = 0u, clo = 0u, chi = 0u;
                        { const unsigned c1 = count_ge(0x80000001u);
                          if (c1 == 256u) { thr = 0x80000001u; exact = true; found = true; }
                          else if (c1 > 256u) { unsigned mx = 0u;
#pragma unroll
                              for (int r = 0; r < NRM; ++r) mx = key[r] > mx ? key[r] : mx;
                              klo = 0x80000001u; clo = c1; khi = max64u(mx) + 1u; chi = 0u; }
                          else { const unsigned c3 = count_ge(0x7FFFFFFFu);
                              if (c3 >= 256u) { found = true;
                                  if (c3 == 256u) { thr = 0x7FFFFFFFu; exact = true; }
                                  else { const unsigned c2 = count_ge(0x80000000u);
                                      if (c2 >= 256u) { thr = 0x80000000u; exact = (c2 == 256u); } else thr = 0x7FFFFFFFu; } }
                              else { unsigned mx = 0u;
#pragma unroll
                                  for (int r = 0; r < NRM; ++r) { const unsigned kc = ~key[r] & (unsigned)((r - nr) >> 31); mx = kc > mx ? kc : mx; }
                                  klo = ~max64u(mx); clo = 64u * (unsigned)nr; khi = 0x7FFFFFFFu; chi = c3; neg = true; } } }
                        if (!found) { float wlo = 1.f, whi = 1.f; int last = 0, it = 0;
#pragma unroll 1
                            for (;;) {
                                if (khi - klo <= 1u) { thr = klo; break; }
                                ++it;
                                const float vlo = ikeyf(klo), vhi = ikeyf(khi);
                                const float a = ((float)clo - 255.5f) * wlo, b = (255.5f - (float)chi) * whi;
                                float frac = a * __builtin_amdgcn_rcpf(a + b);
                                if ((it & 7) == 0) frac = 0.5f;
                                if (it == 1) {
                                    if (!neg) { const float lc = __builtin_amdgcn_logf((float)clo); frac = __builtin_amdgcn_exp2f(0.75f * __builtin_amdgcn_logf((lc - 8.f) * __builtin_amdgcn_rcpf(lc))); }
                                    else { const float lm = __builtin_amdgcn_logf((float)(clo - chi)), lb = __builtin_amdgcn_logf((float)(clo - 256u));
                                           frac = 1.f - __builtin_amdgcn_exp2f(0.8f * __builtin_amdgcn_logf((lm - lb) * __builtin_amdgcn_rcpf(lm))); } }
                                unsigned kp = (unsigned)__builtin_amdgcn_readfirstlane((int)okey(vlo + (vhi - vlo) * frac));
                                if (!(kp > klo && kp < khi)) kp = klo + ((khi - klo) >> 1);
                                const unsigned cn = count_ge(kp);
                                if (cn == 256u) { thr = kp; exact = true; break; }
                                if (cn > 256u) { klo = kp; clo = cn; whi = (last == 1) ? whi * 0.7f : 1.f; wlo = 1.f; last = 1; }
                                else { khi = kp; chi = cn; wlo = (last == -1) ? wlo * 0.7f : 1.f; whi = 1.f; last = -1; }
                            } }
                        unsigned need = 0u;
                        if (!exact) { unsigned cgt = 0u;
#pragma unroll
                            for (int r = 0; r < NRM; ++r) cgt += (unsigned)__popcll(__ballot(key[r] > thr));
                            need = 256u - cgt; }
                        unsigned base = 0u;
                        const unsigned long long lowmask = (1ull << lane) - 1ull;
#pragma unroll
                        for (int r = 0; r < NRM; ++r) {
                            bool sel = key[r] >= thr;
                            if (!exact) { const bool eq = key[r] == thr; const unsigned long long em = __ballot(eq);
                                const unsigned pre = __popcll(em & lowmask); sel = (key[r] > thr) || (eq && (base + pre < need)); base += __popcll(em); }
                            const unsigned long long sm = __ballot(sel);
                            if (lane == 0) mkq[r] = sm;
                        }
                    }

DI void phase_select(const Params& p, const Ctx& c, unsigned* qctr) {
    unsigned char* const ws = kws();
    const h16* QALL = (const h16*)kout(); const h16* KIDX = (const h16*)(ws + WS_KIDX);
    const float* WIDX = (const float*)(ws + WS_WIDX); unsigned long long* MASKG = (unsigned long long*)(ws + WS_MASK);
    const int wave = c.wave;
    LAS unsigned char* lds = c.lds;
    volatile LAS unsigned* qw = (volatile LAS unsigned*)(c.lds + LDS_MISC + 64);
    {
        for (;;) {
            const int lane = lane_id(), tid = wave * 64 + lane;
            if (wave == 0 && lane == 0) *qw = __hip_atomic_fetch_add(qctr, 1u, __ATOMIC_RELAXED, __HIP_MEMORY_SCOPE_AGENT);
            __syncthreads();
            const int unit = (int)*qw;
            __syncthreads();
            if (unit >= 1024) break;
            const int chv = 31 - (unit >> 5), subv = unit & 31;
            const int b = subv >> 1, half = subv & 1;
            const int nadm = 64 * (chv + 1), nkt = chv + 1;
            const int kbase = b * SEQ;
            const int tqu = b * SEQ + chv * 64 + half * 32;
            unsigned long long* mk64 = MASKG + (size_t)tqu * 32;
            if (nadm <= 256) {
                if (lane < 16) mk64[(4 * wave + (lane >> 2)) * 32 + (lane & 3)] = ((lane & 3) < nkt) ? ~0ull : 0ull;
            } else {
                LAS float* SC = (LAS float*)lds;
                const int q4 = lane >> 4, c16 = lane & 15;
#pragma unroll 1
                for (int rnd = 0; rnd < 2; ++rnd) {
                    {
                        h16x8 a0[4], a1[4]; f32x4 wv[4];
#pragma unroll
                        for (int g = 0; g < 4; ++g) { const int tqr = tqu + 16 * rnd + 4 * g;
                            const h16* ap = QALL + (size_t)(tqr + (c16 >> 2)) * NQ + 1024 + (c16 & 3) * 64 + 8 * q4; a0[g] = *(const h16x8*)ap; a1[g] = *(const h16x8*)(ap + 32);
                            wv[g] = *(const f32x4*)(WIDX + (size_t)(tqr + q4) * 4); }
                        const int nt16 = nadm >> 4;
                        const h16* kp = KIDX + (size_t)(kbase + c16) * 64 + 8 * q4;
#pragma unroll 1
                        for (int tb = wave; tb < nt16; tb += 64) {
                            h16x8 b0[8], b1[8];
#pragma unroll
                            for (int u = 0; u < 8; ++u) { int tt = tb + 8 * u; tt = tt < nt16 ? tt : tb; b0[u] = *(const h16x8*)(kp + (size_t)tt * 1024); b1[u] = *(const h16x8*)(kp + (size_t)tt * 1024 + 32); }
#pragma unroll
                            for (int u = 0; u < 8; ++u) { const int tt = tb + 8 * u;
                                if (tt < nt16) {
#pragma unroll
                                    for (int g = 0; g < 4; ++g) { f32x4 acc = (f32x4){0.f, 0.f, 0.f, 0.f};
                                        acc = __builtin_amdgcn_mfma_f32_16x16x32_f16(a0[g], b0[u], acc, 0, 0, 0); acc = __builtin_amdgcn_mfma_f32_16x16x32_f16(a1[g], b1[u], acc, 0, 0, 0);
                                        SC[(4 * g + q4) * 2048 + 16 * tt + c16] = ((fmaxf(acc[0], 0.f) * wv[g][0] + fmaxf(acc[1], 0.f) * wv[g][1]) + fmaxf(acc[2], 0.f) * wv[g][2]) + fmaxf(acc[3], 0.f) * wv[g][3]; }
                                }
                            }
                        }
                    }
                    __syncthreads();
                    const int nr = nadm >> 6;
#pragma unroll 1
                    for (int qi = 0; qi < 2; ++qi) {
                        const int ql = 2 * wave + qi; const LAS float* SCq = SC + ql * 2048; unsigned long long* mkq = mk64 + (16 * rnd + ql) * 32;
                        if (nr <= 8) select_query<8>(SCq, mkq, nr, lane); else if (nr <= 16) select_query<16>(SCq, mkq, nr, lane);
                        else if (nr <= 24) select_query<24>(SCq, mkq, nr, lane); else select_query<32>(SCq, mkq, nr, lane);
                    }
                    __syncthreads();
                }
            }
            __syncthreads();
        }
    }
}

namespace ab {
typedef short bf16x8 __attribute__((ext_vector_type(8)));
typedef short s16x4 __attribute__((ext_vector_type(4)));
constexpr int SHM_V = 64 * 128 * 2, SHM_K = 64 * 128 * 2;
constexpr int LDS_RED = 2 * SHM_V + 2 * SHM_K;
constexpr int LDS_MK = LDS_RED + 8 * 256;
constexpr int LDS_END = LDS_MK + 8 * 8192;
constexpr float THRL = 8.0f;
#define AB_KSWZ(row, colB) ((row) * 256 + ((colB) ^ (((row) & 7) << 4)))
#define AB_SBAR() __builtin_amdgcn_sched_barrier(0)
DI int crow(int r, int hi) { return (r & 3) + 8 * (r >> 2) + 4 * hi; }
DI unsigned cvtpk(float lo, float hi) { unsigned r; asm volatile("v_cvt_pk_bf16_f32 %0, %1, %2" : "=v"(r) : "v"(lo), "v"(hi)); return r; }
DI void partialSM(f32x16& p0, f32x16& p1, float& m_reg, float& mn, float& alpha, unsigned wlo, unsigned whi) {
#pragma unroll
    for (int r = 0; r < 16; ++r) { const int o = (r & 3) + 8 * (r >> 2); p0[r] = ((wlo >> o) & 1u) ? p0[r] : -__builtin_inff(); p1[r] = ((whi >> o) & 1u) ? p1[r] : -__builtin_inff(); }
    float pmax = p0[0];
#pragma unroll
    for (int r = 1; r < 16; ++r) pmax = fmaxf(pmax, p0[r]);
#pragma unroll
    for (int r = 0; r < 16; ++r) pmax = fmaxf(pmax, p1[r]);
    { auto rr = __builtin_amdgcn_permlane32_swap(__float_as_uint(pmax), __float_as_uint(pmax), false, false);
      pmax = fmaxf(__uint_as_float(rr[0]), __uint_as_float(rr[1])); }
    if (__builtin_expect(__all(pmax - m_reg <= THRL), 1)) { mn = m_reg; alpha = 1.f; }
    else { mn = fmaxf(m_reg, pmax); alpha = __builtin_amdgcn_exp2f(m_reg - mn); m_reg = mn; }
#pragma unroll
    for (int r = 0; r < 16; ++r) { p0[r] = p0[r] - mn; p1[r] = p1[r] - mn; }
#pragma unroll
    for (int r = 0; r < 16; ++r) p0[r] = __builtin_amdgcn_exp2f(p0[r]);
}
DI void finishSM(f32x16& p0, f32x16& p1, float alpha, float& l_reg, bf16x8& pa0, bf16x8& pa1, bf16x8& pa2, bf16x8& pa3) {
#pragma unroll
    for (int r = 0; r < 16; ++r) p1[r] = __builtin_amdgcn_exp2f(p1[r]);
    float ps = 0;
#pragma unroll
    for (int r = 0; r < 16; ++r) ps += p0[r];
#pragma unroll
    for (int r = 0; r < 16; ++r) ps += p1[r];
    { auto rr = __builtin_amdgcn_permlane32_swap(__float_as_uint(ps), __float_as_uint(ps), false, false);
      ps = __uint_as_float(rr[0]) + __uint_as_float(rr[1]); }
    l_reg = l_reg * alpha + ps;
#define AB_PK4(P, BASE, OUT) do { unsigned a0 = cvtpk(P[BASE + 0], P[BASE + 1]), a1 = cvtpk(P[BASE + 2], P[BASE + 3]);   \
    unsigned b0 = cvtpk(P[BASE + 4], P[BASE + 5]), b1 = cvtpk(P[BASE + 6], P[BASE + 7]);                              \
    auto r0 = __builtin_amdgcn_permlane32_swap(a0, b0, false, false); auto r1 = __builtin_amdgcn_permlane32_swap(a1, b1, false, false); \
    u32x4 w = {r0[0], r1[0], r0[1], r1[1]}; OUT = __builtin_bit_cast(bf16x8, w); } while (0)
    AB_PK4(p0, 0, pa0); AB_PK4(p0, 8, pa1); AB_PK4(p1, 0, pa2); AB_PK4(p1, 8, pa3);
#undef AB_PK4
}
DI void qkt(f32x16& p0, f32x16& p1, const LAS unsigned char* Ks, const bf16x8* qr, int r32, int hi) {
#pragma unroll
    for (int e = 0; e < 16; ++e) { p0[e] = 0.f; p1[e] = 0.f; }
#pragma unroll
    for (int d0 = 0; d0 < 8; ++d0) { const int cb = (d0 * 16 + hi * 8) * 2;
        const bf16x8 b0 = *(const LAS bf16x8*)(Ks + AB_KSWZ(r32, cb));
        const bf16x8 b1 = *(const LAS bf16x8*)(Ks + AB_KSWZ(32 + r32, cb));
        p0 = __builtin_amdgcn_mfma_f32_32x32x16_bf16(b0, qr[d0], p0, 0, 0, 0);
        p1 = __builtin_amdgcn_mfma_f32_32x32x16_bf16(b1, qr[d0], p1, 0, 0, 0); }
}
DI int v_st(int k, int c) { const int kk = (k & ~0xC) | ((k & 4) << 1) | ((k & 8) >> 1); return ((kk >> 3) * 4 + (c >> 5)) * 512 + ((kk & 7) * 32 + (c & 31)) * 2; }
DI int v_rd_base(int lane) { return ((lane & 3) << 3) | (((lane >> 2) & 3) << 6) | (((lane >> 4) & 1) << 5) | (((lane >> 5) & 1) << 8); }
constexpr int v_rd_off(int d0, int ks, int half) { return d0 * 512 + ks * 4096 + half * 2048; }
template <int OFF> DI s16x4 tr_read(int vb) { s16x4 r; asm volatile("ds_read_b64_tr_b16 %0, %1 offset:%2" : "=&v"(r) : "v"(vb), "i"(OFF) : "memory"); return r; }
template <int D0> DI void pv_one(f32x16& od, int vb, bf16x8 pa0, bf16x8 pa1, bf16x8 pa2, bf16x8 pa3) {
    const s16x4 l0 = tr_read<v_rd_off(D0, 0, 0)>(vb), h0 = tr_read<v_rd_off(D0, 0, 1)>(vb), l1 = tr_read<v_rd_off(D0, 1, 0)>(vb), h1 = tr_read<v_rd_off(D0, 1, 1)>(vb);
    const s16x4 l2 = tr_read<v_rd_off(D0, 2, 0)>(vb), h2 = tr_read<v_rd_off(D0, 2, 1)>(vb), l3 = tr_read<v_rd_off(D0, 3, 0)>(vb), h3 = tr_read<v_rd_off(D0, 3, 1)>(vb);
    asm volatile("s_waitcnt lgkmcnt(0)" ::: "memory"); AB_SBAR();
#define AB_PK(L, H) (bf16x8){L[0], L[1], L[2], L[3], H[0], H[1], H[2], H[3]}
    od = __builtin_amdgcn_mfma_f32_32x32x16_bf16(pa0, AB_PK(l0, h0), od, 0, 0, 0);
    od = __builtin_amdgcn_mfma_f32_32x32x16_bf16(pa1, AB_PK(l1, h1), od, 0, 0, 0);
    od = __builtin_amdgcn_mfma_f32_32x32x16_bf16(pa2, AB_PK(l2, h2), od, 0, 0, 0);
    od = __builtin_amdgcn_mfma_f32_32x32x16_bf16(pa3, AB_PK(l3, h3), od, 0, 0, 0);
#undef AB_PK
}
DI void pv_d0(f32x16* o, int vb, bf16x8 pa0, bf16x8 pa1, bf16x8 pa2, bf16x8 pa3) {
    pv_one<0>(o[0], vb, pa0, pa1, pa2, pa3); pv_one<1>(o[1], vb, pa0, pa1, pa2, pa3); pv_one<2>(o[2], vb, pa0, pa1, pa2, pa3); pv_one<3>(o[3], vb, pa0, pa1, pa2, pa3);
}
DI void body(const unsigned short* Qb, const unsigned short* Kh, h16* Ob, const h16* Wv, const unsigned long long* Mb, const int NT, LAS unsigned char* lds, const int wid, const int lane) {
    const int tid = wid * 64 + lane, r32 = lane & 31, hi = lane >> 5;
    LAS unsigned char* V_lds = lds; LAS unsigned char* K_lds = lds + 2 * SHM_V;
    LAS float* wsf = (LAS float*)(lds + LDS_RED) + wid * 64; LAS float* li_l = wsf; LAS float* al_l = wsf + 32;
    LAS unsigned long long* mkl = (LAS unsigned long long*)(lds + LDS_MK) + wid * 1024;
    float m_reg = -1e30f, l_reg = 0;
    f32x16 o[4];
#pragma unroll
    for (int d = 0; d < 4; ++d)
#pragma unroll
        for (int e = 0; e < 16; ++e) o[d][e] = 0.f;
    bf16x8 qr[8];
    const unsigned short* Qw = Qb + (size_t)(wid * 32 + r32) * NQ + hi * 8;
#pragma unroll
    for (int d0 = 0; d0 < 8; ++d0) qr[d0] = *(const bf16x8*)(Qw + d0 * 16);
    {
        const unsigned long long* mrow = Mb + (size_t)(wid * 32 + r32) * 32 + 2 * hi;
        for (int i = 0; i < (NT >> 2); ++i) { const u32x4 w = *(const u32x4*)(mrow + 4 * i);
            mkl[(4 * i + 2 * hi) * 32 + r32] = ((unsigned long long)w.y << 32) | w.x; mkl[(4 * i + 2 * hi + 1) * 32 + r32] = ((unsigned long long)w.w << 32) | w.z; }
    }
    const int sr = tid >> 4, sc = (tid & 15) * 8, vst0 = v_st(sr, sc), vst1 = v_st(32 + sr, sc);
    const int vb0 = (int)(unsigned)(uintptr_t)V_lds + v_rd_base(lane);
    bf16x8 st0[2], st1[2];
#define AB_SLOAD(i, k0) do { st0[i] = *(const bf16x8*)(Kh + (size_t)((k0) + sr) * 128 + sc); st1[i] = *(const bf16x8*)(Kh + (size_t)((k0) + 32 + sr) * 128 + sc); } while (0)
#define AB_SWRITE(b, i) do { *(LAS bf16x8*)(V_lds + (b) * SHM_V + vst0) = st0[i]; *(LAS bf16x8*)(V_lds + (b) * SHM_V + vst1) = st1[i]; const int kc = sc * 2; \
    *(LAS bf16x8*)(K_lds + (b) * SHM_K + AB_KSWZ(sr, kc)) = st0[i]; *(LAS bf16x8*)(K_lds + (b) * SHM_K + AB_KSWZ(32 + sr, kc)) = st1[i]; } while (0)
#define AB_SWAIT() asm volatile("s_waitcnt vmcnt(2)" ::: "memory")
#define AB_RESC(a) do { if (__any((a) < 1.f)) { if (hi == 0) al_l[r32] = (a); asm volatile("s_waitcnt lgkmcnt(0)" ::: "memory"); \
    _Pragma("unroll") for (int d = 0; d < 4; ++d) _Pragma("unroll") for (int r = 0; r < 16; ++r) o[d][r] *= al_l[crow(r, hi)]; } } while (0)
#define AB_MASK(j, WLO, WHI) const unsigned long long mw_##WLO = mkl[(j) * 32 + r32]; const unsigned WLO = (unsigned)mw_##WLO >> (4 * hi), WHI = (unsigned)(mw_##WLO >> 32) >> (4 * hi)
    f32x16 pA0, pA1, pB0, pB1; float mnA, mnB, alA, alB; bf16x8 pa0, pa1, pa2, pa3;
    AB_SLOAD(0, 0); asm volatile("s_waitcnt vmcnt(0)" ::: "memory"); AB_SWRITE(0, 0); __syncthreads();
    qkt(pA0, pA1, K_lds, qr, r32, hi); { AB_MASK(0, wl, wh); partialSM(pA0, pA1, m_reg, mnA, alA, wl, wh); }
    AB_SLOAD(1, 64); if (2 < NT) AB_SLOAD(0, 128);
    AB_SWAIT(); AB_SWRITE(1, 1); __syncthreads();
    for (int j = 1; j + 1 < NT; j += 2) {
        AB_SBAR(); qkt(pB0, pB1, K_lds + SHM_K, qr, r32, hi);
        finishSM(pA0, pA1, alA, l_reg, pa0, pa1, pa2, pa3); AB_SBAR();
        AB_SLOAD(1, (j + 2) * 64); AB_SBAR();
        pv_d0(o, vb0, pa0, pa1, pa2, pa3); { AB_MASK(j, wl, wh); partialSM(pB0, pB1, m_reg, mnB, alB, wl, wh); }
        __syncthreads(); AB_SWAIT(); AB_SWRITE(0, 0);
        AB_RESC(alB); __syncthreads();
        AB_SBAR(); qkt(pA0, pA1, K_lds, qr, r32, hi);
        finishSM(pB0, pB1, alB, l_reg, pa0, pa1, pa2, pa3); AB_SBAR();
        if (j + 3 < NT) AB_SLOAD(0, (j + 3) * 64); AB_SBAR();
        pv_d0(o, vb0 + SHM_V, pa0, pa1, pa2, pa3); { AB_MASK(j + 1, wl, wh); partialSM(pA0, pA1, m_reg, mnA, alA, wl, wh); }
        __syncthreads(); AB_SWAIT(); AB_SWRITE(1, 1);
        AB_RESC(alA); __syncthreads();
    }
    AB_SBAR(); qkt(pB0, pB1, K_lds + SHM_K, qr, r32, hi);
    finishSM(pA0, pA1, alA, l_reg, pa0, pa1, pa2, pa3); AB_SBAR();
    pv_d0(o, vb0, pa0, pa1, pa2, pa3); { AB_MASK(NT - 1, wl, wh); partialSM(pB0, pB1, m_reg, mnB, alB, wl, wh); }
    __syncthreads(); AB_RESC(alB);
    finishSM(pB0, pB1, alB, l_reg, pa0, pa1, pa2, pa3); AB_SBAR();
    pv_d0(o, vb0 + SHM_V, pa0, pa1, pa2, pa3);
    if (hi == 0) li_l[r32] = l_reg;
    asm volatile("s_waitcnt lgkmcnt(0)" ::: "memory");
    __syncthreads();
    LAS unsigned char* ob = lds + wid * 8192;
    const int le_ = lane_id(), r32e = le_ & 31, hie = le_ >> 5;
#pragma unroll
    for (int r = 0; r < 16; ++r) { const int orow = crow(r, hie); const float rli = __builtin_amdgcn_rcpf(li_l[orow]);
#pragma unroll
        for (int d0 = 0; d0 < 4; ++d0) { const int col = d0 * 32 + r32e; *(LAS h16*)(ob + orow * 256 + ((((col >> 3) ^ (orow & 15)) << 4) | ((col & 7) * 2))) = (h16)(o[d0][r] * rli); } }
    asm volatile("s_waitcnt lgkmcnt(0)" ::: "memory");
    f32x16 yv[2];
#pragma unroll
    for (int e = 0; e < 16; ++e) { yv[0][e] = 0.f; yv[1][e] = 0.f; }
#pragma unroll
    for (int s8 = 0; s8 < 8; ++s8) { const h16x8 af = *(const LAS h16x8*)(ob + r32e * 256 + (((2 * s8 + hie) ^ (r32e & 15)) << 4));
#pragma unroll
        for (int nt = 0; nt < 2; ++nt) { const h16x8 bf = *(const h16x8*)(Wv + (size_t)(32 * nt + r32e) * 128 + 16 * s8 + 8 * hie);
            yv[nt] = __builtin_amdgcn_mfma_f32_32x32x16_f16(af, bf, yv[nt], 0, 0, 0); } }
#pragma unroll
    for (int nt = 0; nt < 2; ++nt)
#pragma unroll
        for (int r = 0; r < 16; ++r) Ob[(size_t)(wid * 32 + crow(r, hie)) * KOUT + 32 * nt + r32e] = (h16)yv[nt][r];
#undef AB_SLOAD
#undef AB_SWRITE
#undef AB_SWAIT
#undef AB_RESC
#undef AB_MASK
}
}

DI void phase_attn(const Params& p, const Ctx& c, unsigned* qctr, const int l) {
    unsigned char* const ws = kws();
    const unsigned short* QALL = (const unsigned short*)kout(); const unsigned short* CKV = (const unsigned short*)(ws + WS_CKV);
    const unsigned long long* MASKG = (const unsigned long long*)(ws + WS_MASK); h16* AOUT = (h16*)(ws + WS_AOUT);
    const int wave = c.wave;
    volatile LAS unsigned* qw = (volatile LAS unsigned*)(c.lds + LDS_MISC + 64);
    for (;;) {
        const int lane = lane_id();
        if (wave == 0 && lane == 0) *qw = __hip_atomic_fetch_add(qctr, 1u, __ATOMIC_RELAXED, __HIP_MEMORY_SCOPE_AGENT);
        __syncthreads();
        const int unit = (int)*qw;
        __syncthreads();
        if (unit >= NB * 8 * 8) break;
        const int qb = 7 - (unit >> 7), b = (unit >> 3) & 15, h = unit & 7;
        const size_t row0 = (size_t)b * SEQ + 256 * qb;
        ab::body(QALL + row0 * NQ + h * 128, CKV + (size_t)b * SEQ * 128, AOUT + row0 * KOUT + h * 64, (const h16*)(ws + wofs(l) + WT_VUP) + h * 64 * 128, MASKG + row0 * 32, 4 * (qb + 1), c.lds, wave, lane);
        __syncthreads();
    }
}

DI int sw128(int row, int boff) { return row * 128 + ((((boff >> 4) ^ ((row >> 1) & 7)) << 4) | (boff & 15)); }
DI int sw64(int row, int boff)  { return row * 64 + ((((boff >> 4) ^ ((row >> 2) & 3)) << 4) | (boff & 15)); }
DI int sw32(int row, int boff)  { return row * 32 + ((((boff >> 4) ^ ((row >> 3) & 1)) << 4) | (boff & 15)); }
constexpr int SL_A1 = 0, SL_A4 = 4096, SL_WY = 8192, SL_VT = 12288, SL_A23 = 14336, SL_A5 = 15360, SL_P16 = 16384, SLOT = 16640;
DI float rl(float x, int l) { return __builtin_bit_cast(float, __builtin_amdgcn_readlane(__builtin_bit_cast(int, x), l)); }
template <int CTRL, int RM> DI float dppf_rm(float x) { return __builtin_bit_cast(float, __builtin_amdgcn_update_dpp(0, __builtin_bit_cast(int, x), CTRL, RM, 0xf, false)); }
DI float sum64u(float x) { x = sum16(x);
    asm("s_nop 1\n\tv_add_f32_dpp %0, %0, %0 row_bcast:15 row_mask:0xa bank_mask:0xf\n\ts_nop 1\n\tv_add_f32_dpp %0, %0, %0 row_bcast:31 row_mask:0xc bank_mask:0xf\n\ts_nop 0" : "+v"(x));
    return rl(x, 63); }
DI u32x4 pk8(float a, float b, float c, float d, float e, float f, float g, float h) { u32x4 w; w.x = pkh(a, b); w.y = pkh(c, d); w.z = pkh(e, f); w.w = pkh(g, h); return w; }

DI void phase_scan2(const Params& p, const Ctx& c, int l) {
    unsigned char* const ws = kws();
    const h16* RKV = (const h16*)(ws + WS_RKV); const h16* LO = (const h16*)(ws + WS_LORAO); h16* V1 = (h16*)(ws + WS_V1ST); h16* AOUT = (h16*)(ws + WS_AOUT);
    const int wave = c.wave;
    LAS unsigned char* const slot = c.lds + wave * SLOT;
    for (int u = blockIdx.x; u < NB * 8; u += c.G) {
        const int b = u >> 3, h = u & 7; const int col0 = h * 64 + lane_id();
        const float mur = kin<I_MU>()[l * 1824 + col0], muk = kin<I_MU>()[l * 1824 + 512 + col0], muv = kin<I_MU>()[l * 1824 + 1024 + col0];
        const float kkw = kin<I_KK>()[l * 512 + col0], kaw = kin<I_KA>()[l * 512 + col0], rkw = kin<I_RK>()[l * 512 + col0];
        const float lng = kin<I_LNXG>()[l * 512 + col0], lnb = kin<I_LNXB>()[l * 512 + col0];
        f32x16 Sg[2]; h16x8 sfrag[4];
#pragma unroll
        for (int i = 0; i < 16; ++i) { Sg[0][i] = 0.f; Sg[1][i] = 0.f; }
#pragma unroll
        for (int i = 0; i < 4; ++i) sfrag[i] = (h16x8){0, 0, 0, 0, 0, 0, 0, 0};
#pragma unroll 1
        for (int ss = 0; ss < SEQ / 128; ++ss) {
            const int lane = lane_id(), n = lane & 31, hh = lane >> 5, col = h * 64 + lane;
            const int t0 = 128 * ss + 16 * wave; const size_t m0 = (size_t)b * SEQ + t0;
            unsigned g12[16];
            {
                float Pin[16], vv[16];
                h16 wd[16], xr[2][8], xk[2][8], xv[2][8], xa[2][8], xg[2][8], xs[2][8], xf[2][8];
#define SC_LOAD_HALF(hb) { _Pragma("unroll") for (int tt = 0; tt < 8; ++tt) { const size_t m = m0 + 8 * (hb) + tt; const h16* q = RKV + m * NRKV + col; const h16* lp = LO + m * NLORA + col; \
                        xr[hb][tt] = q[0]; xk[hb][tt] = q[512]; xv[hb][tt] = q[1024]; xa[hb][tt] = lp[512]; xg[hb][tt] = lp[1024]; \
                        if (l != 0) { xs[hb][tt] = lp[1536]; xf[hb][tt] = V1[m * 512 + col]; } else { xs[hb][tt] = (h16)0.f; xf[hb][tt] = (h16)0.f; } } }
#pragma unroll
                for (int t = 0; t < 16; ++t) wd[t] = LO[(m0 + t) * NLORA + col];
                const h16* qprev = RKV + (m0 - (t0 > 0 ? 1 : 0)) * NRKV + col; const float zprev = (t0 > 0) ? 1.0f : 0.0f;
                const h16 pr_h = qprev[0], pk_h = qprev[512], pv_h = qprev[1024];
                SC_LOAD_HALF(0)
                asm volatile("" ::: "memory");
#pragma unroll
                for (int t = 0; t < 16; ++t) { const float wt = 1.0f - (float)wd[t]; Pin[t] = (t == 0) ? wt : Pin[t - 1] * wt; }
                const float P8 = Pin[7], iP8 = __builtin_amdgcn_rcpf(P8), P16 = Pin[15];
                const int q15 = lane & 15, pos = 16 * (lane >> 4) + 8 * ((q15 >> 2) & 1) + 4 * (q15 >> 3) + (q15 & 3);
                int xbL[8], xbP[8], xa4[4];
#pragma unroll
                for (int e = 0; e < 8; ++e) { xbL[e] = ((((2 * lane) >> 4) ^ e) << 4) | ((2 * lane) & 15); xbP[e] = ((((2 * pos) >> 4) ^ e) << 4) | ((2 * pos) & 15); }
#pragma unroll
                for (int e = 0; e < 4; ++e) xa4[e] = lane * 64 + ((e ^ ((lane >> 2) & 3)) << 4);
                {
                    float pr = (float)pr_h * zprev, pk = (float)pk_h * zprev, pv = (float)pv_h * zprev;
#pragma unroll
                    for (int hb = 0; hb < 2; ++hb) {
                    if (hb == 0) { SC_LOAD_HALF(1) asm volatile("" ::: "memory"); }
#pragma unroll
                    for (int tt = 0; tt < 8; ++tt) {
                        const int t = 8 * hb + tt; const size_t m = m0 + t;
                        const float r0 = (float)xr[hb][tt], k0 = (float)xk[hb][tt], v0 = (float)xv[hb][tt];
                        const float aa = (float)xa[hb][tt], gg = (float)xg[hb][tt], sg = (float)xs[hb][tt];
                        const float r = r0 + (pr - r0) * mur, k = k0 + (pk - k0) * muk; float v = v0 + (pv - v0) * muv;
                        pr = r0; pk = k0; pv = v0;
                        if (l == 0) V1[m * 512 + col] = (h16)v; else { const float vf = (float)xf[hb][tt]; v = v + (vf - v) * sg; }
                        const float kkr = k * kkw, kpv = k * (1.0f + (aa - 1.0f) * kaw);
                        const float ssq = sum64u(kkr * kkr), bon = sum64u(r * kpv * rkw);
                        const float kn = kkr * __builtin_amdgcn_rcpf(fmaxf(__builtin_amdgcn_sqrtf(ssq), 1e-12f)), bt = kn * aa;
                        vv[t] = v; g12[t] = pkh(lng * gg, (lnb + bon * v) * gg);
                        const float iPt = __builtin_amdgcn_rcpf(Pin[t]);
                        const float gin = Pin[t] * iP8, pex = (t == 0) ? 1.0f : Pin[t - 1], gex = pex * iP8, ig = P8 * iPt, sfx = P16 * iPt;
                        *(LAS h16*)(slot + SL_WY + t * 128 + xbL[(t >> 1) & 7]) = (h16)(bt * ig);
                        *(LAS h16*)(slot + SL_WY + (16 + t) * 128 + xbL[(t >> 1) & 7]) = (h16)(kpv * ig);
                        *(LAS h16*)(slot + SL_WY + 4096 + t * 128 + xbL[(t >> 1) & 7]) = (h16)(kn * gex);
                        *(LAS h16*)(slot + SL_WY + 4096 + (16 + t) * 128 + xbL[(t >> 1) & 7]) = (h16)(r * gin);
                        *(LAS h16*)(slot + SL_A1 + t * 128 + xbP[(t >> 1) & 7]) = (h16)(kn * pex);
                        *(LAS h16*)(slot + SL_A1 + (16 + t) * 128 + xbP[(t >> 1) & 7]) = (h16)(r * Pin[t]);
                        const int ps = 8 * ((t >> 2) & 1) + 4 * (t >> 3) + (t & 3);
                        *(LAS h16*)(slot + SL_A4 + xa4[(2 * ps) >> 4] + ((2 * ps) & 15)) = (h16)(bt * sfx);
                        *(LAS h16*)(slot + SL_A4 + xa4[2 + ((2 * ps) >> 4)] + ((2 * ps) & 15)) = (h16)(kpv * sfx);
                    }
                    }
                }
                *(LAS float*)(slot + SL_P16 + 4 * lane) = P16;
                asm volatile("s_waitcnt lgkmcnt(0)" ::: "memory");
                f32x16 G;
#pragma unroll
                for (int i = 0; i < 16; ++i) G[i] = 0.f;
#pragma unroll
                for (int ks = 0; ks < 4; ++ks) { const h16x8 af = *(const LAS h16x8*)(slot + SL_WY + sw128(n, (16 * ks + 8 * hh) * 2)), bf = *(const LAS h16x8*)(slot + SL_WY + 4096 + sw128(n, (16 * ks + 8 * hh) * 2));
                    G = __builtin_amdgcn_mfma_f32_32x32x16_f16(af, bf, G, 0, 0, 0); }
                {
                    const int t = n & 15; const bool isR = n >= 16;
                    float top[8], bot[8];
#pragma unroll
                    for (int i = 0; i < 8; ++i) { const int ip = (i & 3) + 8 * (i >> 2) + 4 * hh; const bool keep = isR ? (ip <= t) : (ip < t);
                        top[i] = keep ? G[i] : 0.f; bot[i] = keep ? (isR ? G[8 + i] : -G[8 + i]) : 0.f; }
                    asm volatile("s_waitcnt lgkmcnt(0)" ::: "memory");
                    if (isR) *(LAS u32x4*)(slot + SL_A23 + sw32(n, 16 * hh)) = pk8(top[0], top[1], top[2], top[3], top[4], top[5], top[6], top[7]);
                    *(LAS u32x4*)(slot + SL_A5 + sw32(n, 16 * hh)) = pk8(bot[0], bot[1], bot[2], bot[3], bot[4], bot[5], bot[6], bot[7]);
                    {
                        const int r16 = lane & 15; float Tr[16];
#pragma unroll
                        for (int j = 0; j < 16; ++j) { float acc = (j == r16) ? 1.0f : 0.0f;
#pragma unroll
                            for (int i = 0; i < j; ++i) acc -= rl(top[(i & 3) + 4 * (i >> 3)], j + 32 * ((i >> 2) & 1)) * Tr[i];
                            Tr[j] = acc; }
                        const int ps2 = 2 * (8 * ((r16 >> 2) & 1) + 4 * (r16 >> 3) + (r16 & 3));
                        if (lane < 16) {
#pragma unroll
                            for (int t2 = 0; t2 < 16; ++t2) *(LAS h16*)(slot + SL_A23 + sw32(t2, ps2)) = (h16)Tr[t2];
                        }
                    }
                }
                *(LAS u32x4*)(slot + SL_VT + sw32(lane, 0)) = pk8(vv[0], vv[1], vv[2], vv[3], vv[8], vv[9], vv[10], vv[11]);
                *(LAS u32x4*)(slot + SL_VT + sw32(lane, 16)) = pk8(vv[4], vv[5], vv[6], vv[7], vv[12], vv[13], vv[14], vv[15]);
                asm volatile("s_waitcnt lgkmcnt(0)" ::: "memory");
                {
                    const h16x8 a5 = *(const LAS h16x8*)(slot + SL_A5 + sw32(n, 16 * hh));
#pragma unroll
                    for (int vt = 0; vt < 2; ++vt) { const h16x8 vf = *(const LAS h16x8*)(slot + SL_VT + sw32(32 * vt + n, 16 * hh));
                        f32x16 Wm;
#pragma unroll
                        for (int i = 0; i < 16; ++i) Wm[i] = 0.f;
                        Wm = __builtin_amdgcn_mfma_f32_32x32x16_f16(a5, vf, Wm, 0, 0, 0);
                        *(LAS u32x4*)(slot + SL_WY + vt * 2048 + sw32(lane, 0)) = pk8(Wm[0], Wm[1], Wm[2], Wm[3], Wm[4], Wm[5], Wm[6], Wm[7]);
                        *(LAS u32x4*)(slot + SL_WY + vt * 2048 + sw32(lane, 16)) = pk8(Wm[8], Wm[9], Wm[10], Wm[11], Wm[12], Wm[13], Wm[14], Wm[15]); }
                }
            }
            __syncthreads();
            if (wave < 2) {
                const int vt = wave;
#pragma unroll 1
                for (int j = 0; j < 8; ++j) {
                    const LAS unsigned char* sb = c.lds + j * SLOT;
                    h16x8 a1[4], a4[2][2];
#pragma unroll
                    for (int ks = 0; ks < 4; ++ks) a1[ks] = *(const LAS h16x8*)(sb + SL_A1 + sw128(n, (16 * ks + 8 * hh) * 2));
                    const u32x4 wy0 = *(const LAS u32x4*)(sb + SL_WY + vt * 2048 + sw32(lane, 0)), wy1 = *(const LAS u32x4*)(sb + SL_WY + vt * 2048 + sw32(lane, 16));
                    const h16x8 a23 = *(const LAS h16x8*)(sb + SL_A23 + sw32(n, 16 * hh));
#pragma unroll
                    for (int kt = 0; kt < 2; ++kt)
#pragma unroll
                        for (int s2 = 0; s2 < 2; ++s2) a4[kt][s2] = *(const LAS h16x8*)(sb + SL_A4 + sw64(32 * kt + n, 32 * s2 + 16 * hh));
                    const h16x8 vf = *(const LAS h16x8*)(sb + SL_VT + sw32(32 * vt + n, 16 * hh));
                    f32x16 D1;
#pragma unroll
                    for (int i = 0; i < 16; ++i) D1[i] = 0.f;
#pragma unroll
                    for (int ks = 0; ks < 4; ++ks) D1 = __builtin_amdgcn_mfma_f32_32x32x16_f16(a1[ks], sfrag[ks], D1, 0, 0, 0);
                    const float w0v[8] = {hlo(wy0.x), hhi(wy0.x), hlo(wy0.y), hhi(wy0.y), hlo(wy0.z), hhi(wy0.z), hlo(wy0.w), hhi(wy0.w)};
                    const float y0v[8] = {hlo(wy1.x), hhi(wy1.x), hlo(wy1.y), hhi(wy1.y), hlo(wy1.z), hhi(wy1.z), hlo(wy1.w), hhi(wy1.w)};
                    const u32x4 ubw = pk8(w0v[0] - D1[0], w0v[1] - D1[1], w0v[2] - D1[2], w0v[3] - D1[3], w0v[4] - D1[4], w0v[5] - D1[5], w0v[6] - D1[6], w0v[7] - D1[7]);
                    f32x16 D2;
#pragma unroll
                    for (int i = 0; i < 16; ++i) D2[i] = 0.f;
                    D2 = __builtin_amdgcn_mfma_f32_32x32x16_f16(a23, __builtin_bit_cast(h16x8, ubw), D2, 0, 0, 0);
                    const h16x8 uf = __builtin_bit_cast(h16x8, pk8(D2[0], D2[1], D2[2], D2[3], D2[4], D2[5], D2[6], D2[7]));
                    D1 = __builtin_amdgcn_mfma_f32_32x32x16_f16(a23, uf, D1, 0, 0, 0);
#pragma unroll
                    for (int kt = 0; kt < 2; ++kt) {
                        f32x4 p16[4];
#pragma unroll
                        for (int g = 0; g < 4; ++g) p16[g] = *(const LAS f32x4*)(sb + SL_P16 + (32 * kt + 8 * g + 4 * hh) * 4);
#pragma unroll
                        for (int i = 0; i < 16; ++i) Sg[kt][i] *= p16[i >> 2][i & 3];
                        Sg[kt] = __builtin_amdgcn_mfma_f32_32x32x16_f16(a4[kt][0], uf, Sg[kt], 0, 0, 0);
                        Sg[kt] = __builtin_amdgcn_mfma_f32_32x32x16_f16(a4[kt][1], vf, Sg[kt], 0, 0, 0);
                    }
                    LAS float* yo = (LAS float*)(c.lds + j * SLOT + SL_WY + vt * 2048);
#pragma unroll
                    for (int i = 0; i < 8; ++i) { const int t = (i & 3) + 8 * (i >> 2) + 4 * hh; yo[t * 32 + n] = D1[8 + i] + y0v[i]; }
#pragma unroll
                    for (int kt = 0; kt < 2; ++kt)
#pragma unroll
                        for (int s = 0; s < 2; ++s) sfrag[2 * kt + s] = __builtin_bit_cast(h16x8, pk8(Sg[kt][8 * s], Sg[kt][8 * s + 1], Sg[kt][8 * s + 2], Sg[kt][8 * s + 3], Sg[kt][8 * s + 4], Sg[kt][8 * s + 5], Sg[kt][8 * s + 6], Sg[kt][8 * s + 7]));
                }
            }
            __syncthreads();
            {
                const LAS float* yi = (const LAS float*)(slot + SL_WY + hh * 2048);
                float yv[16];
#pragma unroll
                for (int t = 0; t < 16; ++t) yv[t] = yi[t * 32 + n];
#pragma unroll
                for (int t = 0; t < 16; ++t) {
                    const float mean = sum64u(yv[t]) * (1.0f / 64.0f), dv = yv[t] - mean, var = sum64u(dv * dv) * (1.0f / 64.0f);
                    const float o = dv * rsqrtf(var + LNX_EPS) * hlo(g12[t]) + hhi(g12[t]);
                    AOUT[(m0 + t) * KOUT + 512 + col] = (h16)o;
                }
            }
            asm volatile("s_waitcnt lgkmcnt(0)" ::: "memory");
        }
        __syncthreads();
    }
}

constexpr int STEPS_PER_LAYER = 10, NSTEPS = 2 + NL * STEPS_PER_LAYER;
#define IN(k) (lo <= (k) && (k) < hi)
#define SEAM(k) do { if (IN(k) && IN((k) + 1)) xcd_barrier(bar, c.wave); } while (0)
template <int l>
DI void layer_steps(const Params& p, const Ctx& c, const XcdBarrier& bar, const int lo, const int hi) {
        const int s0 = 2 + l * STEPS_PER_LAYER;
        if (IN(s0 + 0)) { unsigned char* const ws = kws();
            pg8::Gemm g{(const h16*)(ws + WS_H), (const h16*)(ws + wofs(l) + WT_IN), MT, NIN, DM, DM, DM}; pg8::StaticOrder S; S.init(MT, NIN, c.G, (int)blockIdx.x);
            pg8::EpiH16 E{(h16*)(ws + WS_COLSA), NCA, 3, (h16*)(ws + WS_RKV), NRKV};
            pg8::gemm_phase(c.lds, g, S, E, c.wave);
            if (l + 1 < NL && c.G > NB * 8 && blockIdx.x >= NB * 8) { __syncthreads(); Ctx c2 = c; c2.gw = (blockIdx.x - NB * 8) * 8 + c.wave; c2.ngw = (c.G - NB * 8) * 8; phase_wconv(p, c2, l + 1, 1); }
        }
        SEAM(s0 + 0);
        if (IN(s0 + 1)) phase_prep(p, c, l);
        SEAM(s0 + 1);
        if (IN(s0 + 2)) { unsigned char* const ws = kws();
            { pg8::Gemm g{(const h16*)(ws + WS_CQ), (const h16*)(ws + wofs(l) + WT_Q), MT, NQ, 256, 256, 256}; pg8::StaticOrder S; S.init(MT, NQ, c.G, (int)blockIdx.x);
              pg8::EpiQ E{(h16*)kout()};
              pg8::gemm_phase(c.lds, g, S, E, c.wave); }
            {
              pg8::Gemm g{(const h16*)(ws + WS_ALORA), (const h16*)(ws + wofs(l) + WT_LORA), MT, 1024, 128, KLORA, 128}; pg8::StaticOrder S; S.init(MT, 1024, c.G, (int)blockIdx.x);
              pg8::EpiLora E{(h16*)(ws + WS_LORAO), kin<I_W0>() + l * 512, kin<I_A0>() + l * 512, kin<I_V0>() + (l > 0 ? l - 1 : 0) * 512, l > 0 ? 1 : 0, 0};
              pg8::gemm_phase(c.lds, g, S, E, c.wave); }
            {
              constexpr int N2 = (l > 0) ? 1024 : 512;
              pg8::Gemm g{(const h16*)(ws + WS_ALORA) + 128, (const h16*)(ws + wofs(l) + WT_LORA) + 1024 * 128, MT, N2, 256, KLORA, 256}; pg8::StaticOrder S; S.init(MT, N2, c.G, (int)blockIdx.x);
              pg8::EpiLora E{(h16*)(ws + WS_LORAO), kin<I_W0>() + l * 512, kin<I_A0>() + l * 512, kin<I_V0>() + (l > 0 ? l - 1 : 0) * 512, l > 0 ? 1 : 0, 4};
              pg8::gemm_phase(c.lds, g, S, E, c.wave); }
        }
        SEAM(s0 + 2);
        if (IN(s0 + 3)) { unsigned char* const ws = kws(); if (blockIdx.x < NB * 8) { phase_scan2(p, c, l); __syncthreads(); }
            else if (l + 1 < NL) { Ctx c2 = c; c2.gw = (blockIdx.x - NB * 8) * 8 + c.wave; c2.ngw = (c.G - NB * 8) * 8; phase_wconv(p, c2, l + 1, 2); __syncthreads(); }
            phase_select(p, c, (unsigned*)(ws + WS_CTL) + 8192 + 64 * l); }
        SEAM(s0 + 3);
        if (IN(s0 + 4)) { unsigned char* const ws = kws(); phase_attn(p, c, (unsigned*)(ws + WS_CTL) + 8192 + 64 * l + 16, l); }
        SEAM(s0 + 4);
        if (IN(s0 + 5)) { unsigned char* const ws = kws();
            pg8::Gemm g{(const h16*)(ws + WS_AOUT), (const h16*)(ws + wofs(l) + WT_OUT), MT, DM, KOUT, KOUT, KOUT}; pg8::StaticOrder S; S.init(MT, DM, c.G, (int)blockIdx.x);
            pg8::EpiH16 E{(h16*)(ws + WS_Y), DM, 1000, nullptr, 0};
            pg8::gemm_phase(c.lds, g, S, E, c.wave);
        }
        SEAM(s0 + 5);
        if (IN(s0 + 6)) phase_rows<1, true, false>(p, c, (const h16*)(kws() + WS_Y), kin<I_POSTMIX>() + l * DM, 2048, l, kin<I_PREFFN>() + l * DM, 3072, 4096, l, -1);
        SEAM(s0 + 6);
        if (IN(s0 + 7)) { unsigned char* const ws = kws();
            pg8::Gemm g{(const h16*)(ws + WS_H), (const h16*)(ws + wofs(l) + WT_FC), MT, NFC, DM, DM, DM}; pg8::StaticOrder S; S.init(MT, NFC, c.G, (int)blockIdx.x);
            pg8::EpiSwiglu E{(h16*)(ws + WS_HID)};
            pg8::gemm_phase(c.lds, g, S, E, c.wave);
        }
        SEAM(s0 + 7);
        if (IN(s0 + 8)) { unsigned char* const ws = kws();
            pg8::Gemm g{(const h16*)(ws + WS_HID), (const h16*)(ws + wofs(l) + WT_DOWN), MT, DM, DFF, DFF, DFF}; pg8::StaticOrder S; S.init(MT, DM, c.G, (int)blockIdx.x);
            pg8::EpiH16 E{(h16*)(ws + WS_Y2), DM, 1000, nullptr, 0};
            pg8::gemm_phase(c.lds, g, S, E, c.wave);
        }
        SEAM(s0 + 8);
        if (IN(s0 + 9)) { unsigned char* const ws = kws();
            if (l + 1 < NL) { phase_rows<1, true, true>(p, c, (const h16*)(ws + WS_Y2), kin<I_POSTFFN>() + l * DM, 5120, l, kin<I_PREMIX>() + (l + 1) * DM, 0, 1024, l + 1, l + 1);
                              if (c.G <= NB * 8) { __syncthreads(); phase_wconv(p, c, l + 1); } }
            else phase_rows<1, false, false>(p, c, (const h16*)(ws + WS_Y2), kin<I_POSTFFN>() + l * DM, 5120, l, nullptr, 0, 0, 0, -1);
        }
        SEAM(s0 + 9);
    }
#undef IN
#undef SEAM

__global__ void __launch_bounds__(NTHR, 2) fwd_kernel(Params p) {
    extern __shared__ __attribute__((aligned(16))) unsigned char lds_raw[];
    Ctx c; c.lds = (LAS unsigned char*)lds_raw; c.wave = __builtin_amdgcn_readfirstlane((int)threadIdx.x >> 6);
    c.G = gridDim.x; c.gw = blockIdx.x * 8 + c.wave; c.ngw = c.G * 8;
    volatile LAS unsigned* misc = (volatile LAS unsigned*)(c.lds + LDS_MISC);
    if (c.wave == 0) misc[lane_id()] = 0u;
    __syncthreads();
    unsigned* ctl = (unsigned*)(kws() + WS_CTL);
    XcdBarrier bar; bar.bar = ctl; bar.x = 0; bar.st = nullptr;
    const bool multi = (p.step_hi - p.step_lo) > 1;
    if (multi) bar = xcd_barrier_post(ctl, misc + 8, c.wave);
    const int lo = p.step_lo, hi = p.step_hi;
#define IN(k) (lo <= (k) && (k) < hi)
#define SEAM(k) do { if (IN(k) && IN((k) + 1)) xcd_barrier(bar, c.wave); } while (0)

    if (IN(0)) { phase_mod(p, c); __syncthreads(); phase_wconv(p, c, 0); }
    SEAM(0);
    if (IN(1)) phase_rows<0, true, true>(p, c, nullptr, nullptr, 0, 0, kin<I_PREMIX>(), 0, 1024, 0, 0);
    SEAM(1);
    layer_steps<0>(p, c, bar, lo, hi);
    layer_steps<1>(p, c, bar, lo, hi);
    layer_steps<2>(p, c, bar, lo, hi);
    layer_steps<3>(p, c, bar, lo, hi);
#undef IN
#undef SEAM
}

extern "C" void kernel_launch(void* const* d_in, const int* in_sizes, int n_in, void* d_out, int out_size, void* d_ws, size_t ws_size, hipStream_t stream) {
    static int grid = 0;
    if (grid == 0) {
        if (n_in != 35 || out_size != MT * DM || ws_size < WS_NEED) { fprintf(stderr, "kernel_launch: unexpected problem (n_in %d out %d ws %zu)\n", n_in, out_size, ws_size); grid = -1; return; }
        int dev = 0, cus = 0, per_cu = 0;
        if (hipGetDevice(&dev) != hipSuccess || hipDeviceGetAttribute(&cus, hipDeviceAttributeMultiprocessorCount, dev) != hipSuccess) { grid = -1; return; }
        if (hipFuncSetAttribute((const void*)fwd_kernel, hipFuncAttributeMaxDynamicSharedMemorySize, LDS_BYTES) != hipSuccess) { fprintf(stderr, "kernel_launch: hipFuncSetAttribute failed\n"); grid = -1; return; }
        if (hipOccupancyMaxActiveBlocksPerMultiprocessor(&per_cu, (const void*)fwd_kernel, NTHR, LDS_BYTES) != hipSuccess || per_cu < 1) { fprintf(stderr, "kernel_launch: occupancy query says %d\n", per_cu); (void)hipGetLastError(); per_cu = 1; }
        grid = cus;
        if (grid > 256) grid = 256;
    }
    if (grid < 0) return;
    (void)hipMemsetAsync((char*)d_ws + WS_CTL, 0, CTL_BYTES, stream);
    Params p{};
    for (int i = 0; i < 35; ++i) p.in[i] = (const float*)d_in[i];
    p.out = (float*)d_out; p.ws = (unsigned char*)d_ws;
#if MK_PER_STEP_LAUNCH
    for (int s = 0; s < NSTEPS; ++s) { p.step_lo = s; p.step_hi = s + 1; hipLaunchKernelGGL(fwd_kernel, dim3(grid), dim3(NTHR), LDS_BYTES, stream, p); }
#else
    p.step_lo = 0; p.step_hi = NSTEPS;
    hipLaunchKernelGGL(fwd_kernel, dim3(grid), dim3(NTHR), LDS_BYTES, stream, p);
#endif
}
```

```cpp
#include <hip/hip_runtime.h>
#include <cstdio>
#include <cstdint>

#ifndef MK_PER_STEP_LAUNCH
#define MK_PER_STEP_LAUNCH 0
#endif

#define DI __device__ __forceinline__
#define LAS __attribute__((address_space(3)))
typedef _Float16 h16;
typedef h16 h16x8 __attribute__((ext_vector_type(8)));
typedef h16 h16x4 __attribute__((ext_vector_type(4)));
typedef h16 h16x2 __attribute__((ext_vector_type(2)));
typedef float f32x2 __attribute__((ext_vector_type(2)));
typedef float f32x4 __attribute__((ext_vector_type(4)));
typedef float f32x16 __attribute__((ext_vector_type(16)));
typedef unsigned u32x2 __attribute__((ext_vector_type(2)));
typedef unsigned u32x4 __attribute__((ext_vector_type(4)));
typedef int i32x4 __attribute__((ext_vector_type(4)));

constexpr int NB = 16, SEQ = 2048, DM = 1024, NL = 4, MT = NB * SEQ;
constexpr int PIN = 2276;
constexpr int NCA = 768, NRKV = 1536, NIN = NCA + NRKV;
constexpr int WC_NOQ = (2816 / 64) * (1024 / 32) + 16 * (1024 / 32), WC_NIT = WC_NOQ + 16 * ((768 + 1536) / 32) + 16 * (5632 / 32), WC_P1 = 0, NIN16 = 512;
constexpr int NQ = 1280, KLORA = 384, NLORA = 2048, KOUT = 1024, NFC = 5632, DFF = 2816;
constexpr float NORM_EPS = 1e-6f, LNX_EPS = 64e-5f;

constexpr size_t MiB = 1u << 20;
constexpr size_t WS_CTL = 0, CTL_BYTES = 64 * 1024;
constexpr size_t WS_MOD = 1 * MiB;
constexpr size_t WS_WIDX = 3 * MiB;
constexpr size_t WS_RS = 3 * MiB + 512 * 1024;
constexpr size_t WS_H8IN = 148 * MiB;
constexpr size_t WS_KIDX = 4 * MiB;
constexpr size_t WS_CKV = 8 * MiB;
constexpr size_t WS_CKVT = 16 * MiB;
constexpr size_t WS_V1ST = 24 * MiB;
constexpr size_t WS_WTS = 56 * MiB;
constexpr size_t WT_IN = WS_WTS, WT_Q = WT_IN + (size_t)NIN * DM * 2, WT_LORA = WT_Q + (size_t)NQ * 256 * 2, WT_OUT = WT_LORA + (size_t)NLORA * KLORA * 2,
                 WT_VUP = WT_OUT + (size_t)DM * KOUT * 2  , WT_FC = WT_OUT + (size_t)DM * 1536 * 2, WT_DOWN = WT_FC + (size_t)NFC * DM * 2, WT_END = WT_DOWN + (size_t)DM * DFF * 2;
static_assert(WT_END <= 84 * MiB, "weights region");
constexpr size_t WS_H = 84 * MiB;
constexpr size_t WS_CQ = 148 * MiB;
constexpr size_t WS_ALORA = 164 * MiB;
constexpr size_t WS_AOUT = 84 * MiB;
constexpr size_t WS_RKV = 188 * MiB;
constexpr size_t WS_COLSA = 284 * MiB;
constexpr size_t WS_LORAO = 284 * MiB;
constexpr size_t WS_X16 = 412 * MiB;
constexpr size_t WS_Y = 188 * MiB;
constexpr size_t WS_HID = 188 * MiB;
constexpr size_t WS_Y2 = 84 * MiB;
constexpr size_t WS_MASK = 476 * MiB;
constexpr size_t WS_WTS2 = 484 * MiB;
constexpr size_t WS_NEED = 484 * MiB + (84 - 56) * MiB;
DI size_t wofs(int l) { return (l & 1) ? (WS_WTS2 - WS_WTS) : 0; }

constexpr int LDS_BYTES = 147456;
constexpr int LDS_MISC = LDS_BYTES - 256;
constexpr int NTHR = 512;

DI unsigned pkh(float a, float b) { h16x2 v; v.x = (h16)a; v.y = (h16)b; return __builtin_bit_cast(unsigned, v); }
DI unsigned pkb(float lo, float hi) { unsigned r; asm("v_cvt_pk_bf16_f32 %0, %1, %2" : "=v"(r) : "v"(lo), "v"(hi)); return r; }
DI float hlo(unsigned u) { h16x2 v = __builtin_bit_cast(h16x2, u); return (float)v.x; }
DI float hhi(unsigned u) { h16x2 v = __builtin_bit_cast(h16x2, u); return (float)v.y; }
DI float h2f(unsigned short s) { return (float)__builtin_bit_cast(h16, s); }
DI unsigned short f2h(float f) { return __builtin_bit_cast(unsigned short, (h16)f); }
template <int CTRL> DI float dppf(float x) { return __builtin_bit_cast(float, __builtin_amdgcn_update_dpp(0, __builtin_bit_cast(int, x), CTRL, 0xf, 0xf, false)); }
template <int CTRL> DI unsigned dppu(unsigned x) { return (unsigned)__builtin_amdgcn_update_dpp(0, (int)x, CTRL, 0xf, 0xf, false); }
template <int CTRL, int RM> DI unsigned dppu_rm(unsigned x) { return (unsigned)__builtin_amdgcn_update_dpp(0, (int)x, CTRL, RM, 0xf, false); }
DI unsigned umax_(unsigned a, unsigned b) { return a > b ? a : b; }
DI unsigned max64u(unsigned x) {
    x = umax_(x, dppu<0xB1>(x)); x = umax_(x, dppu<0x4E>(x)); x = umax_(x, dppu<0x141>(x)); x = umax_(x, dppu<0x140>(x));
    x = umax_(x, dppu_rm<0x142, 0xA>(x)); x = umax_(x, dppu_rm<0x143, 0xC>(x)); return (unsigned)__builtin_amdgcn_readlane((int)x, 63);
}
DI float sum4(float x) { x += dppf<0xB1>(x); x += dppf<0x4E>(x); return x; }
DI float sum8(float x) { x = sum4(x); x += dppf<0x141>(x); return x; }
DI float sum16(float x) { x = sum8(x); x += dppf<0x140>(x); return x; }
DI unsigned usum16(unsigned x) { x += dppu<0xB1>(x); x += dppu<0x4E>(x); x += dppu<0x141>(x); x += dppu<0x140>(x); return x; }
DI float sum64(float x) { x = sum16(x); x += __shfl_xor(x, 16); x += __shfl_xor(x, 32); return x; }
DI int lane_id() { int l; asm volatile("v_mbcnt_lo_u32_b32 %0, -1, 0\n\tv_mbcnt_hi_u32_b32 %0, -1, %0" : "=v"(l)); return l; }
DI float sigmoidf_(float z) { return __builtin_amdgcn_rcpf(1.0f + __expf(-z)); }
DI float tanhf_(float z) { return 1.0f - 2.0f * __builtin_amdgcn_rcpf(1.0f + __expf(2.0f * z)); }

#define XB_TMO      128
#define XB_XCNT(j)  (256  + 64 * (j))
#define XB_XSUB(j)  (1280 + 64 * (j))
#define XB_XGEN(j)  (2304 + 64 * (j))
#define XB_TOP      3328
#define XB_TOPGEN   3392
#define XCD_BAR_WORDS 3456
#define XB_SPIN_CAP (1u << 18)
DI unsigned xb_ld(unsigned* p)              { return __hip_atomic_load(p, __ATOMIC_RELAXED, __HIP_MEMORY_SCOPE_AGENT); }
DI unsigned xb_add(unsigned* p, unsigned v) { return __hip_atomic_fetch_add(p, v, __ATOMIC_RELAXED, __HIP_MEMORY_SCOPE_AGENT); }
DI unsigned xb_xcc_id() { return (unsigned)__builtin_amdgcn_s_getreg((3 << 11) | 20) & 0xFu; }
#define XB_SPIN(cond, bar) do { unsigned _sp = 0; while (cond) { __builtin_amdgcn_s_sleep(1); \
    if ((++_sp & 255u) == 0u) { if (xb_ld(&(bar)[XB_TMO])) break; if (_sp > XB_SPIN_CAP) { atomicAdd(&(bar)[XB_TMO], 1u); break; } } } } while (0)
struct XcdBarrier { unsigned* bar; unsigned x; volatile LAS unsigned* st; };
DI XcdBarrier xcd_barrier_post(unsigned* bar, volatile LAS unsigned* st, int wave) {
    XcdBarrier b; b.bar = bar; b.x = xb_xcc_id(); b.st = st;
    if (wave == 0 && lane_id() == 0) (void)xb_add(&bar[XB_XCNT(b.x)], 1u);
    return b;
}
DI void xcd_barrier_complete(unsigned* bar, unsigned x, unsigned& nloc, unsigned& nx) {
    const unsigned G = gridDim.x * gridDim.y * gridDim.z;
    unsigned sum, cnt, mine, sp = 0u;
    for (;;) {
        sum = 0u; cnt = 0u; mine = 0u;
#pragma unroll
        for (unsigned j = 0; j < 16; ++j) { const unsigned c = xb_ld(&bar[XB_XCNT(j)]); sum += c; cnt += (c > 0u) ? 1u : 0u; mine = (j == x) ? c : mine; }
        if (sum == G) break;
        __builtin_amdgcn_s_sleep(1);
        if ((++sp & 255u) == 0u) { if (xb_ld(&bar[XB_TMO])) break; if (sp > XB_SPIN_CAP) { atomicAdd(&bar[XB_TMO], 1u); break; } }
    }
    nloc = mine > 0u ? mine : 1u; nx = cnt > 0u ? cnt : 1u;
}
DI void xcd_barrier(const XcdBarrier& b, int wave) {
    asm volatile("s_waitcnt vmcnt(0)" ::: "memory");
    __syncthreads();
    if (wave == 0 && lane_id() == 0) {
        unsigned* bar = b.bar;
        __builtin_amdgcn_s_waitcnt(0);
        unsigned nloc = b.st[0], nx = b.st[1];
        if (nloc == 0u) { xcd_barrier_complete(bar, b.x, nloc, nx); b.st[0] = nloc; b.st[1] = nx; }
        const unsigned old = xb_add(&bar[XB_XSUB(b.x)], 1u);
        const unsigned gen = old / nloc;
        if (old + 1u == (gen + 1u) * nloc) {
            __builtin_amdgcn_fence(__ATOMIC_RELEASE, "agent");
            asm volatile("s_waitcnt vmcnt(0)" ::: "memory");
            const unsigned og = xb_add(&bar[XB_TOP], 1u);
            const unsigned tg = og / nx;
            if (og + 1u == (tg + 1u) * nx) xb_add(&bar[XB_TOPGEN], 1u);
            else XB_SPIN(xb_ld(&bar[XB_TOPGEN]) == tg, bar);
            __builtin_amdgcn_fence(__ATOMIC_ACQUIRE, "agent");
            xb_add(&bar[XB_XGEN(b.x)], 1u);
            asm volatile("s_waitcnt vmcnt(0)" ::: "memory");
        } else {
            XB_SPIN(xb_ld(&bar[XB_XGEN(b.x)]) == gen, bar);
            __builtin_amdgcn_fence(__ATOMIC_ACQUIRE, "agent");
            asm volatile("s_waitcnt vmcnt(0)" ::: "memory");
        }
    }
    __syncthreads();
}

namespace pg8 {
constexpr int BM = 256, BK = 64, HALF = 128, HTB = HALF * BK * 2, STAGE_BYTES = 8 * HTB, NXCD = 8, WGM = 8;
DI int lds_byte(int r, int c) { const int st = (r >> 4) * 2 + (c >> 5), rr = r & 15, cc = c & 31, ob = rr * 64 + cc * 2; return st * 1024 + (ob ^ (((ob >> 9) & 1) << 5)); }
DI void stage_rc(int b, int& R, int& C) { const int st = b / 1024, sb = b % 1024, swz = sb ^ (((sb >> 9) & 1) << 5); R = (st >> 1) * 16 + swz / 64; C = (st & 1) * 32 + (swz % 64) / 2; }
DI int perm32(int rho) { const int n = rho >> 4, i = rho & 15; return 8 * (i >> 2) + 4 * n + (i & 3); }
struct Unit { int pm, pn; };
struct Gemm { const h16* A; const h16* Bt; int M, N, K, lda, ldb; };
struct StaticOrder {
    int nM, nN, nwg, G, c;
    DI void init(int M, int N, int G_, int c_) { nM = M / BM; nN = N / BM; nwg = nM * nN; G = G_; c = c_; }
    DI bool next(int i, Unit& u) const {
        const long L = (long)i * G + c; if (L >= nwg) return false;
        int wgid = (int)L; { const int q = nwg / NXCD, r = nwg % NXCD, xcd = wgid % NXCD, off = wgid / NXCD; wgid = (xcd < r ? xcd * (q + 1) : r * (q + 1) + (xcd - r) * q) + off; }
        const int nig = WGM * nN, gid = wgid / nig, fm = gid * WGM, gsz = (nM - fm) < WGM ? (nM - fm) : WGM;
        u.pm = fm + ((wgid % nig) % gsz); u.pn = (wgid % nig) / gsz; return true;
    }
};
struct EpiF32 {
    static constexpr bool PERM = false; typedef f32x4 acc_t;
    float* C; int ldc;
    DI void operator()(const f32x4 (&acc)[2][2][4][2], const Unit& u, int wr, int wc, int fr, int fq) const {
        const int row0 = u.pm * BM + wr * 64 + fr, col0 = u.pn * BM + wc * 32 + 4 * fq;
#pragma unroll
        for (int ai = 0; ai < 2; ++ai)
#pragma unroll
            for (int m = 0; m < 4; ++m) { float* rowp = C + (size_t)(row0 + ai * HALF + m * 16) * ldc + col0;
#pragma unroll
                for (int bj = 0; bj < 2; ++bj)
#pragma unroll
                    for (int n = 0; n < 2; ++n) *(f32x4*)(rowp + bj * HALF + n * 16) = acc[ai][bj][m][n]; }
    }
};
struct EpiH16 {
    static constexpr bool PERM = true; typedef f32x4 acc_t;
    h16* O0; int ld0; int nsplit; h16* O1; int ld1;
    DI void operator()(const f32x4 (&acc)[2][2][4][2], const Unit& u, int wr, int wc, int fr, int fq) const {
        const int row0 = u.pm * BM + wr * 64 + fr;
        h16* base; int ld, colt;
        if (u.pn < nsplit) { base = O0; ld = ld0; colt = u.pn * BM; } else { base = O1; ld = ld1; colt = (u.pn - nsplit) * BM; }
        const int col0 = colt + wc * 32 + 8 * fq;
#pragma unroll
        for (int ai = 0; ai < 2; ++ai)
#pragma unroll
            for (int m = 0; m < 4; ++m) { h16* rowp = base + (size_t)(row0 + ai * HALF + m * 16) * ld + col0;
#pragma unroll
                for (int bj = 0; bj < 2; ++bj) { const f32x4 v0 = acc[ai][bj][m][0], v1 = acc[ai][bj][m][1];
                    u32x4 w; w.x = pkh(v0[0], v0[1]); w.y = pkh(v0[2], v0[3]); w.z = pkh(v1[0], v1[1]); w.w = pkh(v1[2], v1[3]);
                    *(u32x4*)(rowp + bj * HALF) = w; } }
    }
};
struct EpiH16I8 {
    static constexpr bool PERM = true; typedef i32x4 acc_t;
    h16* O0; int ld0; int nsplit; h16* O1; int ld1; const float* rs; float wsc;
    DI void operator()(const i32x4 (&acc)[2][2][4][2], const Unit& u, int wr, int wc, int fr, int fq) const {
        const int row0 = u.pm * BM + wr * 64 + fr;
        h16* base; int ld, colt;
        if (u.pn < nsplit) { base = O0; ld = ld0; colt = u.pn * BM; } else { base = O1; ld = ld1; colt = (u.pn - nsplit) * BM; }
        const int col0 = colt + wc * 32 + 8 * fq;
#pragma unroll
        for (int ai = 0; ai < 2; ++ai)
#pragma unroll
            for (int m = 0; m < 4; ++m) { const int row = row0 + ai * HALF + m * 16; h16* rowp = base + (size_t)row * ld + col0; const float sc = rs[row] * wsc;
#pragma unroll
                for (int bj = 0; bj < 2; ++bj) { const i32x4 v0 = acc[ai][bj][m][0], v1 = acc[ai][bj][m][1];
                    u32x4 w; w.x = pkh((float)v0[0] * sc, (float)v0[1] * sc); w.y = pkh((float)v0[2] * sc, (float)v0[3] * sc); w.z = pkh((float)v1[0] * sc, (float)v1[1] * sc); w.w = pkh((float)v1[2] * sc, (float)v1[3] * sc);
                    *(u32x4*)(rowp + bj * HALF) = w; } }
    }
};
struct EpiQ {
    static constexpr bool PERM = true; typedef f32x4 acc_t;
    h16* O;
    DI void operator()(const f32x4 (&acc)[2][2][4][2], const Unit& u, int wr, int wc, int fr, int fq) const {
        const int row0 = u.pm * BM + wr * 64 + fr, col0 = u.pn * BM + wc * 32 + 8 * fq; const bool bf = u.pn < 4;
#pragma unroll
        for (int ai = 0; ai < 2; ++ai)
#pragma unroll
            for (int m = 0; m < 4; ++m) { h16* rowp = O + (size_t)(row0 + ai * HALF + m * 16) * NQ + col0;
#pragma unroll
                for (int bj = 0; bj < 2; ++bj) { const f32x4 v0 = acc[ai][bj][m][0], v1 = acc[ai][bj][m][1]; u32x4 w;
                    if (bf) { w.x = pkb(v0[0], v0[1]); w.y = pkb(v0[2], v0[3]); w.z = pkb(v1[0], v1[1]); w.w = pkb(v1[2], v1[3]); }
                    else { w.x = pkh(v0[0], v0[1]); w.y = pkh(v0[2], v0[3]); w.z = pkh(v1[0], v1[1]); w.w = pkh(v1[2], v1[3]); }
                    *(u32x4*)(rowp + bj * HALF) = w; } }
    }
};
struct EpiLora {
    static constexpr bool PERM = true; typedef f32x4 acc_t;
    h16* O; const float* w0; const float* a0; const float* v0; int has_v; int pn_off;
    DI void operator()(const f32x4 (&acc)[2][2][4][2], const Unit& u, int wr, int wc, int fr, int fq) const {
        const int pnt = u.pn + pn_off; const int row0 = u.pm * BM + wr * 64 + fr; const int type = pnt >> 1;
        const int col0 = pnt * BM + wc * 32 + 8 * fq, j0 = (pnt & 1) * BM + wc * 32 + 8 * fq;
        float bias[2][8];
#pragma unroll
        for (int bj = 0; bj < 2; ++bj)
#pragma unroll
            for (int e = 0; e < 8; ++e) { const int j = j0 + bj * HALF + e; bias[bj][e] = type == 0 ? w0[j] : type == 1 ? a0[j] : (type == 3 && has_v) ? v0[j] : 0.f; }
        if (type == 0) body<0>(acc, bias, row0, col0); else if (type == 2) body<2>(acc, bias, row0, col0); else body<1>(acc, bias, row0, col0);
    }
    template <int TYPE> DI void body(const f32x4 (&acc)[2][2][4][2], const float (&bias)[2][8], const int row0, const int col0) const {
#pragma unroll
        for (int ai = 0; ai < 2; ++ai)
#pragma unroll
            for (int m = 0; m < 4; ++m) { h16* rowp = O + (size_t)(row0 + ai * HALF + m * 16) * NLORA + col0;
#pragma unroll
                for (int bj = 0; bj < 2; ++bj) { float v[8];
#pragma unroll
                    for (int e = 0; e < 8; ++e) { const float z = acc[ai][bj][m][e >> 2][e & 3] + bias[bj][e];
                        float o;
                        if (TYPE == 0) { const float ee = 0.6065306597126334f * sigmoidf_(z); o = 1.0f - __expf(-ee); }
                        else if (TYPE == 2) o = z;
                        else o = sigmoidf_(z);
                        v[e] = o; }
                    u32x4 w; w.x = pkh(v[0], v[1]); w.y = pkh(v[2], v[3]); w.z = pkh(v[4], v[5]); w.w = pkh(v[6], v[7]);
                    *(u32x4*)(rowp + bj * HALF) = w; asm volatile("" ::: "memory"); } }
    }
};
struct EpiSwiglu {
    static constexpr bool PERM = true; typedef f32x4 acc_t;
    h16* O;
    DI void operator()(const f32x4 (&acc)[2][2][4][2], const Unit& u, int wr, int wc, int fr, int fq) const {
        const int row0 = u.pm * BM + wr * 64 + fr, col0 = u.pn * HALF + wc * 32 + 8 * fq;
#pragma unroll
        for (int ai = 0; ai < 2; ++ai)
#pragma unroll
            for (int m = 0; m < 4; ++m) { h16* rowp = O + (size_t)(row0 + ai * HALF + m * 16) * DFF + col0; float v[8];
#pragma unroll
                for (int e = 0; e < 8; ++e) { const float g = acc[ai][0][m][e >> 2][e & 3], up = acc[ai][1][m][e >> 2][e & 3]; v[e] = g * sigmoidf_(g) * up; }
                u32x4 w; w.x = pkh(v[0], v[1]); w.y = pkh(v[2], v[3]); w.z = pkh(v[4], v[5]); w.w = pkh(v[6], v[7]);
                *(u32x4*)rowp = w; }
    }
};
struct EpiSwigluI8 {
    static constexpr bool PERM = true; typedef i32x4 acc_t;
    h16* O; const float* rs; float wsc;
    DI void operator()(const i32x4 (&acc)[2][2][4][2], const Unit& u, int wr, int wc, int fr, int fq) const {
        const int row0 = u.pm * BM + wr * 64 + fr, col0 = u.pn * HALF + wc * 32 + 8 * fq;
#pragma unroll
        for (int ai = 0; ai < 2; ++ai)
#pragma unroll
            for (int m = 0; m < 4; ++m) { const int row = row0 + ai * HALF + m * 16; h16* rowp = O + (size_t)row * DFF + col0; float v[8];
                const float sc = rs[row] * wsc;
#pragma unroll
                for (int e = 0; e < 8; ++e) { const float g = (float)acc[ai][0][m][e >> 2][e & 3] * sc, up = (float)acc[ai][1][m][e >> 2][e & 3] * sc; v[e] = g * sigmoidf_(g) * up; }
                u32x4 w; w.x = pkh(v[0], v[1]); w.y = pkh(v[2], v[3]); w.z = pkh(v[4], v[5]); w.w = pkh(v[6], v[7]);
                *(u32x4*)rowp = w; }
    }
};
DI f32x4 mma_(const h16x8 b, const h16x8 a, const f32x4 c) { return __builtin_amdgcn_mfma_f32_16x16x32_f16(b, a, c, 0, 0, 0); }
DI i32x4 mma_(const h16x8 b, const h16x8 a, const i32x4 c) { return __builtin_amdgcn_mfma_i32_16x16x64_i8(__builtin_bit_cast(i32x4, b), __builtin_bit_cast(i32x4, a), c, 0, 0, 0); }

template <class Epi>
DI void gemm_phase(LAS unsigned char* lds, const Gemm g, const StaticOrder& S, const Epi& E, const int wid) {
    const int lane = lane_id(), tid = wid * 64 + lane, wr = wid >> 2, wc = wid & 3, fr = lane & 15, fq = lane >> 4;
    const int K = g.K, nt = K / BK;
    unsigned voffA[2], voffB[2];
#pragma unroll
    for (int i = 0; i < 2; ++i) { int R, C; stage_rc(tid * 16 + i * 8192, R, C); const int Rb = Epi::PERM ? ((R & ~31) + perm32(R & 31)) : R;
        voffA[i] = (unsigned)(R * g.lda + C) * 2u; voffB[i] = (unsigned)(Rb * g.ldb + C) * 2u; }
    const size_t kstep = (size_t)(BK * 2);
    const size_t hstepA = (size_t)HALF * g.lda * 2, hstepB = (size_t)HALF * g.ldb * 2;
    const size_t tstepA = 2 * hstepA, tstepB = 2 * hstepB;
    const unsigned ldsw = (unsigned)wid * 1024u;
    const int aoff = lds_byte(wr * 64 + fr, fq * 8), boff = lds_byte(wc * 32 + fr, fq * 8);
#define PG8_SA(b, h) (((b) * 2 + (h)) * HTB)
#define PG8_SB(b, h) ((4 + (b) * 2 + (h)) * HTB)
#define PG8_STAGE(bufoff, gbase, voff) do { _Pragma("unroll") for (int _i = 0; _i < 2; ++_i) \
        __builtin_amdgcn_global_load_lds((const unsigned*)((const char*)(gbase) + (voff)[_i]), (LAS unsigned*)(lds + (bufoff) + ldsw + _i * 8192), 16, 0, 0); } while (0)
#define PG8_LDA(dst, b, h) do { _Pragma("unroll") for (int m = 0; m < 4; ++m) _Pragma("unroll") for (int k = 0; k < 2; ++k) dst[m][k] = *(const LAS h16x8*)(lds + PG8_SA(b, h) + aoff + m * 2048 + k * 1024); } while (0)
#define PG8_LDB(dst, b, h) do { _Pragma("unroll") for (int n = 0; n < 2; ++n) _Pragma("unroll") for (int k = 0; k < 2; ++k) dst[n][k] = *(const LAS h16x8*)(lds + PG8_SB(b, h) + boff + n * 2048 + k * 1024); } while (0)
#define PG8_MMA(ai, bj, At, Bt) do { __builtin_amdgcn_s_setprio(1); _Pragma("unroll") for (int m = 0; m < 4; ++m) _Pragma("unroll") for (int n = 0; n < 2; ++n) _Pragma("unroll") for (int k = 0; k < 2; ++k) \
        acc[ai][bj][m][n] = mma_(Bt[n][k], At[m][k], acc[ai][bj][m][n]); __builtin_amdgcn_s_setprio(0); } while (0)
#define PG8_WAIT_V(n) asm volatile("s_waitcnt vmcnt(" #n ")" ::: "memory")
#define PG8_WAIT_L(n) asm volatile("s_waitcnt lgkmcnt(" #n ")" ::: "memory")
#define PG8_BAR __builtin_amdgcn_s_barrier()
#define PG8_SCHED __builtin_amdgcn_sched_barrier(0)
    Unit cur, nxt; int ui = 0;
    if (!S.next(0, cur)) return;
    typedef typename Epi::acc_t acc_t;
    acc_t acc[2][2][4][2];
#pragma unroll
    for (int a = 0; a < 2; ++a)
#pragma unroll
        for (int b = 0; b < 2; ++b)
#pragma unroll
            for (int m = 0; m < 4; ++m)
#pragma unroll
                for (int n = 0; n < 2; ++n) acc[a][b][m][n] = acc_t{};
    h16x8 At[4][2], B0[2][2], B1[2][2];
    const char* cA = (const char*)g.A + (size_t)cur.pm * tstepA; const char* cB = (const char*)g.Bt + (size_t)cur.pn * tstepB;
    PG8_STAGE(PG8_SB(0, 0), cB, voffB); PG8_STAGE(PG8_SB(0, 1), cB + hstepB, voffB); PG8_STAGE(PG8_SA(0, 0), cA, voffA); PG8_STAGE(PG8_SA(0, 1), cA + hstepA, voffA);
    if (wr == 1) PG8_BAR;
    PG8_WAIT_V(2); PG8_BAR;
    PG8_STAGE(PG8_SB(1, 0), cB + kstep, voffB); PG8_STAGE(PG8_SA(1, 0), cA + kstep, voffA); PG8_STAGE(PG8_SB(1, 1), cB + hstepB + kstep, voffB);
    PG8_WAIT_V(6); PG8_BAR;
    for (;;) {
        const bool has_next = S.next(ui + 1, nxt);
        const char* nA = has_next ? (const char*)g.A + (size_t)nxt.pm * tstepA : cA; const char* nB = has_next ? (const char*)g.Bt + (size_t)nxt.pn * tstepB : cB;
        for (int t = 0; t < nt; t += 2) {
            const bool last = (t == nt - 2);
            const char* a1 = cA + (size_t)(t + 1) * kstep;
            const char* a2 = last ? nA : cA + (size_t)(t + 2) * kstep; const char* b2 = last ? nB : cB + (size_t)(t + 2) * kstep;
            const char* a3 = a2 + kstep; const char* b3 = b2 + kstep;
            PG8_LDB(B0, 0, 0); PG8_LDB(B1, 0, 1); PG8_SCHED; PG8_LDA(At, 0, 0); PG8_STAGE(PG8_SA(1, 1), a1 + hstepA, voffA);
            PG8_WAIT_V(8); PG8_WAIT_L(0); PG8_BAR; PG8_MMA(0, 0, At, B0); PG8_MMA(0, 1, At, B1); PG8_BAR; PG8_SCHED;
            PG8_LDA(At, 0, 1); PG8_STAGE(PG8_SB(0, 0), b2, voffB); PG8_STAGE(PG8_SB(0, 1), b2 + hstepB, voffB); PG8_STAGE(PG8_SA(0, 0), a2, voffA);
            PG8_WAIT_V(8); PG8_WAIT_L(0); PG8_BAR; PG8_MMA(1, 0, At, B0); PG8_MMA(1, 1, At, B1); PG8_BAR; PG8_SCHED;
            PG8_LDB(B0, 1, 0); PG8_LDB(B1, 1, 1); PG8_SCHED; PG8_LDA(At, 1, 0); PG8_STAGE(PG8_SA(0, 1), a2 + hstepA, voffA);
            PG8_WAIT_V(8); PG8_WAIT_L(0); PG8_BAR; PG8_MMA(0, 0, At, B0); PG8_MMA(0, 1, At, B1); PG8_BAR; PG8_SCHED;
            PG8_LDA(At, 1, 1); PG8_STAGE(PG8_SB(1, 0), b3, voffB); PG8_STAGE(PG8_SB(1, 1), b3 + hstepB, voffB); PG8_STAGE(PG8_SA(1, 0), a3, voffA);
            PG8_WAIT_V(8); PG8_WAIT_L(0); PG8_BAR; PG8_MMA(1, 0, At, B0); PG8_MMA(1, 1, At, B1); PG8_BAR; PG8_SCHED;
        }
        if (wr == 0) PG8_BAR;
        { const int l2 = lane_id(); E(acc, cur, wr, wc, l2 & 15, l2 >> 4); }
        if (!has_next) break;
#pragma unroll
        for (int a = 0; a < 2; ++a)
#pragma unroll
            for (int b = 0; b < 2; ++b)
#pragma unroll
                for (int m = 0; m < 4; ++m)
#pragma unroll
                    for (int n = 0; n < 2; ++n) acc[a][b][m][n] = acc_t{};
        cur = nxt; cA = nA; cB = nB; ++ui;
        if (wr == 1) PG8_BAR;
    }
    PG8_WAIT_V(0);
    PG8_BAR;
#undef PG8_SA
#undef PG8_SB
#undef PG8_STAGE
#undef PG8_LDA
#undef PG8_LDB
#undef PG8_MMA
#undef PG8_WAIT_V
#undef PG8_WAIT_L
#undef PG8_BAR
#undef PG8_SCHED
}
}

struct Params {
    const float* in[35];
    float* out;
    unsigned char* ws;
    int step_lo, step_hi;
};
enum { I_X = 0, I_C, I_ADAW, I_ADAB, I_PREMIX, I_POSTMIX, I_PREFFN, I_POSTFFN, I_WIN, I_WINV, I_MU, I_MUV, I_WOUT, I_QNG, I_KVNG, I_WQUP, I_WQIUP, I_WKUP, I_WVUP,
       I_KLNG, I_KLNB, I_W0, I_W2, I_A0, I_A2, I_G2, I_V0, I_V2, I_KK, I_KA, I_RK, I_LNXG, I_LNXB, I_WFC, I_WDOWN };

template <int OFF> DI unsigned long long ka_load64() {
    unsigned long long v;
    asm volatile("s_load_dwordx2 %0, %1, %2\n\ts_waitcnt lgkmcnt(0)" : "=s"(v) : "s"(__builtin_amdgcn_kernarg_segment_ptr()), "n"(OFF));
    return v;
}
#define GAS __attribute__((address_space(1)))
template <int I> DI const float* kin() { return (const float*)(const GAS float*)ka_load64<8 * I>(); }
DI float* kout() { return (float*)(GAS float*)ka_load64<8 * 35>(); }
DI unsigned char* kws() { return (unsigned char*)(GAS unsigned char*)ka_load64<8 * 36>(); }

struct Ctx {
    LAS unsigned char* lds;
    int wave, gw, ngw, G;
};

DI void phase_mod(const Params& p, const Ctx& c) {
    const int lane = lane_id(), tid = c.wave * 64 + lane; (void)tid;
    unsigned char* const ws = kws();
    LAS float* cond = (LAS float*)c.lds;
    LAS float* red = (LAS float*)(c.lds + 65536);
    const float* cin = kin<I_C>();
    for (int i = tid; i < 16384; i += NTHR) { const int b = i & 15, k = i >> 4; const float cv = cin[b * 1024 + k]; cond[k * 16 + b] = cv * sigmoidf_(cv); }
    __syncthreads();
    float* MOD = (float*)(ws + WS_MOD);
    for (int item = blockIdx.x; item < 384; item += c.G) {
        const int l = item / 96, n0 = (item % 96) * 64;
        const float* W = kin<I_ADAW>() + (size_t)l * 1024 * 6144 + n0 + lane;
        float acc[16];
#pragma unroll
        for (int b = 0; b < 16; ++b) acc[b] = 0.f;
        const int k0 = c.wave * 128;
#pragma unroll 8
        for (int k = k0; k < k0 + 128; ++k) {
            const float wv = W[(size_t)k * 6144];
            const LAS f32x4* cb = (const LAS f32x4*)(cond + k * 16);
            const f32x4 c0 = cb[0], c1 = cb[1], c2 = cb[2], c3 = cb[3];
            acc[0] += c0[0] * wv; acc[1] += c0[1] * wv; acc[2] += c0[2] * wv; acc[3] += c0[3] * wv;
            acc[4] += c1[0] * wv; acc[5] += c1[1] * wv; acc[6] += c1[2] * wv; acc[7] += c1[3] * wv;
            acc[8] += c2[0] * wv; acc[9] += c2[1] * wv; acc[10] += c2[2] * wv; acc[11] += c2[3] * wv;
            acc[12] += c3[0] * wv; acc[13] += c3[1] * wv; acc[14] += c3[2] * wv; acc[15] += c3[3] * wv;
        }
#pragma unroll
        for (int b = 0; b < 16; ++b) red[(c.wave * 16 + b) * 64 + lane] = acc[b];
        __syncthreads();
        for (int idx = tid; idx < 1024; idx += NTHR) { const int b = idx >> 6, n = idx & 63; float s = kin<I_ADAB>()[l * 6144 + n0 + n];
#pragma unroll
            for (int w = 0; w < 8; ++w) s += red[(w * 16 + b) * 64 + n];
            MOD[(size_t)(l * 16 + b) * 6144 + n0 + n] = s; }
        __syncthreads();
    }
}

DI void tr_item(const float* src, int ldsrc, h16* dst, int ldd, LAS float* scr, int lane, bool zero) {
#pragma unroll
    for (int hb = 0; hb < 2; ++hb) { float tv[16];
#pragma unroll
        for (int i = 0; i < 16; ++i) { const int kk = 2 * (16 * hb + i) + (lane >> 5); tv[i] = zero ? 0.f : src[(size_t)kk * ldsrc + (lane & 31)]; }
#pragma unroll
        for (int i = 0; i < 16; ++i) { const int kk = 2 * (16 * hb + i) + (lane >> 5); scr[kk * 33 + (lane & 31)] = tv[i]; } }
    asm volatile("s_waitcnt lgkmcnt(0)" ::: "memory");
    const int cc = lane & 7;
#pragma unroll
    for (int j = 0; j < 4; ++j) { const int n = (lane >> 3) + 8 * j; const LAS float* s = scr + (8 * cc) * 33 + n;
        u32x4 o; o.x = pkh(s[0 * 33], s[1 * 33]); o.y = pkh(s[2 * 33], s[3 * 33]); o.z = pkh(s[4 * 33], s[5 * 33]); o.w = pkh(s[6 * 33], s[7 * 33]);
        *(u32x4*)(dst + (size_t)n * ldd + 8 * cc) = o; }
    asm volatile("s_waitcnt lgkmcnt(0)" ::: "memory");
}
DI void tr_item_q8(const float* src, int ldsrc, unsigned char* dst, int ldd, LAS float* scr, int lane, const float qs) {
#pragma unroll
    for (int hb = 0; hb < 2; ++hb) { float tv[16];
#pragma unroll
        for (int i = 0; i < 16; ++i) { const int kk = 2 * (16 * hb + i) + (lane >> 5); tv[i] = src[(size_t)kk * ldsrc + (lane & 31)]; }
#pragma unroll
        for (int i = 0; i < 16; ++i) { const int kk = 2 * (16 * hb + i) + (lane >> 5); scr[kk * 33 + (lane & 31)] = tv[i]; } }
    asm volatile("s_waitcnt lgkmcnt(0)" ::: "memory");
    const int n = lane >> 1, kh = lane & 1; const LAS float* sp = scr + (32 * kh) * 33 + n;
#pragma unroll
    for (int g = 0; g < 2; ++g) { unsigned o[4];
#pragma unroll
        for (int w4 = 0; w4 < 4; ++w4) { unsigned bq[4];
#pragma unroll
            for (int e = 0; e < 4; ++e) bq[e] = __builtin_bit_cast(unsigned, fminf(fmaxf(sp[(16 * g + 4 * w4 + e) * 33] * qs, -127.0f), 127.0f) + 12582912.0f);
            o[w4] = __builtin_amdgcn_perm(bq[1], bq[0], 0x0c0c0400u) | __builtin_amdgcn_perm(bq[3], bq[2], 0x04000c0cu); }
        u32x4 ov; ov.x = o[0]; ov.y = o[1]; ov.z = o[2]; ov.w = o[3];
        *(u32x4*)(dst + (size_t)n * ldd + 32 * kh + 16 * g) = ov; }
    asm volatile("s_waitcnt lgkmcnt(0)" ::: "memory");
}
DI unsigned* wmax_word(unsigned char* ws, int l, int which) { return (unsigned*)(ws + WS_CTL) + 8192 + 64 * l + 32 + which; }
DI float absmax4(float am, const f32x4 v) { return fmaxf(fmaxf(am, fmaxf(__builtin_fabsf(v[0]), __builtin_fabsf(v[1]))), fmaxf(__builtin_fabsf(v[2]), __builtin_fabsf(v[3]))); }
DI void phase_wmax(const Params& p, const Ctx& c, int l) {
    const int lane = lane_id();
    { const f32x4* w = (const f32x4*)(kin<I_WFC>() + (size_t)l * DM * NFC); float am = 0.f;
#pragma unroll 8
      for (int i = c.gw * 64 + lane; i < DM * NFC / 4; i += c.ngw * 64) am = absmax4(am, w[i]);
      const unsigned mx = max64u(__builtin_bit_cast(unsigned, am));
      if (lane == 0) __hip_atomic_fetch_max(wmax_word(kws(), l, 0), mx, __ATOMIC_RELAXED, __HIP_MEMORY_SCOPE_AGENT); }
    { const f32x4* w = (const f32x4*)(kin<I_WIN>() + (size_t)l * DM * PIN); float am = 0.f;
#pragma unroll 8
      for (int i = c.gw * 64 + lane; i < DM * PIN / 4; i += c.ngw * 64) am = absmax4(am, w[i]);
      if (l > 0) { const f32x4* wv = (const f32x4*)(kin<I_WINV>() + (size_t)(l - 1) * DM * 32);
          for (int i = c.gw * 64 + lane; i < DM * 32 / 4; i += c.ngw * 64) am = absmax4(am, wv[i]); }
      const unsigned mx = max64u(__builtin_bit_cast(unsigned, am));
      if (lane == 0) __hip_atomic_fetch_max(wmax_word(kws(), l, 1), mx, __ATOMIC_RELAXED, __HIP_MEMORY_SCOPE_AGENT); }
}
DI float wmax_load(unsigned char* ws, int l, int which) { return fmaxf(__builtin_bit_cast(float, __hip_atomic_load(wmax_word(ws, l, which), __ATOMIC_RELAXED, __HIP_MEMORY_SCOPE_AGENT)), 1e-30f); }
DI void phase_wconv(const Params& p, const Ctx& c, int l, const int it_lo, const int it_hi, const bool do_elem) {
    const int lane = lane_id(), tid = c.wave * 64 + lane; (void)tid;
    unsigned char* const ws = kws();
    LAS float* scr = (LAS float*)(c.lds + c.wave * 16384);
    unsigned char* const wb = ws + wofs(l);
    h16* Win = (h16*)(wb + WT_IN); h16* Wq = (h16*)(wb + WT_Q); h16* Wlo = (h16*)(wb + WT_LORA); h16* Wout = (h16*)(wb + WT_OUT); h16* Wfc = (h16*)(wb + WT_FC); h16* Wdn = (h16*)(wb + WT_DOWN);
    const float* w_in = kin<I_WIN>() + (size_t)l * DM * PIN;
    const float* w_vr = kin<I_WINV>() + (size_t)(l > 0 ? l - 1 : 0) * DM * 32;
    const float* w_fc = kin<I_WFC>() + (size_t)l * DM * NFC;
    const float* w_dn = kin<I_WDOWN>() + (size_t)l * DFF * DM;
    const float* w_out = kin<I_WOUT>() + (size_t)l * 1024 * DM;
    constexpr int IT_IN = 16 * (NIN / 32), IT_FC = 16 * (NFC / 32), IT_DN = (DFF / 64) * (DM / 32), IT_O2 = 16 * (DM / 32);
    float qs = 0.f, qsi = 0.f;
    if (it_hi > WC_NOQ) { qs = 127.0f * __builtin_amdgcn_rcpf(wmax_load(ws, l, 0)); qsi = 127.0f * __builtin_amdgcn_rcpf(wmax_load(ws, l, 1)); }
#pragma unroll 1
    for (int it = it_lo + c.gw; it < it_hi; it += c.ngw) {
        int r = it; const float* src; int ld; h16* d16 = nullptr; unsigned char* d8 = nullptr; int ldd; bool zero = false; float q = 0.f;
        if (r < IT_DN) { const int nb = r % (DM / 32), kb = r / (DM / 32), nd = nb * 32, k0 = kb * 64;
            src = w_dn + (size_t)k0 * DM + nd; ld = DM; d16 = Wdn + (size_t)nd * DFF + k0; ldd = DFF; }
        else if ((r -= IT_DN) < IT_O2) { const int nb = r % (DM / 32), kb = r / (DM / 32), nd = nb * 32, k0 = kb * 64;
            src = w_out + (size_t)k0 * DM + nd; ld = DM; d16 = Wout + (size_t)nd * KOUT + k0; ldd = KOUT; }
        else if ((r -= IT_O2) < IT_IN) { const int nb = r % (NIN / 32), kb = r / (NIN / 32), nd = nb * 32, k0 = kb * 64;
            int sc; const float* sp = w_in; ld = PIN;
            if (nd < 448) sc = nd;
            else if (nd < 736) sc = 1988 + (nd - 448);
            else if (nd < 768) { if (l > 0) { sp = w_vr; ld = 32; sc = 0; } else { zero = true; sc = 0; } }
            else sc = 452 + (nd - 768);
            src = sp + (size_t)k0 * ld + sc; ldd = DM;
            if (nd < NIN16) d16 = Win + (size_t)nd * DM + k0; else { d8 = (unsigned char*)(Win + (size_t)NIN16 * DM) + (size_t)(nd - NIN16) * DM + k0; q = zero ? 0.f : qsi; } }
        else { r -= IT_IN; const int nb = r % (NFC / 32), kb = r / (NFC / 32), nd = nb * 32, k0 = kb * 64;
            const int pn = nd >> 8, i = nd & 255; const int sc = (i < 128) ? (128 * pn + i) : (DFF + 128 * pn + (i - 128));
            src = w_fc + (size_t)k0 * NFC + sc; ld = NFC; d8 = (unsigned char*)Wfc + (size_t)nd * DM + k0; ldd = DM; q = qs; }
        if (d8) tr_item_q8(src, ld, d8, ldd, scr, lane, q); else tr_item(src, ld, d16, ldd, scr, lane, zero);
    }
    if (!do_elem) return;
    const int gt = c.gw * 64 + lane, ngt = c.ngw * 64;
    const float* wq = kin<I_WQUP>() + (size_t)l * 256 * 512; const float* wk = kin<I_WKUP>() + (size_t)l * 128 * 512; const float* wqi = kin<I_WQIUP>() + (size_t)l * 256 * 256;
    const float* wv = kin<I_WVUP>() + (size_t)l * 128 * 512;
    const float qscl = 0.125f * 1.4426950408889634f;
    for (int it = c.gw; it < 8 * 8 * 4; it += c.ngw) {
        const int h = it >> 5, rb = (it >> 2) & 7, cb = it & 3, cc = cb * 64 + lane;
        f32x4 qv[16];
#pragma unroll
        for (int d4 = 0; d4 < 16; ++d4) qv[d4] = *(const f32x4*)(wq + cc * 512 + h * 64 + 4 * d4);
#pragma unroll 2
        for (int r = 0; r < 16; ++r) { const float* kr = wk + (rb * 16 + r) * 512 + h * 64; float sacc = 0.f;
#pragma unroll
            for (int d4 = 0; d4 < 16; ++d4) { const f32x4 kv = *(const f32x4*)(kr + 4 * d4); sacc += (qv[d4][0] * kv[0] + qv[d4][1] * kv[1]) + (qv[d4][2] * kv[2] + qv[d4][3] * kv[3]); }
            Wq[(size_t)(h * 128 + rb * 16 + r) * 256 + cc] = (h16)(sacc * qscl); }
    }
    for (int idx = gt; idx < 256 * 256; idx += ngt) { const int n = idx >> 8, cc = idx & 255; Wq[(size_t)(1024 + n) * 256 + cc] = (h16)wqi[cc * 256 + n]; }
    const float* w2 = kin<I_W2>() + (size_t)l * 64 * 512; const float* a2 = kin<I_A2>() + (size_t)l * 64 * 512; const float* g2 = kin<I_G2>() + (size_t)l * 160 * 512;
    const float* v2 = kin<I_V2>() + (size_t)(l > 0 ? l - 1 : 0) * 32 * 512;
    for (int idx = gt; idx < 1024 * 128; idx += ngt) {
        const int n = idx >> 7, k = idx & 127, j = n & 511; float o = 0.f;
        if (n < 512) { if (k < 64) o = w2[k * 512 + j]; } else { if (k >= 64) o = a2[(k - 64) * 512 + j]; }
        Wlo[idx] = (h16)o; }
    for (int idx = gt; idx < 1024 * 256; idx += ngt) {
        const int n = idx >> 8, k = idx & 255, j = n & 511; float o = 0.f;
        if (n < 512) { if (k < 160) o = g2[k * 512 + j]; } else { if (l > 0 && k >= 160 && k < 192) o = v2[(k - 160) * 512 + j]; }
        Wlo[1024 * 128 + idx] = (h16)o; }
    { h16* WVt = (h16*)(wb + WT_VUP);
      for (int idx = gt; idx < 8 * 64 * 128; idx += ngt) { const int k = idx & 127, n = (idx >> 7) & 63, h = idx >> 13; WVt[idx] = (h16)wv[k * 512 + h * 64 + n]; } }
}

template <int MODE, bool HAS_NEXT, bool WIDX_, int Q8 = 0>
DI void phase_rows(const Params& p, const Ctx& c, const h16* Y, const float* postg, int gate_off, int mod_l_gate,
                   const float* preg, int sh_off, int sc_off, int mod_l_next, int widx_l) {
    const int lane = lane_id(), tid = c.wave * 64 + lane; (void)tid;
    unsigned char* const ws = kws();
    h16* X = (h16*)(ws + WS_X16); float* OUT = kout(); h16* H = (h16*)(ws + WS_H); const float* MOD = (const float*)(ws + WS_MOD); float* WIDX = (float*)(ws + WS_WIDX);
    for (int rg = c.gw; rg < MT / 16; rg += c.ngw) {
        const int m0 = rg * 16, b = m0 / SEQ;
        f32x4 gp[4], ps[4], shv[4], wi[4][4];
#pragma unroll
        for (int j = 0; j < 4; ++j) { const int col = 4 * lane + 256 * j;
            if (MODE == 1) gp[j] = *(const f32x4*)(MOD + (size_t)(mod_l_gate * 16 + b) * 6144 + gate_off + col) * *(const f32x4*)(postg + col);
            if (HAS_NEXT) { shv[j] = *(const f32x4*)(MOD + (size_t)(mod_l_next * 16 + b) * 6144 + sh_off + col);
                ps[j] = *(const f32x4*)(preg + col) * (*(const f32x4*)(MOD + (size_t)(mod_l_next * 16 + b) * 6144 + sc_off + col) + 1.0f); }
            if (WIDX_) {
#pragma unroll
                for (int e = 0; e < 4; ++e) wi[j][e] = *(const f32x4*)(kin<I_WIN>() + ((size_t)widx_l * DM + col + e) * PIN + 448); }
        }
        for (int rr = 0; rr < 16; ++rr) {
            const size_t m = (size_t)(m0 + rr);
            f32x4 xv[4];
            if (MODE == 0) {
#pragma unroll
                for (int j = 0; j < 4; ++j) xv[j] = *(const f32x4*)(kin<I_X>() + m * DM + 4 * lane + 256 * j);
            } else {
                f32x4 yv[4]; float ss = 0.f;
#pragma unroll
                for (int j = 0; j < 4; ++j) { const u32x2 yr = *(const u32x2*)(Y + m * DM + 4 * lane + 256 * j); yv[j] = (f32x4){hlo(yr.x), hhi(yr.x), hlo(yr.y), hhi(yr.y)}; const u32x2 xr = *(const u32x2*)(X + m * DM + 4 * lane + 256 * j); xv[j] = (f32x4){hlo(xr.x), hhi(xr.x), hlo(xr.y), hhi(xr.y)};
                    ss += (yv[j][0] * yv[j][0] + yv[j][1] * yv[j][1]) + (yv[j][2] * yv[j][2] + yv[j][3] * yv[j][3]); }
                const float rn = rsqrtf(sum64(ss) * (1.0f / DM) + NORM_EPS);
#pragma unroll
                for (int j = 0; j < 4; ++j) xv[j] = xv[j] + (yv[j] * rn) * gp[j];
            }
            if (HAS_NEXT) {
#pragma unroll
                for (int j = 0; j < 4; ++j) { u32x2 w; w.x = pkh(xv[j][0], xv[j][1]); w.y = pkh(xv[j][2], xv[j][3]); *(u32x2*)(X + m * DM + 4 * lane + 256 * j) = w; }
            } else {
#pragma unroll
                for (int j = 0; j < 4; ++j) *(f32x4*)(OUT + m * DM + 4 * lane + 256 * j) = xv[j];
            }
            if (HAS_NEXT) {
                float ss = 0.f;
#pragma unroll
                for (int j = 0; j < 4; ++j) ss += (xv[j][0] * xv[j][0] + xv[j][1] * xv[j][1]) + (xv[j][2] * xv[j][2] + xv[j][3] * xv[j][3]);
                const float rn = rsqrtf(sum64(ss) * (1.0f / DM) + NORM_EPS);
                float d0 = 0.f, d1 = 0.f, d2 = 0.f, d3 = 0.f;
                if (Q8 != 0) {
                    float am = 0.f;
#pragma unroll
                    for (int j = 0; j < 4; ++j) { const f32x4 hq = (xv[j] * rn) * ps[j] + shv[j];
                        am = fmaxf(fmaxf(am, fmaxf(__builtin_fabsf(hq[0]), __builtin_fabsf(hq[1]))), fmaxf(__builtin_fabsf(hq[2]), __builtin_fabsf(hq[3]))); }
                    const float amax = fmaxf(__builtin_bit_cast(float, max64u(__builtin_bit_cast(unsigned, am))), 1e-20f);
                    const float qs = 127.0f * __builtin_amdgcn_rcpf(amax);
                    unsigned char* H8 = (Q8 == 2) ? (unsigned char*)(ws + WS_H8IN) : (unsigned char*)H;
#pragma unroll
                    for (int j = 0; j < 4; ++j) {
                        const f32x4 hq = (xv[j] * rn) * ps[j] + shv[j];
                        unsigned bq[4];
#pragma unroll
                        for (int e = 0; e < 4; ++e) bq[e] = __builtin_bit_cast(unsigned, fminf(fmaxf(hq[e] * qs, -127.0f), 127.0f) + 12582912.0f);
                        const unsigned w = __builtin_amdgcn_perm(bq[1], bq[0], 0x0c0c0400u) | __builtin_amdgcn_perm(bq[3], bq[2], 0x04000c0cu);
                        *(unsigned*)(H8 + m * DM + 4 * lane + 256 * j) = w; }
                    if (lane == 0) ((float*)(ws + WS_RS))[m] = amax * (1.0f / 127.0f);
                }
                if (Q8 != 1)
#pragma unroll
                for (int j = 0; j < 4; ++j) { const f32x4 hv = (xv[j] * rn) * ps[j] + shv[j];
                    u32x2 w; w.x = pkh(hv[0], hv[1]); w.y = pkh(hv[2], hv[3]);
                    *(u32x2*)(H + m * DM + 4 * lane + 256 * j) = w;
                    if (WIDX_) {
#pragma unroll
                        for (int e = 0; e < 4; ++e) { d0 += hv[e] * wi[j][e][0]; d1 += hv[e] * wi[j][e][1]; d2 += hv[e] * wi[j][e][2]; d3 += hv[e] * wi[j][e][3]; } } }
                if (WIDX_) { d0 = sum64(d0); d1 = sum64(d1); d2 = sum64(d2); d3 = sum64(d3);
                    if (lane == 0) *(f32x4*)(WIDX + m * 4) = (f32x4){d0 * 0.0625f, d1 * 0.0625f, d2 * 0.0625f, d3 * 0.0625f}; }
            }
        }
    }
}

DI void phase_prep(const Params& p, const Ctx& c, int l) {
    unsigned char* const ws = kws();
    const int lane = lane_id();
    const h16* CA = (const h16*)(ws + WS_COLSA);
    h16* CQ = (h16*)(ws + WS_CQ); h16* CKV = (h16*)(ws + WS_CKV); h16* KIDX = (h16*)(ws + WS_KIDX); h16* AL = (h16*)(ws + WS_ALORA);
    const f32x4 qg = *(const f32x4*)(kin<I_QNG>() + l * 256 + 4 * lane);
    const f32x2 kvg = *(const f32x2*)(kin<I_KVNG>() + l * 128 + 2 * lane);
    const float lg = kin<I_KLNG>()[l * 64 + lane], lb = kin<I_KLNB>()[l * 64 + lane];
    float mu[5];
#pragma unroll
    for (int i = 0; i < 5; ++i) { const int j = lane + 64 * i;
        mu[i] = (j < 288) ? kin<I_MU>()[l * 1824 + 1536 + j] : (l > 0 ? kin<I_MUV>()[(l - 1) * 32 + (j - 288)] : 0.f); }
    for (int rg = c.gw; rg < MT / 16; rg += c.ngw) {
        const int m0 = rg * 16, b = m0 / SEQ, t0 = m0 % SEQ;
        float prevv[5];
#pragma unroll
        for (int i = 0; i < 5; ++i) prevv[i] = (t0 > 0) ? (float)CA[(size_t)(m0 - 1) * NCA + 448 + lane + 64 * i] : 0.f;
#pragma unroll
        for (int rr = 0; rr < 16; ++rr) {
            const size_t m = (size_t)(m0 + rr); const h16* row = CA + m * NCA;
            const u32x2 cqr = *(const u32x2*)(row + 4 * lane);
            const unsigned ckr = *(const unsigned*)(row + 256 + 2 * lane);
            const float kir = (float)row[384 + lane];
            float cur[5];
#pragma unroll
            for (int i = 0; i < 5; ++i) cur[i] = (float)row[448 + lane + 64 * i];
            const float q0 = hlo(cqr.x), q1 = hhi(cqr.x), q2 = hlo(cqr.y), q3 = hhi(cqr.y);
            const float rq = rsqrtf(sum64((q0 * q0 + q1 * q1) + (q2 * q2 + q3 * q3)) * (1.0f / 256.0f) + NORM_EPS);
            u32x2 qo; qo.x = pkh(q0 * rq * qg[0], q1 * rq * qg[1]); qo.y = pkh(q2 * rq * qg[2], q3 * rq * qg[3]);
            *(u32x2*)(CQ + m * 256 + 4 * lane) = qo;
            const float k0 = hlo(ckr), k1 = hhi(ckr);
            const float rk = rsqrtf(sum64(k0 * k0 + k1 * k1) * (1.0f / 128.0f) + NORM_EPS);
            const float o0 = k0 * rk * kvg[0], o1 = k1 * rk * kvg[1];
            *(unsigned*)(CKV + m * 128 + 2 * lane) = pkb(o0, o1);
            const float mean = sum64(kir) * (1.0f / 64.0f); const float dv = kir - mean; const float var = sum64(dv * dv) * (1.0f / 64.0f);
            KIDX[m * 64 + lane] = (h16)(dv * rsqrtf(var + NORM_EPS) * lg + lb);
#pragma unroll
            for (int i = 0; i < 5; ++i) { const float sh = cur[i] + (prevv[i] - cur[i]) * mu[i]; prevv[i] = cur[i]; const int j = lane + 64 * i; float o;
                if (i == 0) o = tanhf_(sh); else if (i == 1) o = sh; else if (j < 288) o = sigmoidf_(sh); else o = (l > 0) ? sh : 0.f;
                AL[m * KLORA + j] = (h16)o; }
            AL[m * KLORA + 320 + lane] = (h16)0.f;
        }
    }
}

constexpr int AT_KSTR = 272, AT_VSTR = 144;
constexpr int AT_KB = 64 * AT_KSTR, AT_VB = 128 * AT_VSTR, AT_BUF = AT_KB + AT_VB;
constexpr int AT_MASK = 131072 + 1024;
DI unsigned okey(float s) { const unsigned u = __builtin_bit_cast(unsigned, s); return (u & 0x80000000u) ? ~u : (u | 0x80000000u); }
DI float ikeyf(unsigned k) { return __builtin_bit_cast(float, (k & 0x80000000u) ? (k & 0x7FFFFFFFu) : ~k); }

template <int NRM>
DI void select_query(const LAS float* SCq, unsigned long long* mkq, const int nr, const int lane) {

                        unsigned key[NRM];
                        float sraw[NRM];
#pragma unroll
                        for (int r = 0; r < NRM; ++r) sraw[r] = SCq[64 * (r < nr ? r : 0) + lane];
#pragma unroll
                        for (int r = 0; r < NRM; ++r) key[r] = okey(sraw[r]) & (unsigned)((r - nr) >> 31);
                        auto count_ge = [&](const unsigned cand) -> unsigned { unsigned cnt = 0u;
#pragma unroll
                            for (int r = 0; r < NRM; r += 4) {
                                const unsigned long long m0 = __ballot(key[r] >= cand), m1 = __ballot(key[r + 1] >= cand), m2 = __ballot(key[r + 2] >= cand), m3 = __ballot(key[r + 3] >= cand);
                                cnt += (unsigned)(__popcll(m0) + __popcll(m1)) + (unsigned)(__popcll(m2) + __popcll(m3)); }
                            return cnt; };
                        unsigned thr = 0u; bool exact = false, found = false, neg = false;
                        unsigned klo = 0u, khi = 0u, clo = 0u, chi = 0u;
                        { const unsigned c1 = count_ge(0x80000001u);
                          if (c1 == 256u) { thr = 0x80000001u; exact = true; found = true; }
                          else if (c1 > 256u) { unsigned mx = 0u;
#pragma unroll
                              for (int r = 0; r < NRM; ++r) mx = key[r] > mx ? key[r] : mx;
                              klo = 0x80000001u; clo = c1; khi = max64u(mx) + 1u; chi = 0u; }
                          else { const unsigned c3 = count_ge(0x7FFFFFFFu);
                              if (c3 >= 256u) { found = true;
                                  if (c3 == 256u) { thr = 0x7FFFFFFFu; exact = true; }
                                  else { const unsigned c2 = count_ge(0x80000000u);
                                      if (c2 >= 256u) { thr = 0x80000000u; exact = (c2 == 256u); } else thr = 0x7FFFFFFFu; } }
                              else { unsigned mx = 0u;
#pragma unroll
                                  for (int r = 0; r < NRM; ++r) { const unsigned kc = ~key[r] & (unsigned)((r - nr) >> 31); mx = kc > mx ? kc : mx; }
                                  klo = ~max64u(mx); clo = 64u * (unsigned)nr; khi = 0x7FFFFFFFu; chi = c3; neg = true; } } }
                        if (!found) { float wlo = 1.f, whi = 1.f; int last = 0, it = 0;
#pragma unroll 1
                            for (;;) {
                                if (khi - klo <= 1u) { thr = klo; break; }
                                ++it;
                                const float vlo = ikeyf(klo), vhi = ikeyf(khi);
                                const float a = ((float)clo - 255.5f) * wlo, b = (255.5f - (float)chi) * whi;
                                float frac = a * __builtin_amdgcn_rcpf(a + b);
                                if ((it & 7) == 0) frac = 0.5f;
                                if (it == 1) {
                                    if (!neg) { const float lc = __builtin_amdgcn_logf((float)clo); frac = __builtin_amdgcn_exp2f(0.75f * __builtin_amdgcn_logf((lc - 8.f) * __builtin_amdgcn_rcpf(lc))); }
                                    else { const float lm = __builtin_amdgcn_logf((float)(clo - chi)), lb = __builtin_amdgcn_logf((float)(clo - 256u));
                                           frac = 1.f - __builtin_amdgcn_exp2f(0.8f * __builtin_amdgcn_logf((lm - lb) * __builtin_amdgcn_rcpf(lm))); } }
                                unsigned kp = (unsigned)__builtin_amdgcn_readfirstlane((int)okey(vlo + (vhi - vlo) * frac));
                                if (!(kp > klo && kp < khi)) kp = klo + ((khi - klo) >> 1);
                                const unsigned cn = count_ge(kp);
                                if (cn == 256u) { thr = kp; exact = true; break; }
                                if (cn > 256u) { klo = kp; clo = cn; whi = (last == 1) ? whi * 0.7f : 1.f; wlo = 1.f; last = 1; }
                                else { khi = kp; chi = cn; wlo = (last == -1) ? wlo * 0.7f : 1.f; whi = 1.f; last = -1; }
                            } }
                        unsigned need = 0u;
                        if (!exact) { unsigned cgt = 0u;
#pragma unroll
                            for (int r = 0; r < NRM; ++r) cgt += (unsigned)__popcll(__ballot(key[r] > thr));
                            need = 256u - cgt; }
                        unsigned base = 0u;
                        const unsigned long long lowmask = (1ull << lane) - 1ull;
#pragma unroll
                        for (int r = 0; r < NRM; ++r) {
                            bool sel = key[r] >= thr;
                            if (!exact) { const bool eq = key[r] == thr; const unsigned long long em = __ballot(eq);
                                const unsigned pre = __popcll(em & lowmask); sel = (key[r] > thr) || (eq && (base + pre < need)); base += __popcll(em); }
                            const unsigned long long sm = __ballot(sel);
                            if (lane == 0) mkq[r] = sm;
                        }
                    }

DI void phase_select(const Params& p, const Ctx& c, unsigned* qctr) {
    unsigned char* const ws = kws();
    const h16* QALL = (const h16*)kout(); const h16* KIDX = (const h16*)(ws + WS_KIDX);
    const float* WIDX = (const float*)(ws + WS_WIDX); unsigned long long* MASKG = (unsigned long long*)(ws + WS_MASK);
    const int wave = c.wave;
    LAS unsigned char* lds = c.lds;
    volatile LAS unsigned* qw = (volatile LAS unsigned*)(c.lds + LDS_MISC + 64);
    {
        for (;;) {
            const int lane = lane_id(), tid = wave * 64 + lane;
            if (wave == 0 && lane == 0) *qw = __hip_atomic_fetch_add(qctr, 1u, __ATOMIC_RELAXED, __HIP_MEMORY_SCOPE_AGENT);
            __syncthreads();
            const int unit = (int)*qw;
            __syncthreads();
            if (unit >= 1024) break;
            const int chv = 31 - (unit >> 5), subv = unit & 31;
            const int b = subv >> 1, half = subv & 1;
            const int nadm = 64 * (chv + 1), nkt = chv + 1;
            const int kbase = b * SEQ;
            const int tqu = b * SEQ + chv * 64 + half * 32;
            unsigned long long* mk64 = MASKG + (size_t)tqu * 32;
            if (nadm <= 256) {
                if (lane < 16) mk64[(4 * wave + (lane >> 2)) * 32 + (lane & 3)] = ((lane & 3) < nkt) ? ~0ull : 0ull;
            } else {
                LAS float* SC = (LAS float*)lds;
                const int q4 = lane >> 4, c16 = lane & 15;
#pragma unroll 1
                for (int rnd = 0; rnd < 2; ++rnd) {
                    {
                        h16x8 a0[4], a1[4]; f32x4 wv[4];
#pragma unroll
                        for (int g = 0; g < 4; ++g) { const int tqr = tqu + 16 * rnd + 4 * g;
                            const h16* ap = QALL + (size_t)(tqr + (c16 >> 2)) * NQ + 1024 + (c16 & 3) * 64 + 8 * q4; a0[g] = *(const h16x8*)ap; a1[g] = *(const h16x8*)(ap + 32);
                            wv[g] = *(const f32x4*)(WIDX + (size_t)(tqr + q4) * 4); }
                        const int nt16 = nadm >> 4;
                        const h16* kp = KIDX + (size_t)(kbase + c16) * 64 + 8 * q4;
#pragma unroll 1
                        for (int tb = wave; tb < nt16; tb += 64) {
                            h16x8 b0[8], b1[8];
#pragma unroll
                            for (int u = 0; u < 8; ++u) { int tt = tb + 8 * u; tt = tt < nt16 ? tt : tb; b0[u] = *(const h16x8*)(kp + (size_t)tt * 1024); b1[u] = *(const h16x8*)(kp + (size_t)tt * 1024 + 32); }
#pragma unroll
                            for (int u = 0; u < 8; ++u) { const int tt = tb + 8 * u;
                                if (tt < nt16) {
#pragma unroll
                                    for (int g = 0; g < 4; ++g) { f32x4 acc = (f32x4){0.f, 0.f, 0.f, 0.f};
                                        acc = __builtin_amdgcn_mfma_f32_16x16x32_f16(a0[g], b0[u], acc, 0, 0, 0); acc = __builtin_amdgcn_mfma_f32_16x16x32_f16(a1[g], b1[u], acc, 0, 0, 0);
                                        SC[(4 * g + q4) * 2048 + 16 * tt + c16] = ((fmaxf(acc[0], 0.f) * wv[g][0] + fmaxf(acc[1], 0.f) * wv[g][1]) + fmaxf(acc[2], 0.f) * wv[g][2]) + fmaxf(acc[3], 0.f) * wv[g][3]; }
                                }
                            }
                        }
                    }
                    __syncthreads();
                    const int nr = nadm >> 6;
#pragma unroll 1
                    for (int qi = 0; qi < 2; ++qi) {
                        const int ql = 2 * wave + qi; const LAS float* SCq = SC + ql * 2048; unsigned long long* mkq = mk64 + (16 * rnd + ql) * 32;
                        if (nr <= 8) select_query<8>(SCq, mkq, nr, lane); else if (nr <= 16) select_query<16>(SCq, mkq, nr, lane);
                        else if (nr <= 24) select_query<24>(SCq, mkq, nr, lane); else select_query<32>(SCq, mkq, nr, lane);
                    }
                    __syncthreads();
                }
            }
            __syncthreads();
        }
    }
}

namespace ab {
typedef short bf16x8 __attribute__((ext_vector_type(8)));
typedef short s16x4 __attribute__((ext_vector_type(4)));
constexpr int SHM_V = 64 * 128 * 2, SHM_K = 64 * 128 * 2;
constexpr int LDS_RED = 2 * SHM_V + 2 * SHM_K;
constexpr int LDS_MK = LDS_RED + 8 * 256;
constexpr int LDS_END = LDS_MK + 8 * 8192;
constexpr float THRL = 8.0f;
#define AB_KSWZ(row, colB) ((row) * 256 + ((colB) ^ (((row) & 7) << 4)))
#define AB_SBAR() __builtin_amdgcn_sched_barrier(0)
DI int crow(int r, int hi) { return (r & 3) + 8 * (r >> 2) + 4 * hi; }
DI unsigned cvtpk(float lo, float hi) { unsigned r; asm volatile("v_cvt_pk_bf16_f32 %0, %1, %2" : "=v"(r) : "v"(lo), "v"(hi)); return r; }
DI void partialSM(f32x16& p0, f32x16& p1, float& m_reg, float& mn, float& alpha, unsigned wlo, unsigned whi) {
#pragma unroll
    for (int r = 0; r < 16; ++r) { const int o = (r & 3) + 8 * (r >> 2); p0[r] = ((wlo >> o) & 1u) ? p0[r] : -__builtin_inff(); p1[r] = ((whi >> o) & 1u) ? p1[r] : -__builtin_inff(); }
    float pmax = p0[0];
#pragma unroll
    for (int r = 1; r < 16; ++r) pmax = fmaxf(pmax, p0[r]);
#pragma unroll
    for (int r = 0; r < 16; ++r) pmax = fmaxf(pmax, p1[r]);
    { auto rr = __builtin_amdgcn_permlane32_swap(__float_as_uint(pmax), __float_as_uint(pmax), false, false);
      pmax = fmaxf(__uint_as_float(rr[0]), __uint_as_float(rr[1])); }
    if (__builtin_expect(__all(pmax - m_reg <= THRL), 1)) { mn = m_reg; alpha = 1.f; }
    else { mn = fmaxf(m_reg, pmax); alpha = __builtin_amdgcn_exp2f(m_reg - mn); m_reg = mn; }
#pragma unroll
    for (int r = 0; r < 16; ++r) { p0[r] = p0[r] - mn; p1[r] = p1[r] - mn; }
#pragma unroll
    for (int r = 0; r < 16; ++r) p0[r] = __builtin_amdgcn_exp2f(p0[r]);
}
DI void finishSM(f32x16& p0, f32x16& p1, float alpha, float& l_reg, bf16x8& pa0, bf16x8& pa1, bf16x8& pa2, bf16x8& pa3) {
#pragma unroll
    for (int r = 0; r < 16; ++r) p1[r] = __builtin_amdgcn_exp2f(p1[r]);
    float ps = 0;
#pragma unroll
    for (int r = 0; r < 16; ++r) ps += p0[r];
#pragma unroll
    for (int r = 0; r < 16; ++r) ps += p1[r];
    { auto rr = __builtin_amdgcn_permlane32_swap(__float_as_uint(ps), __float_as_uint(ps), false, false);
      ps = __uint_as_float(rr[0]) + __uint_as_float(rr[1]); }
    l_reg = l_reg * alpha + ps;
#define AB_PK4(P, BASE, OUT) do { unsigned a0 = cvtpk(P[BASE + 0], P[BASE + 1]), a1 = cvtpk(P[BASE + 2], P[BASE + 3]);   \
    unsigned b0 = cvtpk(P[BASE + 4], P[BASE + 5]), b1 = cvtpk(P[BASE + 6], P[BASE + 7]);                              \
    auto r0 = __builtin_amdgcn_permlane32_swap(a0, b0, false, false); auto r1 = __builtin_amdgcn_permlane32_swap(a1, b1, false, false); \
    u32x4 w = {r0[0], r1[0], r0[1], r1[1]}; OUT = __builtin_bit_cast(bf16x8, w); } while (0)
    AB_PK4(p0, 0, pa0); AB_PK4(p0, 8, pa1); AB_PK4(p1, 0, pa2); AB_PK4(p1, 8, pa3);
#undef AB_PK4
}
DI void qkt(f32x16& p0, f32x16& p1, const LAS unsigned char* Ks, const bf16x8* qr, int r32, int hi) {
#pragma unroll
    for (int e = 0; e < 16; ++e) { p0[e] = 0.f; p1[e] = 0.f; }
#pragma unroll
    for (int d0 = 0; d0 < 8; ++d0) { const int cb = (d0 * 16 + hi * 8) * 2;
        const bf16x8 b0 = *(const LAS bf16x8*)(Ks + AB_KSWZ(r32, cb));
        const bf16x8 b1 = *(const LAS bf16x8*)(Ks + AB_KSWZ(32 + r32, cb));
        p0 = __builtin_amdgcn_mfma_f32_32x32x16_bf16(b0, qr[d0], p0, 0, 0, 0);
        p1 = __builtin_amdgcn_mfma_f32_32x32x16_bf16(b1, qr[d0], p1, 0, 0, 0); }
}
DI int v_st(int k, int c) { const int kk = (k & ~0xC) | ((k & 4) << 1) | ((k & 8) >> 1); return ((kk >> 3) * 4 + (c >> 5)) * 512 + ((kk & 7) * 32 + (c & 31)) * 2; }
DI int v_rd_base(int lane) { return ((lane & 3) << 3) | (((lane >> 2) & 3) << 6) | (((lane >> 4) & 1) << 5) | (((lane >> 5) & 1) << 8); }
constexpr int v_rd_off(int d0, int ks, int half) { return d0 * 512 + ks * 4096 + half * 2048; }
template <int OFF> DI s16x4 tr_read(int vb) { s16x4 r; asm volatile("ds_read_b64_tr_b16 %0, %1 offset:%2" : "=&v"(r) : "v"(vb), "i"(OFF) : "memory"); return r; }
template <int D0> DI void pv_one(f32x16& od, int vb, bf16x8 pa0, bf16x8 pa1, bf16x8 pa2, bf16x8 pa3) {
    const s16x4 l0 = tr_read<v_rd_off(D0, 0, 0)>(vb), h0 = tr_read<v_rd_off(D0, 0, 1)>(vb), l1 = tr_read<v_rd_off(D0, 1, 0)>(vb), h1 = tr_read<v_rd_off(D0, 1, 1)>(vb);
    const s16x4 l2 = tr_read<v_rd_off(D0, 2, 0)>(vb), h2 = tr_read<v_rd_off(D0, 2, 1)>(vb), l3 = tr_read<v_rd_off(D0, 3, 0)>(vb), h3 = tr_read<v_rd_off(D0, 3, 1)>(vb);
    asm volatile("s_waitcnt lgkmcnt(0)" ::: "memory"); AB_SBAR();
#define AB_PK(L, H) (bf16x8){L[0], L[1], L[2], L[3], H[0], H[1], H[2], H[3]}
    od = __builtin_amdgcn_mfma_f32_32x32x16_bf16(pa0, AB_PK(l0, h0), od, 0, 0, 0);
    od = __builtin_amdgcn_mfma_f32_32x32x16_bf16(pa1, AB_PK(l1, h1), od, 0, 0, 0);
    od = __builtin_amdgcn_mfma_f32_32x32x16_bf16(pa2, AB_PK(l2, h2), od, 0, 0, 0);
    od = __builtin_amdgcn_mfma_f32_32x32x16_bf16(pa3, AB_PK(l3, h3), od, 0, 0, 0);
#undef AB_PK
}
DI void pv_d0(f32x16* o, int vb, bf16x8 pa0, bf16x8 pa1, bf16x8 pa2, bf16x8 pa3) {
    pv_one<0>(o[0], vb, pa0, pa1, pa2, pa3); pv_one<1>(o[1], vb, pa0, pa1, pa2, pa3); pv_one<2>(o[2], vb, pa0, pa1, pa2, pa3); pv_one<3>(o[3], vb, pa0, pa1, pa2, pa3);
}
DI void body(const unsigned short* Qb, const unsigned short* Kh, h16* Ob, const h16* Wv, const unsigned long long* Mb, const int NT, LAS unsigned char* lds, const int wid, const int lane) {
    const int tid = wid * 64 + lane, r32 = lane & 31, hi = lane >> 5;
    LAS unsigned char* V_lds = lds; LAS unsigned char* K_lds = lds + 2 * SHM_V;
    LAS float* wsf = (LAS float*)(lds + LDS_RED) + wid * 64; LAS float* li_l = wsf; LAS float* al_l = wsf + 32;
    LAS unsigned long long* mkl = (LAS unsigned long long*)(lds + LDS_MK) + wid * 1024;
    float m_reg = -1e30f, l_reg = 0;
    f32x16 o[4];
#pragma unroll
    for (int d = 0; d < 4; ++d)
#pragma unroll
        for (int e = 0; e < 16; ++e) o[d][e] = 0.f;
    bf16x8 qr[8];
    const unsigned short* Qw = Qb + (size_t)(wid * 32 + r32) * NQ + hi * 8;
#pragma unroll
    for (int d0 = 0; d0 < 8; ++d0) qr[d0] = *(const bf16x8*)(Qw + d0 * 16);
    {
        const unsigned long long* mrow = Mb + (size_t)(wid * 32 + r32) * 32 + 2 * hi;
        for (int i = 0; i < (NT >> 2); ++i) { const u32x4 w = *(const u32x4*)(mrow + 4 * i);
            mkl[(4 * i + 2 * hi) * 32 + r32] = ((unsigned long long)w.y << 32) | w.x; mkl[(4 * i + 2 * hi + 1) * 32 + r32] = ((unsigned long long)w.w << 32) | w.z; }
    }
    const int sr = tid >> 4, sc = (tid & 15) * 8, vst0 = v_st(sr, sc), vst1 = v_st(32 + sr, sc);
    const int vb0 = (int)(unsigned)(uintptr_t)V_lds + v_rd_base(lane);
    bf16x8 st0[2], st1[2];
#define AB_SLOAD(i, k0) do { st0[i] = *(const bf16x8*)(Kh + (size_t)((k0) + sr) * 128 + sc); st1[i] = *(const bf16x8*)(Kh + (size_t)((k0) + 32 + sr) * 128 + sc); } while (0)
#define AB_SWRITE(b, i) do { *(LAS bf16x8*)(V_lds + (b) * SHM_V + vst0) = st0[i]; *(LAS bf16x8*)(V_lds + (b) * SHM_V + vst1) = st1[i]; const int kc = sc * 2; \
    *(LAS bf16x8*)(K_lds + (b) * SHM_K + AB_KSWZ(sr, kc)) = st0[i]; *(LAS bf16x8*)(K_lds + (b) * SHM_K + AB_KSWZ(32 + sr, kc)) = st1[i]; } while (0)
#define AB_SWAIT() asm volatile("s_waitcnt vmcnt(2)" ::: "memory")
#define AB_RESC(a) do { if (__any((a) < 1.f)) { if (hi == 0) al_l[r32] = (a); asm volatile("s_waitcnt lgkmcnt(0)" ::: "memory"); \
    _Pragma("unroll") for (int d = 0; d < 4; ++d) _Pragma("unroll") for (int r = 0; r < 16; ++r) o[d][r] *= al_l[crow(r, hi)]; } } while (0)
#define AB_MASK(j, WLO, WHI) const unsigned long long mw_##WLO = mkl[(j) * 32 + r32]; const unsigned WLO = (unsigned)mw_##WLO >> (4 * hi), WHI = (unsigned)(mw_##WLO >> 32) >> (4 * hi)
    f32x16 pA0, pA1, pB0, pB1; float mnA, mnB, alA, alB; bf16x8 pa0, pa1, pa2, pa3;
    AB_SLOAD(0, 0); asm volatile("s_waitcnt vmcnt(0)" ::: "memory"); AB_SWRITE(0, 0); __syncthreads();
    qkt(pA0, pA1, K_lds, qr, r32, hi); { AB_MASK(0, wl, wh); partialSM(pA0, pA1, m_reg, mnA, alA, wl, wh); }
    AB_SLOAD(1, 64); if (2 < NT) AB_SLOAD(0, 128);
    AB_SWAIT(); AB_SWRITE(1, 1); __syncthreads();
    for (int j = 1; j + 1 < NT; j += 2) {
        AB_SBAR(); qkt(pB0, pB1, K_lds + SHM_K, qr, r32, hi);
        finishSM(pA0, pA1, alA, l_reg, pa0, pa1, pa2, pa3); AB_SBAR();
        AB_SLOAD(1, (j + 2) * 64); AB_SBAR();
        pv_d0(o, vb0, pa0, pa1, pa2, pa3); { AB_MASK(j, wl, wh); partialSM(pB0, pB1, m_reg, mnB, alB, wl, wh); }
        __syncthreads(); AB_SWAIT(); AB_SWRITE(0, 0);
        AB_RESC(alB); __syncthreads();
        AB_SBAR(); qkt(pA0, pA1, K_lds, qr, r32, hi);
        finishSM(pB0, pB1, alB, l_reg, pa0, pa1, pa2, pa3); AB_SBAR();
        if (j + 3 < NT) AB_SLOAD(0, (j + 3) * 64); AB_SBAR();
        pv_d0(o, vb0 + SHM_V, pa0, pa1, pa2, pa3); { AB_MASK(j + 1, wl, wh); partialSM(pA0, pA1, m_reg, mnA, alA, wl, wh); }
        __syncthreads(); AB_SWAIT(); AB_SWRITE(1, 1);
        AB_RESC(alA); __syncthreads();
    }
    AB_SBAR(); qkt(pB0, pB1, K_lds + SHM_K, qr, r32, hi);
    finishSM(pA0, pA1, alA, l_reg, pa0, pa1, pa2, pa3); AB_SBAR();
    pv_d0(o, vb0, pa0, pa1, pa2, pa3); { AB_MASK(NT - 1, wl, wh); partialSM(pB0, pB1, m_reg, mnB, alB, wl, wh); }
    __syncthreads(); AB_RESC(alB);
    finishSM(pB0, pB1, alB, l_reg, pa0, pa1, pa2, pa3); AB_SBAR();
    pv_d0(o, vb0 + SHM_V, pa0, pa1, pa2, pa3);
    if (hi == 0) li_l[r32] = l_reg;
    asm volatile("s_waitcnt lgkmcnt(0)" ::: "memory");
    __syncthreads();
    LAS unsigned char* ob = lds + wid * 8192;
    const int le_ = lane_id(), r32e = le_ & 31, hie = le_ >> 5;
#pragma unroll
    for (int r = 0; r < 16; ++r) { const int orow = crow(r, hie); const float rli = __builtin_amdgcn_rcpf(li_l[orow]);
#pragma unroll
        for (int d0 = 0; d0 < 4; ++d0) { const int col = d0 * 32 + r32e; *(LAS h16*)(ob + orow * 256 + ((((col >> 3) ^ (orow & 15)) << 4) | ((col & 7) * 2))) = (h16)(o[d0][r] * rli); } }
    asm volatile("s_waitcnt lgkmcnt(0)" ::: "memory");
    f32x16 yv[2];
#pragma unroll
    for (int e = 0; e < 16; ++e) { yv[0][e] = 0.f; yv[1][e] = 0.f; }
#pragma unroll
    for (int s8 = 0; s8 < 8; ++s8) { const h16x8 af = *(const LAS h16x8*)(ob + r32e * 256 + (((2 * s8 + hie) ^ (r32e & 15)) << 4));
#pragma unroll
        for (int nt = 0; nt < 2; ++nt) { const h16x8 bf = *(const h16x8*)(Wv + (size_t)(32 * nt + r32e) * 128 + 16 * s8 + 8 * hie);
            yv[nt] = __builtin_amdgcn_mfma_f32_32x32x16_f16(af, bf, yv[nt], 0, 0, 0); } }
#pragma unroll
    for (int nt = 0; nt < 2; ++nt)
#pragma unroll
        for (int r = 0; r < 16; ++r) Ob[(size_t)(wid * 32 + crow(r, hie)) * KOUT + 32 * nt + r32e] = (h16)yv[nt][r];
#undef AB_SLOAD
#undef AB_SWRITE
#undef AB_SWAIT
#undef AB_RESC
#undef AB_MASK
}
}

DI void phase_attn(const Params& p, const Ctx& c, unsigned* qctr, const int l) {
    unsigned char* const ws = kws();
    const unsigned short* QALL = (const unsigned short*)kout(); const unsigned short* CKV = (const unsigned short*)(ws + WS_CKV);
    const unsigned long long* MASKG = (const unsigned long long*)(ws + WS_MASK); h16* AOUT = (h16*)(ws + WS_AOUT);
    const int wave = c.wave;
    volatile LAS unsigned* qw = (volatile LAS unsigned*)(c.lds + LDS_MISC + 64);
    for (;;) {
        const int lane = lane_id();
        if (wave == 0 && lane == 0) *qw = __hip_atomic_fetch_add(qctr, 1u, __ATOMIC_RELAXED, __HIP_MEMORY_SCOPE_AGENT);
        __syncthreads();
        const int unit = (int)*qw;
        __syncthreads();
        if (unit >= NB * 8 * 8) break;
        const int qb = 7 - (unit >> 7), b = (unit >> 3) & 15, h = unit & 7;
        const size_t row0 = (size_t)b * SEQ + 256 * qb;
        ab::body(QALL + row0 * NQ + h * 128, CKV + (size_t)b * SEQ * 128, AOUT + row0 * KOUT + h * 64, (const h16*)(ws + wofs(l) + WT_VUP) + h * 64 * 128, MASKG + row0 * 32, 4 * (qb + 1), c.lds, wave, lane);
        __syncthreads();
    }
}

DI int sw128(int row, int boff) { return row * 128 + ((((boff >> 4) ^ ((row >> 1) & 7)) << 4) | (boff & 15)); }
DI int sw64(int row, int boff)  { return row * 64 + ((((boff >> 4) ^ ((row >> 2) & 3)) << 4) | (boff & 15)); }
DI int sw32(int row, int boff)  { return row * 32 + ((((boff >> 4) ^ ((row >> 3) & 1)) << 4) | (boff & 15)); }
constexpr int SL_A1 = 0, SL_A4 = 4096, SL_WY = 8192, SL_VT = 12288, SL_A23 = 14336, SL_A5 = 15360, SL_P16 = 16384, SLOT = 16640;
DI float rl(float x, int l) { return __builtin_bit_cast(float, __builtin_amdgcn_readlane(__builtin_bit_cast(int, x), l)); }
template <int CTRL, int RM> DI float dppf_rm(float x) { return __builtin_bit_cast(float, __builtin_amdgcn_update_dpp(0, __builtin_bit_cast(int, x), CTRL, RM, 0xf, false)); }
DI float sum64u(float x) { x = sum16(x);
    asm("s_nop 1\n\tv_add_f32_dpp %0, %0, %0 row_bcast:15 row_mask:0xa bank_mask:0xf\n\ts_nop 1\n\tv_add_f32_dpp %0, %0, %0 row_bcast:31 row_mask:0xc bank_mask:0xf\n\ts_nop 0" : "+v"(x));
    return rl(x, 63); }
DI void sum64u2(float x, float y, float& rx, float& ry) {
#define S2_STEP(ctl) "v_add_f32_dpp %0, %0, %0 " ctl "\n\tv_add_f32_dpp %1, %1, %1 " ctl "\n\ts_nop 0\n\t"
    asm("s_nop 1\n\t"
        S2_STEP("quad_perm:[1,0,3,2] row_mask:0xf bank_mask:0xf bound_ctrl:1")
        S2_STEP("quad_perm:[2,3,0,1] row_mask:0xf bank_mask:0xf bound_ctrl:1")
        S2_STEP("row_half_mirror row_mask:0xf bank_mask:0xf bound_ctrl:1")
        S2_STEP("row_mirror row_mask:0xf bank_mask:0xf bound_ctrl:1")
        S2_STEP("row_bcast:15 row_mask:0xa bank_mask:0xf")
        S2_STEP("row_bcast:31 row_mask:0xc bank_mask:0xf")
        : "+v"(x), "+v"(y));
#undef S2_STEP
    rx = rl(x, 63); ry = rl(y, 63);
}
DI u32x4 pk8(float a, float b, float c, float d, float e, float f, float g, float h) { u32x4 w; w.x = pkh(a, b); w.y = pkh(c, d); w.z = pkh(e, f); w.w = pkh(g, h); return w; }

DI void phase_scan2(const Params& p, const Ctx& c, int l) {
    unsigned char* const ws = kws();
    const h16* RKV = (const h16*)(ws + WS_RKV); const h16* LO = (const h16*)(ws + WS_LORAO); h16* V1 = (h16*)(ws + WS_V1ST); h16* AOUT = (h16*)(ws + WS_AOUT);
    const int wave = c.wave;
    LAS unsigned char* const slot = c.lds + wave * SLOT;
    for (int u = blockIdx.x; u < NB * 8; u += c.G) {
        const int b = u >> 3, h = u & 7; const int col0 = h * 64 + lane_id();
        const float mur = kin<I_MU>()[l * 1824 + col0], muk = kin<I_MU>()[l * 1824 + 512 + col0], muv = kin<I_MU>()[l * 1824 + 1024 + col0];
        const float kkw = kin<I_KK>()[l * 512 + col0], kaw = kin<I_KA>()[l * 512 + col0], rkw = kin<I_RK>()[l * 512 + col0];
        const float lng = kin<I_LNXG>()[l * 512 + col0], lnb = kin<I_LNXB>()[l * 512 + col0];
        f32x16 Sg[2]; h16x8 sfrag[4];
#pragma unroll
        for (int i = 0; i < 16; ++i) { Sg[0][i] = 0.f; Sg[1][i] = 0.f; }
#pragma unroll
        for (int i = 0; i < 4; ++i) sfrag[i] = (h16x8){0, 0, 0, 0, 0, 0, 0, 0};
#pragma unroll 1
        for (int ss = 0; ss < SEQ / 128; ++ss) {
            const int lane = lane_id(), n = lane & 31, hh = lane >> 5, col = h * 64 + lane;
            const int t0 = 128 * ss + 16 * wave; const size_t m0 = (size_t)b * SEQ + t0;
            unsigned g12[16];
            {
                float Pin[16], vv[16];
                h16 wd[16], xr[2][8], xk[2][8], xv[2][8], xa[2][8], xg[2][8], xs[2][8], xf[2][8];
#define SC_LOAD_HALF(hb) { _Pragma("unroll") for (int tt = 0; tt < 8; ++tt) { const size_t m = m0 + 8 * (hb) + tt; const h16* q = RKV + m * NRKV + col; const h16* lp = LO + m * NLORA + col; \
                        xr[hb][tt] = q[0]; xk[hb][tt] = q[512]; xv[hb][tt] = q[1024]; xa[hb][tt] = lp[512]; xg[hb][tt] = lp[1024]; \
                        if (l != 0) { xs[hb][tt] = lp[1536]; xf[hb][tt] = V1[m * 512 + col]; } else { xs[hb][tt] = (h16)0.f; xf[hb][tt] = (h16)0.f; } } }
#pragma unroll
                for (int t = 0; t < 16; ++t) wd[t] = LO[(m0 + t) * NLORA + col];
                const h16* qprev = RKV + (m0 - (t0 > 0 ? 1 : 0)) * NRKV + col; const float zprev = (t0 > 0) ? 1.0f : 0.0f;
                const h16 pr_h = qprev[0], pk_h = qprev[512], pv_h = qprev[1024];
                SC_LOAD_HALF(0)
                asm volatile("" ::: "memory");
#pragma unroll
                for (int t = 0; t < 16; ++t) { const float wt = 1.0f - (float)wd[t]; Pin[t] = (t == 0) ? wt : Pin[t - 1] * wt; }
                const float P8 = Pin[7], iP8 = __builtin_amdgcn_rcpf(P8), P16 = Pin[15];
                const int q15 = lane & 15, pos = 16 * (lane >> 4) + 8 * ((q15 >> 2) & 1) + 4 * (q15 >> 3) + (q15 & 3);
                int xbL[8], xbP[8], xa4[4];
#pragma unroll
                for (int e = 0; e < 8; ++e) { xbL[e] = ((((2 * lane) >> 4) ^ e) << 4) | ((2 * lane) & 15); xbP[e] = ((((2 * pos) >> 4) ^ e) << 4) | ((2 * pos) & 15); }
#pragma unroll
                for (int e = 0; e < 4; ++e) xa4[e] = lane * 64 + ((e ^ ((lane >> 2) & 3)) << 4);
                {
                    float pr = (float)pr_h * zprev, pk = (float)pk_h * zprev, pv = (float)pv_h * zprev;
#pragma unroll
                    for (int hb = 0; hb < 2; ++hb) {
                    if (hb == 0) { SC_LOAD_HALF(1) asm volatile("" ::: "memory"); }
#pragma unroll
                    for (int tt = 0; tt < 8; ++tt) {
                        const int t = 8 * hb + tt; const size_t m = m0 + t;
                        const float r0 = (float)xr[hb][tt], k0 = (float)xk[hb][tt], v0 = (float)xv[hb][tt];
                        const float aa = (float)xa[hb][tt], gg = (float)xg[hb][tt], sg = (float)xs[hb][tt];
                        const float r = r0 + (pr - r0) * mur, k = k0 + (pk - k0) * muk; float v = v0 + (pv - v0) * muv;
                        pr = r0; pk = k0; pv = v0;
                        if (l == 0) V1[m * 512 + col] = (h16)v; else { const float vf = (float)xf[hb][tt]; v = v + (vf - v) * sg; }
                        const float kkr = k * kkw, kpv = k * (1.0f + (aa - 1.0f) * kaw);
                        float ssq, bon; sum64u2(kkr * kkr, r * kpv * rkw, ssq, bon);
                        const float kn = kkr * __builtin_amdgcn_rcpf(fmaxf(__builtin_amdgcn_sqrtf(ssq), 1e-12f)), bt = kn * aa;
                        vv[t] = v; g12[t] = pkh(lng * gg, (lnb + bon * v) * gg);
                        const float iPt = __builtin_amdgcn_rcpf(Pin[t]);
                        const float gin = Pin[t] * iP8, pex = (t == 0) ? 1.0f : Pin[t - 1], gex = pex * iP8, ig = P8 * iPt, sfx = P16 * iPt;
                        *(LAS h16*)(slot + SL_WY + t * 128 + xbL[(t >> 1) & 7]) = (h16)(bt * ig);
                        *(LAS h16*)(slot + SL_WY + (16 + t) * 128 + xbL[(t >> 1) & 7]) = (h16)(kpv * ig);
                        *(LAS h16*)(slot + SL_WY + 4096 + t * 128 + xbL[(t >> 1) & 7]) = (h16)(kn * gex);
                        *(LAS h16*)(slot + SL_WY + 4096 + (16 + t) * 128 + xbL[(t >> 1) & 7]) = (h16)(r * gin);
                        *(LAS h16*)(slot + SL_A1 + t * 128 + xbP[(t >> 1) & 7]) = (h16)(kn * pex);
                        *(LAS h16*)(slot + SL_A1 + (16 + t) * 128 + xbP[(t >> 1) & 7]) = (h16)(r * Pin[t]);
                        const int ps = 8 * ((t >> 2) & 1) + 4 * (t >> 3) + (t & 3);
                        *(LAS h16*)(slot + SL_A4 + xa4[(2 * ps) >> 4] + ((2 * ps) & 15)) = (h16)(bt * sfx);
                        *(LAS h16*)(slot + SL_A4 + xa4[2 + ((2 * ps) >> 4)] + ((2 * ps) & 15)) = (h16)(kpv * sfx);
                    }
                    }
                }
                *(LAS float*)(slot + SL_P16 + 4 * lane) = P16;
                asm volatile("s_waitcnt lgkmcnt(0)" ::: "memory");
                f32x16 G;
#pragma unroll
                for (int i = 0; i < 16; ++i) G[i] = 0.f;
#pragma unroll
                for (int ks = 0; ks < 4; ++ks) { const h16x8 af = *(const LAS h16x8*)(slot + SL_WY + sw128(n, (16 * ks + 8 * hh) * 2)), bf = *(const LAS h16x8*)(slot + SL_WY + 4096 + sw128(n, (16 * ks + 8 * hh) * 2));
                    G = __builtin_amdgcn_mfma_f32_32x32x16_f16(af, bf, G, 0, 0, 0); }
                {
                    const int t = n & 15; const bool isR = n >= 16;
                    float top[8], bot[8];
#pragma unroll
                    for (int i = 0; i < 8; ++i) { const int ip = (i & 3) + 8 * (i >> 2) + 4 * hh; const bool keep = isR ? (ip <= t) : (ip < t);
                        top[i] = keep ? G[i] : 0.f; bot[i] = keep ? (isR ? G[8 + i] : -G[8 + i]) : 0.f; }
                    asm volatile("s_waitcnt lgkmcnt(0)" ::: "memory");
                    if (isR) *(LAS u32x4*)(slot + SL_A23 + sw32(n, 16 * hh)) = pk8(top[0], top[1], top[2], top[3], top[4], top[5], top[6], top[7]);
                    *(LAS u32x4*)(slot + SL_A5 + sw32(n, 16 * hh)) = pk8(bot[0], bot[1], bot[2], bot[3], bot[4], bot[5], bot[6], bot[7]);
                    {
                        const int r16 = lane & 15; float Tr[16];
#pragma unroll
                        for (int j = 0; j < 16; ++j) { float acc = (j == r16) ? 1.0f : 0.0f;
#pragma unroll
                            for (int i = 0; i < j; ++i) acc -= rl(top[(i & 3) + 4 * (i >> 3)], j + 32 * ((i >> 2) & 1)) * Tr[i];
                            Tr[j] = acc; }
                        const int ps2 = 2 * (8 * ((r16 >> 2) & 1) + 4 * (r16 >> 3) + (r16 & 3));
                        if (lane < 16) {
#pragma unroll
                            for (int t2 = 0; t2 < 16; ++t2) *(LAS h16*)(slot + SL_A23 + sw32(t2, ps2)) = (h16)Tr[t2];
                        }
                    }
                }
                *(LAS u32x4*)(slot + SL_VT + sw32(lane, 0)) = pk8(vv[0], vv[1], vv[2], vv[3], vv[8], vv[9], vv[10], vv[11]);
                *(LAS u32x4*)(slot + SL_VT + sw32(lane, 16)) = pk8(vv[4], vv[5], vv[6], vv[7], vv[12], vv[13], vv[14], vv[15]);
                asm volatile("s_waitcnt lgkmcnt(0)" ::: "memory");
                {
                    const h16x8 a5 = *(const LAS h16x8*)(slot + SL_A5 + sw32(n, 16 * hh));
#pragma unroll
                    for (int vt = 0; vt < 2; ++vt) { const h16x8 vf = *(const LAS h16x8*)(slot + SL_VT + sw32(32 * vt + n, 16 * hh));
                        f32x16 Wm;
#pragma unroll
                        for (int i = 0; i < 16; ++i) Wm[i] = 0.f;
                        Wm = __builtin_amdgcn_mfma_f32_32x32x16_f16(a5, vf, Wm, 0, 0, 0);
                        *(LAS u32x4*)(slot + SL_WY + vt * 2048 + sw32(lane, 0)) = pk8(Wm[0], Wm[1], Wm[2], Wm[3], Wm[4], Wm[5], Wm[6], Wm[7]);
                        *(LAS u32x4*)(slot + SL_WY + vt * 2048 + sw32(lane, 16)) = pk8(Wm[8], Wm[9], Wm[10], Wm[11], Wm[12], Wm[13], Wm[14], Wm[15]); }
                }
            }
            __syncthreads();
            if (wave < 2) {
                const int vt = wave;
#pragma unroll 1
                for (int j = 0; j < 8; ++j) {
                    const LAS unsigned char* sb = c.lds + j * SLOT;
                    h16x8 a1[4], a4[2][2];
#pragma unroll
                    for (int ks = 0; ks < 4; ++ks) a1[ks] = *(const LAS h16x8*)(sb + SL_A1 + sw128(n, (16 * ks + 8 * hh) * 2));
                    const u32x4 wy0 = *(const LAS u32x4*)(sb + SL_WY + vt * 2048 + sw32(lane, 0)), wy1 = *(const LAS u32x4*)(sb + SL_WY + vt * 2048 + sw32(lane, 16));
                    const h16x8 a23 = *(const LAS h16x8*)(sb + SL_A23 + sw32(n, 16 * hh));
#pragma unroll
                    for (int kt = 0; kt < 2; ++kt)
#pragma unroll
                        for (int s2 = 0; s2 < 2; ++s2) a4[kt][s2] = *(const LAS h16x8*)(sb + SL_A4 + sw64(32 * kt + n, 32 * s2 + 16 * hh));
                    const h16x8 vf = *(const LAS h16x8*)(sb + SL_VT + sw32(32 * vt + n, 16 * hh));
                    f32x16 D1;
#pragma unroll
                    for (int i = 0; i < 16; ++i) D1[i] = 0.f;
#pragma unroll
                    for (int ks = 0; ks < 4; ++ks) D1 = __builtin_amdgcn_mfma_f32_32x32x16_f16(a1[ks], sfrag[ks], D1, 0, 0, 0);
                    const float w0v[8] = {hlo(wy0.x), hhi(wy0.x), hlo(wy0.y), hhi(wy0.y), hlo(wy0.z), hhi(wy0.z), hlo(wy0.w), hhi(wy0.w)};
                    const float y0v[8] = {hlo(wy1.x), hhi(wy1.x), hlo(wy1.y), hhi(wy1.y), hlo(wy1.z), hhi(wy1.z), hlo(wy1.w), hhi(wy1.w)};
                    const u32x4 ubw = pk8(w0v[0] - D1[0], w0v[1] - D1[1], w0v[2] - D1[2], w0v[3] - D1[3], w0v[4] - D1[4], w0v[5] - D1[5], w0v[6] - D1[6], w0v[7] - D1[7]);
                    f32x16 D2;
#pragma unroll
                    for (int i = 0; i < 16; ++i) D2[i] = 0.f;
                    D2 = __builtin_amdgcn_mfma_f32_32x32x16_f16(a23, __builtin_bit_cast(h16x8, ubw), D2, 0, 0, 0);
                    const h16x8 uf = __builtin_bit_cast(h16x8, pk8(D2[0], D2[1], D2[2], D2[3], D2[4], D2[5], D2[6], D2[7]));
                    D1 = __builtin_amdgcn_mfma_f32_32x32x16_f16(a23, uf, D1, 0, 0, 0);
#pragma unroll
                    for (int kt = 0; kt < 2; ++kt) {
                        f32x4 p16[4];
#pragma unroll
                        for (int g = 0; g < 4; ++g) p16[g] = *(const LAS f32x4*)(sb + SL_P16 + (32 * kt + 8 * g + 4 * hh) * 4);
#pragma unroll
                        for (int i = 0; i < 16; ++i) Sg[kt][i] *= p16[i >> 2][i & 3];
                        Sg[kt] = __builtin_amdgcn_mfma_f32_32x32x16_f16(a4[kt][0], uf, Sg[kt], 0, 0, 0);
                        Sg[kt] = __builtin_amdgcn_mfma_f32_32x32x16_f16(a4[kt][1], vf, Sg[kt], 0, 0, 0);
                    }
                    LAS float* yo = (LAS float*)(c.lds + j * SLOT + SL_WY + vt * 2048);
#pragma unroll
                    for (int i = 0; i < 8; ++i) { const int t = (i & 3) + 8 * (i >> 2) + 4 * hh; yo[t * 32 + n] = D1[8 + i] + y0v[i]; }
#pragma unroll
                    for (int kt = 0; kt < 2; ++kt)
#pragma unroll
                        for (int s = 0; s < 2; ++s) sfrag[2 * kt + s] = __builtin_bit_cast(h16x8, pk8(Sg[kt][8 * s], Sg[kt][8 * s + 1], Sg[kt][8 * s + 2], Sg[kt][8 * s + 3], Sg[kt][8 * s + 4], Sg[kt][8 * s + 5], Sg[kt][8 * s + 6], Sg[kt][8 * s + 7]));
                }
            }
            __syncthreads();
            {
                const LAS float* yi = (const LAS float*)(slot + SL_WY + hh * 2048);
                float yv[16];
#pragma unroll
                for (int t = 0; t < 16; ++t) yv[t] = yi[t * 32 + n];
#pragma unroll
                for (int t = 0; t < 16; t += 2) {
                    float s0, s1; sum64u2(yv[t], yv[t + 1], s0, s1);
                    const float dv0 = yv[t] - s0 * (1.0f / 64.0f), dv1 = yv[t + 1] - s1 * (1.0f / 64.0f);
                    float q0, q1; sum64u2(dv0 * dv0, dv1 * dv1, q0, q1);
                    const float o0 = dv0 * rsqrtf(q0 * (1.0f / 64.0f) + LNX_EPS) * hlo(g12[t]) + hhi(g12[t]);
                    const float o1 = dv1 * rsqrtf(q1 * (1.0f / 64.0f) + LNX_EPS) * hlo(g12[t + 1]) + hhi(g12[t + 1]);
                    AOUT[(m0 + t) * KOUT + 512 + col] = (h16)o0; AOUT[(m0 + t + 1) * KOUT + 512 + col] = (h16)o1;
                }
            }
            asm volatile("s_waitcnt lgkmcnt(0)" ::: "memory");
        }
        __syncthreads();
    }
}

constexpr int STEPS_PER_LAYER = 10, NSTEPS = 2 + NL * STEPS_PER_LAYER;
#define IN(k) (lo <= (k) && (k) < hi)
#define SEAM(k) do { if (IN(k) && IN((k) + 1)) xcd_barrier(bar, c.wave); } while (0)
template <int l>
DI void layer_steps(const Params& p, const Ctx& c, const XcdBarrier& bar, const int lo, const int hi) {
        const int s0 = 2 + l * STEPS_PER_LAYER;
        if (IN(s0 + 0)) { unsigned char* const ws = kws();
            {
              pg8::Gemm g{(const h16*)(ws + WS_H), (const h16*)(ws + wofs(l) + WT_IN), MT, NIN16, DM, DM, DM}; pg8::StaticOrder S; S.init(MT, NIN16, c.G, (int)blockIdx.x);
              pg8::EpiH16 E{(h16*)(ws + WS_COLSA), NCA, 1000, nullptr, 0};
              pg8::gemm_phase(c.lds, g, S, E, c.wave); }
            {
              pg8::Gemm g{(const h16*)(ws + WS_H8IN), (const h16*)(ws + wofs(l) + WT_IN + (size_t)NIN16 * DM * 2), MT, NIN - NIN16, DM / 2, DM / 2, DM / 2}; pg8::StaticOrder S; S.init(MT, NIN - NIN16, c.G, (int)blockIdx.x);
              pg8::EpiH16I8 E{(h16*)(ws + WS_COLSA) + NIN16, NCA, 1, (h16*)(ws + WS_RKV), NRKV, (const float*)(ws + WS_RS), wmax_load(ws, l, 1) * (1.0f / 127.0f)};
              pg8::gemm_phase(c.lds, g, S, E, c.wave); }
            if (l + 1 < NL && c.G > NB * 8 && blockIdx.x >= NB * 8) { __syncthreads(); Ctx c2 = c; c2.gw = (blockIdx.x - NB * 8) * 8 + c.wave; c2.ngw = (c.G - NB * 8) * 8; phase_wmax(p, c2, l + 1); phase_wconv(p, c2, l + 1, 0, WC_P1, false); }
        }
        SEAM(s0 + 0);
        if (IN(s0 + 1)) phase_prep(p, c, l);
        SEAM(s0 + 1);
        if (IN(s0 + 2)) { unsigned char* const ws = kws();
            { pg8::Gemm g{(const h16*)(ws + WS_CQ), (const h16*)(ws + wofs(l) + WT_Q), MT, NQ, 256, 256, 256}; pg8::StaticOrder S; S.init(MT, NQ, c.G, (int)blockIdx.x);
              pg8::EpiQ E{(h16*)kout()};
              pg8::gemm_phase(c.lds, g, S, E, c.wave); }
            {
              pg8::Gemm g{(const h16*)(ws + WS_ALORA), (const h16*)(ws + wofs(l) + WT_LORA), MT, 1024, 128, KLORA, 128}; pg8::StaticOrder S; S.init(MT, 1024, c.G, (int)blockIdx.x);
              pg8::EpiLora E{(h16*)(ws + WS_LORAO), kin<I_W0>() + l * 512, kin<I_A0>() + l * 512, kin<I_V0>() + (l > 0 ? l - 1 : 0) * 512, l > 0 ? 1 : 0, 0};
              pg8::gemm_phase(c.lds, g, S, E, c.wave); }
            {
              constexpr int N2 = (l > 0) ? 1024 : 512;
              pg8::Gemm g{(const h16*)(ws + WS_ALORA) + 128, (const h16*)(ws + wofs(l) + WT_LORA) + 1024 * 128, MT, N2, 256, KLORA, 256}; pg8::StaticOrder S; S.init(MT, N2, c.G, (int)blockIdx.x);
              pg8::EpiLora E{(h16*)(ws + WS_LORAO), kin<I_W0>() + l * 512, kin<I_A0>() + l * 512, kin<I_V0>() + (l > 0 ? l - 1 : 0) * 512, l > 0 ? 1 : 0, 4};
              pg8::gemm_phase(c.lds, g, S, E, c.wave); }
        }
        SEAM(s0 + 2);
        if (IN(s0 + 3)) { unsigned char* const ws = kws(); if (blockIdx.x < NB * 8) { phase_scan2(p, c, l); __syncthreads(); }
            else if (l + 1 < NL) { Ctx c2 = c; c2.gw = (blockIdx.x - NB * 8) * 8 + c.wave; c2.ngw = (c.G - NB * 8) * 8; phase_wconv(p, c2, l + 1, WC_P1, WC_NIT, true); __syncthreads(); }
            phase_select(p, c, (unsigned*)(ws + WS_CTL) + 8192 + 64 * l); }
        SEAM(s0 + 3);
        if (IN(s0 + 4)) { unsigned char* const ws = kws(); phase_attn(p, c, (unsigned*)(ws + WS_CTL) + 8192 + 64 * l + 16, l); }
        SEAM(s0 + 4);
        if (IN(s0 + 5)) { unsigned char* const ws = kws();
            pg8::Gemm g{(const h16*)(ws + WS_AOUT), (const h16*)(ws + wofs(l) + WT_OUT), MT, DM, KOUT, KOUT, KOUT}; pg8::StaticOrder S; S.init(MT, DM, c.G, (int)blockIdx.x);
            pg8::EpiH16 E{(h16*)(ws + WS_Y), DM, 1000, nullptr, 0};
            pg8::gemm_phase(c.lds, g, S, E, c.wave);
        }
        SEAM(s0 + 5);
        if (IN(s0 + 6)) { phase_rows<1, true, false, 1>(p, c, (const h16*)(kws() + WS_Y), kin<I_POSTMIX>() + l * DM, 2048, l, kin<I_PREFFN>() + l * DM, 3072, 4096, l, -1);
                          if (l + 1 < NL && c.G <= NB * 8) phase_wmax(p, c, l + 1); }
        SEAM(s0 + 6);
        if (IN(s0 + 7)) { unsigned char* const ws = kws();
            pg8::Gemm g{(const h16*)(ws + WS_H), (const h16*)(ws + wofs(l) + WT_FC), MT, NFC, DM / 2, DM / 2, DM / 2}; pg8::StaticOrder S; S.init(MT, NFC, c.G, (int)blockIdx.x);
            pg8::EpiSwigluI8 E{(h16*)(ws + WS_HID), (const float*)(ws + WS_RS), wmax_load(ws, l, 0) * (1.0f / 127.0f)};
            pg8::gemm_phase(c.lds, g, S, E, c.wave);
        }
        SEAM(s0 + 7);
        if (IN(s0 + 8)) { unsigned char* const ws = kws();
            pg8::Gemm g{(const h16*)(ws + WS_HID), (const h16*)(ws + wofs(l) + WT_DOWN), MT, DM, DFF, DFF, DFF}; pg8::StaticOrder S; S.init(MT, DM, c.G, (int)blockIdx.x);
            pg8::EpiH16 E{(h16*)(ws + WS_Y2), DM, 1000, nullptr, 0};
            pg8::gemm_phase(c.lds, g, S, E, c.wave);
        }
        SEAM(s0 + 8);
        if (IN(s0 + 9)) { unsigned char* const ws = kws();
            if (l + 1 < NL) { phase_rows<1, true, true, 2>(p, c, (const h16*)(ws + WS_Y2), kin<I_POSTFFN>() + l * DM, 5120, l, kin<I_PREMIX>() + (l + 1) * DM, 0, 1024, l + 1, l + 1);
                              if (c.G <= NB * 8) { __syncthreads(); phase_wconv(p, c, l + 1, 0, WC_NIT, true); } }
            else phase_rows<1, false, false>(p, c, (const h16*)(ws + WS_Y2), kin<I_POSTFFN>() + l * DM, 5120, l, nullptr, 0, 0, 0, -1);
        }
        SEAM(s0 + 9);
    }
#undef IN
#undef SEAM

__global__ void __launch_bounds__(NTHR, 2) fwd_kernel(Params p) {
    extern __shared__ __attribute__((aligned(16))) unsigned char lds_raw[];
    Ctx c; c.lds = (LAS unsigned char*)lds_raw; c.wave = __builtin_amdgcn_readfirstlane((int)threadIdx.x >> 6);
    c.G = gridDim.x; c.gw = blockIdx.x * 8 + c.wave; c.ngw = c.G * 8;
    volatile LAS unsigned* misc = (volatile LAS unsigned*)(c.lds + LDS_MISC);
    if (c.wave == 0) misc[lane_id()] = 0u;
    __syncthreads();
    unsigned* ctl = (unsigned*)(kws() + WS_CTL);
    XcdBarrier bar; bar.bar = ctl; bar.x = 0; bar.st = nullptr;
    const bool multi = (p.step_hi - p.step_lo) > 1;
    if (multi) bar = xcd_barrier_post(ctl, misc + 8, c.wave);
    const int lo = p.step_lo, hi = p.step_hi;
#define IN(k) (lo <= (k) && (k) < hi)
#define SEAM(k) do { if (IN(k) && IN((k) + 1)) xcd_barrier(bar, c.wave); } while (0)

    if (IN(0)) { phase_mod(p, c); __syncthreads();
        if (c.G > NB * 8) {
            if (blockIdx.x >= NB * 8) { Ctx c2 = c; c2.gw = (blockIdx.x - NB * 8) * 8 + c.wave; c2.ngw = (c.G - NB * 8) * 8; phase_wmax(p, c2, 0); phase_wconv(p, c2, 0, 0, WC_NOQ, false); }
            phase_wconv(p, c, 0, 0, 0, true);
        } else { phase_wmax(p, c, 0); phase_wconv(p, c, 0, 0, WC_NOQ, true); } }
    SEAM(0);
    if (IN(1)) { phase_rows<0, true, true, 2>(p, c, nullptr, nullptr, 0, 0, kin<I_PREMIX>(), 0, 1024, 0, 0); phase_wconv(p, c, 0, WC_NOQ, WC_NIT, false); }
    SEAM(1);
    layer_steps<0>(p, c, bar, lo, hi);
    layer_steps<1>(p, c, bar, lo, hi);
    layer_steps<2>(p, c, bar, lo, hi);
    layer_steps<3>(p, c, bar, lo, hi);
#undef IN
#undef SEAM
}

extern "C" void kernel_launch(void* const* d_in, const int* in_sizes, int n_in, void* d_out, int out_size, void* d_ws, size_t ws_size, hipStream_t stream) {
    static int grid = 0;
    if (grid == 0) {
        if (n_in != 35 || out_size != MT * DM || ws_size < WS_NEED) { fprintf(stderr, "kernel_launch: unexpected problem (n_in %d out %d ws %zu)\n", n_in, out_size, ws_size); grid = -1; return; }
        int dev = 0, cus = 0, per_cu = 0;
        if (hipGetDevice(&dev) != hipSuccess || hipDeviceGetAttribute(&cus, hipDeviceAttributeMultiprocessorCount, dev) != hipSuccess) { grid = -1; return; }
        if (hipFuncSetAttribute((const void*)fwd_kernel, hipFuncAttributeMaxDynamicSharedMemorySize, LDS_BYTES) != hipSuccess) { fprintf(stderr, "kernel_launch: hipFuncSetAttribute failed\n"); grid = -1; return; }
        if (hipOccupancyMaxActiveBlocksPerMultiprocessor(&per_cu, (const void*)fwd_kernel, NTHR, LDS_BYTES) != hipSuccess || per_cu < 1) { fprintf(stderr, "kernel_launch: occupancy query says %d\n", per_cu); (void)hipGetLastError(); per_cu = 1; }
        grid = cus;
        if (grid > 256) grid = 256;
    }
    if (grid < 0) return;
    (void)hipMemsetAsync((char*)d_ws + WS_CTL, 0, CTL_BYTES, stream);
    Params p{};
    for (int i = 0; i < 35; ++i) p.in[i] = (const float*)d_in[i];
    p.out = (float*)d_out; p.ws = (unsigned char*)d_ws;
#if MK_PER_STEP_LAUNCH
    for (int s = 0; s < NSTEPS; ++s) { p.step_lo = s; p.step_hi = s + 1; hipLaunchKernelGGL(fwd_kernel, dim3(grid), dim3(NTHR), LDS_BYTES, stream, p); }
#else
    p.step_lo = 0; p.step_hi = NSTEPS;
    hipLaunchKernelGGL(fwd_kernel, dim3(grid), dim3(NTHR), LDS_BYTES, stream, p);
#endif
}
```

```cpp
#include <hip/hip_runtime.h>
#include <cstdio>
#include <cstdint>

#ifndef MK_PER_STEP_LAUNCH
#define MK_PER_STEP_LAUNCH 0
#endif

#define DI __device__ __forceinline__
#define LAS __attribute__((address_space(3)))
typedef _Float16 h16;
typedef h16 h16x8 __attribute__((ext_vector_type(8)));
typedef h16 h16x4 __attribute__((ext_vector_type(4)));
typedef h16 h16x2 __attribute__((ext_vector_type(2)));
typedef float f32x2 __attribute__((ext_vector_type(2)));
typedef float f32x4 __attribute__((ext_vector_type(4)));
typedef float f32x16 __attribute__((ext_vector_type(16)));
typedef unsigned u32x2 __attribute__((ext_vector_type(2)));
typedef unsigned u32x4 __attribute__((ext_vector_type(4)));
typedef int i32x4 __attribute__((ext_vector_type(4)));

constexpr int NB = 16, SEQ = 2048, DM = 1024, NL = 4, MT = NB * SEQ;
constexpr int PIN = 2276;
constexpr int NCA = 768, NRKV = 1536, NIN = NCA + NRKV;
constexpr int WC_NOQ = (2816 / 64) * (1024 / 32) + 16 * (1024 / 32), WC_NIT = WC_NOQ + 16 * ((768 + 1536) / 32) + 16 * (5632 / 32), WC_P1 = 0, NIN16 = 512;
constexpr int NQ = 1280, KLORA = 384, NLORA = 2048, KOUT = 1024, NFC = 5632, DFF = 2816;
constexpr float NORM_EPS = 1e-6f, LNX_EPS = 64e-5f;

constexpr size_t MiB = 1u << 20;
constexpr size_t WS_CTL = 0, CTL_BYTES = 64 * 1024;
constexpr size_t WS_MOD = 1 * MiB;
constexpr size_t WS_WIDX = 3 * MiB;
constexpr size_t WS_RS = 3 * MiB + 512 * 1024;
constexpr size_t WS_H8IN = 148 * MiB;
constexpr size_t WS_KIDX = 4 * MiB;
constexpr size_t WS_CKV = 8 * MiB;
constexpr size_t WS_CKVT = 16 * MiB;
constexpr size_t WS_V1ST = 24 * MiB;
constexpr size_t WS_WTS = 56 * MiB;
constexpr size_t WT_IN = WS_WTS, WT_Q = WT_IN + (size_t)NIN * DM * 2, WT_LORA = WT_Q + (size_t)NQ * 256 * 2, WT_OUT = WT_LORA + (size_t)NLORA * KLORA * 2,
                 WT_VUP = WT_OUT + (size_t)DM * KOUT * 2  , WT_FC = WT_OUT + (size_t)DM * 1536 * 2, WT_DOWN = WT_FC + (size_t)NFC * DM * 2, WT_END = WT_DOWN + (size_t)DM * DFF * 2;
static_assert(WT_END <= 84 * MiB, "weights region");
constexpr size_t WS_H = 84 * MiB;
constexpr size_t WS_CQ = 148 * MiB;
constexpr size_t WS_ALORA = 164 * MiB;
constexpr size_t WS_AOUT = 84 * MiB;
constexpr size_t WS_RKV = 188 * MiB;
constexpr size_t WS_COLSA = 284 * MiB;
constexpr size_t WS_LORAO = 284 * MiB;
constexpr size_t WS_X16 = 412 * MiB;
constexpr size_t WS_Y = 188 * MiB;
constexpr size_t WS_HID = 188 * MiB;
constexpr size_t WS_Y2 = 84 * MiB;
constexpr size_t WS_MASK = 476 * MiB;
constexpr size_t WS_WTS2 = 484 * MiB;
constexpr size_t WS_NEED = 484 * MiB + (84 - 56) * MiB;
DI size_t wofs(int l) { return (l & 1) ? (WS_WTS2 - WS_WTS) : 0; }

constexpr int LDS_BYTES = 147456;
constexpr int LDS_MISC = LDS_BYTES - 256;
constexpr int NTHR = 512;

DI unsigned pkh(float a, float b) { h16x2 v; v.x = (h16)a; v.y = (h16)b; return __builtin_bit_cast(unsigned, v); }
DI unsigned pkb(float lo, float hi) { unsigned r; asm("v_cvt_pk_bf16_f32 %0, %1, %2" : "=v"(r) : "v"(lo), "v"(hi)); return r; }
DI float hlo(unsigned u) { h16x2 v = __builtin_bit_cast(h16x2, u); return (float)v.x; }
DI float hhi(unsigned u) { h16x2 v = __builtin_bit_cast(h16x2, u); return (float)v.y; }
DI float h2f(unsigned short s) { return (float)__builtin_bit_cast(h16, s); }
DI unsigned short f2h(float f) { return __builtin_bit_cast(unsigned short, (h16)f); }
template <int CTRL> DI float dppf(float x) { return __builtin_bit_cast(float, __builtin_amdgcn_update_dpp(0, __builtin_bit_cast(int, x), CTRL, 0xf, 0xf, false)); }
template <int CTRL> DI unsigned dppu(unsigned x) { return (unsigned)__builtin_amdgcn_update_dpp(0, (int)x, CTRL, 0xf, 0xf, false); }
template <int CTRL, int RM> DI unsigned dppu_rm(unsigned x) { return (unsigned)__builtin_amdgcn_update_dpp(0, (int)x, CTRL, RM, 0xf, false); }
DI unsigned umax_(unsigned a, unsigned b) { return a > b ? a : b; }
DI unsigned max64u(unsigned x) {
    x = umax_(x, dppu<0xB1>(x)); x = umax_(x, dppu<0x4E>(x)); x = umax_(x, dppu<0x141>(x)); x = umax_(x, dppu<0x140>(x));
    x = umax_(x, dppu_rm<0x142, 0xA>(x)); x = umax_(x, dppu_rm<0x143, 0xC>(x)); return (unsigned)__builtin_amdgcn_readlane((int)x, 63);
}
DI float sum4(float x) { x += dppf<0xB1>(x); x += dppf<0x4E>(x); return x; }
DI float sum8(float x) { x = sum4(x); x += dppf<0x141>(x); return x; }
DI float sum16(float x) { x = sum8(x); x += dppf<0x140>(x); return x; }
DI unsigned usum16(unsigned x) { x += dppu<0xB1>(x); x += dppu<0x4E>(x); x += dppu<0x141>(x); x += dppu<0x140>(x); return x; }
DI float sum64(float x) { x = sum16(x); x += __shfl_xor(x, 16); x += __shfl_xor(x, 32); return x; }
DI int lane_id() { int l; asm volatile("v_mbcnt_lo_u32_b32 %0, -1, 0\n\tv_mbcnt_hi_u32_b32 %0, -1, %0" : "=v"(l)); return l; }
DI float sigmoidf_(float z) { return __builtin_amdgcn_rcpf(1.0f + __expf(-z)); }
DI float tanhf_(float z) { return 1.0f - 2.0f * __builtin_amdgcn_rcpf(1.0f + __expf(2.0f * z)); }

#define XB_TMO      128
#define XB_XCNT(j)  (256  + 64 * (j))
#define XB_XSUB(j)  (1280 + 64 * (j))
#define XB_XGEN(j)  (2304 + 64 * (j))
#define XB_TOP      3328
#define XB_TOPGEN   3392
#define XCD_BAR_WORDS 3456
#define XB_SPIN_CAP (1u << 18)
DI unsigned xb_ld(unsigned* p)              { return __hip_atomic_load(p, __ATOMIC_RELAXED, __HIP_MEMORY_SCOPE_AGENT); }
DI unsigned xb_add(unsigned* p, unsigned v) { return __hip_atomic_fetch_add(p, v, __ATOMIC_RELAXED, __HIP_MEMORY_SCOPE_AGENT); }
DI unsigned xb_xcc_id() { return (unsigned)__builtin_amdgcn_s_getreg((3 << 11) | 20) & 0xFu; }
#define XB_SPIN(cond, bar) do { unsigned _sp = 0; while (cond) { __builtin_amdgcn_s_sleep(1); \
    if ((++_sp & 255u) == 0u) { if (xb_ld(&(bar)[XB_TMO])) break; if (_sp > XB_SPIN_CAP) { atomicAdd(&(bar)[XB_TMO], 1u); break; } } } } while (0)
struct XcdBarrier { unsigned* bar; unsigned x; volatile LAS unsigned* st; };
DI XcdBarrier xcd_barrier_post(unsigned* bar, volatile LAS unsigned* st, int wave) {
    XcdBarrier b; b.bar = bar; b.x = xb_xcc_id(); b.st = st;
    if (wave == 0 && lane_id() == 0) (void)xb_add(&bar[XB_XCNT(b.x)], 1u);
    return b;
}
DI void xcd_barrier_complete(unsigned* bar, unsigned x, unsigned& nloc, unsigned& nx) {
    const unsigned G = gridDim.x * gridDim.y * gridDim.z;
    unsigned sum, cnt, mine, sp = 0u;
    for (;;) {
        sum = 0u; cnt = 0u; mine = 0u;
#pragma unroll
        for (unsigned j = 0; j < 16; ++j) { const unsigned c = xb_ld(&bar[XB_XCNT(j)]); sum += c; cnt += (c > 0u) ? 1u : 0u; mine = (j == x) ? c : mine; }
        if (sum == G) break;
        __builtin_amdgcn_s_sleep(1);
        if ((++sp & 255u) == 0u) { if (xb_ld(&bar[XB_TMO])) break; if (sp > XB_SPIN_CAP) { atomicAdd(&bar[XB_TMO], 1u); break; } }
    }
    nloc = mine > 0u ? mine : 1u; nx = cnt > 0u ? cnt : 1u;
}
DI void xcd_barrier(const XcdBarrier& b, int wave) {
    asm volatile("s_waitcnt vmcnt(0)" ::: "memory");
    __syncthreads();
    if (wave == 0 && lane_id() == 0) {
        unsigned* bar = b.bar;
        __builtin_amdgcn_s_waitcnt(0);
        unsigned nloc = b.st[0], nx = b.st[1];
        if (nloc == 0u) { xcd_barrier_complete(bar, b.x, nloc, nx); b.st[0] = nloc; b.st[1] = nx; }
        const unsigned old = xb_add(&bar[XB_XSUB(b.x)], 1u);
        const unsigned gen = old / nloc;
        if (old + 1u == (gen + 1u) * nloc) {
            __builtin_amdgcn_fence(__ATOMIC_RELEASE, "agent");
            asm volatile("s_waitcnt vmcnt(0)" ::: "memory");
            const unsigned og = xb_add(&bar[XB_TOP], 1u);
            const unsigned tg = og / nx;
            if (og + 1u == (tg + 1u) * nx) xb_add(&bar[XB_TOPGEN], 1u);
            else XB_SPIN(xb_ld(&bar[XB_TOPGEN]) == tg, bar);
            __builtin_amdgcn_fence(__ATOMIC_ACQUIRE, "agent");
            xb_add(&bar[XB_XGEN(b.x)], 1u);
            asm volatile("s_waitcnt vmcnt(0)" ::: "memory");
        } else {
            XB_SPIN(xb_ld(&bar[XB_XGEN(b.x)]) == gen, bar);
            __builtin_amdgcn_fence(__ATOMIC_ACQUIRE, "agent");
            asm volatile("s_waitcnt vmcnt(0)" ::: "memory");
        }
    }
    __syncthreads();
}

namespace pg8 {
constexpr int BM = 256, BK = 64, HALF = 128, HTB = HALF * BK * 2, STAGE_BYTES = 8 * HTB, NXCD = 8, WGM = 8;
DI int lds_byte(int r, int c) { const int st = (r >> 4) * 2 + (c >> 5), rr = r & 15, cc = c & 31, ob = rr * 64 + cc * 2; return st * 1024 + (ob ^ (((ob >> 9) & 1) << 5)); }
DI void stage_rc(int b, int& R, int& C) { const int st = b / 1024, sb = b % 1024, swz = sb ^ (((sb >> 9) & 1) << 5); R = (st >> 1) * 16 + swz / 64; C = (st & 1) * 32 + (swz % 64) / 2; }
DI int perm32(int rho) { const int n = rho >> 4, i = rho & 15; return 8 * (i >> 2) + 4 * n + (i & 3); }
struct Unit { int pm, pn; };
struct Gemm { const h16* A; const h16* Bt; int M, N, K, lda, ldb; };
struct StaticOrder {
    int nM, nN, nwg, G, c;
    DI void init(int M, int N, int G_, int c_) { nM = M / BM; nN = N / BM; nwg = nM * nN; G = G_; c = c_; }
    DI bool next(int i, Unit& u) const {
        const long L = (long)i * G + c; if (L >= nwg) return false;
        int wgid = (int)L; { const int q = nwg / NXCD, r = nwg % NXCD, xcd = wgid % NXCD, off = wgid / NXCD; wgid = (xcd < r ? xcd * (q + 1) : r * (q + 1) + (xcd - r) * q) + off; }
        const int nig = WGM * nN, gid = wgid / nig, fm = gid * WGM, gsz = (nM - fm) < WGM ? (nM - fm) : WGM;
        u.pm = fm + ((wgid % nig) % gsz); u.pn = (wgid % nig) / gsz; return true;
    }
};
struct EpiF32 {
    static constexpr bool PERM = false; typedef f32x4 acc_t;
    float* C; int ldc;
    DI void operator()(const f32x4 (&acc)[2][2][4][2], const Unit& u, int wr, int wc, int fr, int fq) const {
        const int row0 = u.pm * BM + wr * 64 + fr, col0 = u.pn * BM + wc * 32 + 4 * fq;
#pragma unroll
        for (int ai = 0; ai < 2; ++ai)
#pragma unroll
            for (int m = 0; m < 4; ++m) { float* rowp = C + (size_t)(row0 + ai * HALF + m * 16) * ldc + col0;
#pragma unroll
                for (int bj = 0; bj < 2; ++bj)
#pragma unroll
                    for (int n = 0; n < 2; ++n) *(f32x4*)(rowp + bj * HALF + n * 16) = acc[ai][bj][m][n]; }
    }
};
struct EpiH16 {
    static constexpr bool PERM = true; typedef f32x4 acc_t;
    h16* O0; int ld0; int nsplit; h16* O1; int ld1;
    DI void operator()(const f32x4 (&acc)[2][2][4][2], const Unit& u, int wr, int wc, int fr, int fq) const {
        const int row0 = u.pm * BM + wr * 64 + fr;
        h16* base; int ld, colt;
        if (u.pn < nsplit) { base = O0; ld = ld0; colt = u.pn * BM; } else { base = O1; ld = ld1; colt = (u.pn - nsplit) * BM; }
        const int col0 = colt + wc * 32 + 8 * fq;
#pragma unroll
        for (int ai = 0; ai < 2; ++ai)
#pragma unroll
            for (int m = 0; m < 4; ++m) { h16* rowp = base + (size_t)(row0 + ai * HALF + m * 16) * ld + col0;
#pragma unroll
                for (int bj = 0; bj < 2; ++bj) { const f32x4 v0 = acc[ai][bj][m][0], v1 = acc[ai][bj][m][1];
                    u32x4 w; w.x = pkh(v0[0], v0[1]); w.y = pkh(v0[2], v0[3]); w.z = pkh(v1[0], v1[1]); w.w = pkh(v1[2], v1[3]);
                    *(u32x4*)(rowp + bj * HALF) = w; } }
    }
};
struct EpiH16I8 {
    static constexpr bool PERM = true; typedef i32x4 acc_t;
    h16* O0; int ld0; int nsplit; h16* O1; int ld1; const float* rs; float wsc;
    DI void operator()(const i32x4 (&acc)[2][2][4][2], const Unit& u, int wr, int wc, int fr, int fq) const {
        const int row0 = u.pm * BM + wr * 64 + fr;
        h16* base; int ld, colt;
        if (u.pn < nsplit) { base = O0; ld = ld0; colt = u.pn * BM; } else { base = O1; ld = ld1; colt = (u.pn - nsplit) * BM; }
        const int col0 = colt + wc * 32 + 8 * fq;
#pragma unroll
        for (int ai = 0; ai < 2; ++ai)
#pragma unroll
            for (int m = 0; m < 4; ++m) { const int row = row0 + ai * HALF + m * 16; h16* rowp = base + (size_t)row * ld + col0; const float sc = rs[row] * wsc;
#pragma unroll
                for (int bj = 0; bj < 2; ++bj) { const i32x4 v0 = acc[ai][bj][m][0], v1 = acc[ai][bj][m][1];
                    u32x4 w; w.x = pkh((float)v0[0] * sc, (float)v0[1] * sc); w.y = pkh((float)v0[2] * sc, (float)v0[3] * sc); w.z = pkh((float)v1[0] * sc, (float)v1[1] * sc); w.w = pkh((float)v1[2] * sc, (float)v1[3] * sc);
                    *(u32x4*)(rowp + bj * HALF) = w; } }
    }
};
struct EpiQ {
    static constexpr bool PERM = true; typedef f32x4 acc_t;
    h16* O;
    DI void operator()(const f32x4 (&acc)[2][2][4][2], const Unit& u, int wr, int wc, int fr, int fq) const {
        const int row0 = u.pm * BM + wr * 64 + fr, col0 = u.pn * BM + wc * 32 + 8 * fq; const bool bf = u.pn < 4;
#pragma unroll
        for (int ai = 0; ai < 2; ++ai)
#pragma unroll
            for (int m = 0; m < 4; ++m) { h16* rowp = O + (size_t)(row0 + ai * HALF + m * 16) * NQ + col0;
#pragma unroll
                for (int bj = 0; bj < 2; ++bj) { const f32x4 v0 = acc[ai][bj][m][0], v1 = acc[ai][bj][m][1]; u32x4 w;
                    if (bf) { w.x = pkb(v0[0], v0[1]); w.y = pkb(v0[2], v0[3]); w.z = pkb(v1[0], v1[1]); w.w = pkb(v1[2], v1[3]); }
                    else { w.x = pkh(v0[0], v0[1]); w.y = pkh(v0[2], v0[3]); w.z = pkh(v1[0], v1[1]); w.w = pkh(v1[2], v1[3]); }
                    *(u32x4*)(rowp + bj * HALF) = w; } }
    }
};
struct EpiLora {
    static constexpr bool PERM = true; typedef f32x4 acc_t;
    h16* O; const float* w0; const float* a0; const float* v0; int has_v; int pn_off;
    DI void operator()(const f32x4 (&acc)[2][2][4][2], const Unit& u, int wr, int wc, int fr, int fq) const {
        const int pnt = u.pn + pn_off; const int row0 = u.pm * BM + wr * 64 + fr; const int type = pnt >> 1;
        const int col0 = pnt * BM + wc * 32 + 8 * fq, j0 = (pnt & 1) * BM + wc * 32 + 8 * fq;
        float bias[2][8];
#pragma unroll
        for (int bj = 0; bj < 2; ++bj)
#pragma unroll
            for (int e = 0; e < 8; ++e) { const int j = j0 + bj * HALF + e; bias[bj][e] = type == 0 ? w0[j] : type == 1 ? a0[j] : (type == 3 && has_v) ? v0[j] : 0.f; }
        if (type == 0) body<0>(acc, bias, row0, col0); else if (type == 2) body<2>(acc, bias, row0, col0); else body<1>(acc, bias, row0, col0);
    }
    template <int TYPE> DI void body(const f32x4 (&acc)[2][2][4][2], const float (&bias)[2][8], const int row0, const int col0) const {
#pragma unroll
        for (int ai = 0; ai < 2; ++ai)
#pragma unroll
            for (int m = 0; m < 4; ++m) { h16* rowp = O + (size_t)(row0 + ai * HALF + m * 16) * NLORA + col0;
#pragma unroll
                for (int bj = 0; bj < 2; ++bj) { float v[8];
#pragma unroll
                    for (int e = 0; e < 8; ++e) { const float z = acc[ai][bj][m][e >> 2][e & 3] + bias[bj][e];
                        float o;
                        if (TYPE == 0) { const float ee = 0.6065306597126334f * sigmoidf_(z); o = 1.0f - __expf(-ee); }
                        else if (TYPE == 2) o = z;
                        else o = sigmoidf_(z);
                        v[e] = o; }
                    u32x4 w; w.x = pkh(v[0], v[1]); w.y = pkh(v[2], v[3]); w.z = pkh(v[4], v[5]); w.w = pkh(v[6], v[7]);
                    *(u32x4*)(rowp + bj * HALF) = w; asm volatile("" ::: "memory"); } }
    }
};
struct EpiSwiglu {
    static constexpr bool PERM = true; typedef f32x4 acc_t;
    h16* O;
    DI void operator()(const f32x4 (&acc)[2][2][4][2], const Unit& u, int wr, int wc, int fr, int fq) const {
        const int row0 = u.pm * BM + wr * 64 + fr, col0 = u.pn * HALF + wc * 32 + 8 * fq;
#pragma unroll
        for (int ai = 0; ai < 2; ++ai)
#pragma unroll
            for (int m = 0; m < 4; ++m) { h16* rowp = O + (size_t)(row0 + ai * HALF + m * 16) * DFF + col0; float v[8];
#pragma unroll
                for (int e = 0; e < 8; ++e) { const float g = acc[ai][0][m][e >> 2][e & 3], up = acc[ai][1][m][e >> 2][e & 3]; v[e] = g * sigmoidf_(g) * up; }
                u32x4 w; w.x = pkh(v[0], v[1]); w.y = pkh(v[2], v[3]); w.z = pkh(v[4], v[5]); w.w = pkh(v[6], v[7]);
                *(u32x4*)rowp = w; }
    }
};
struct EpiSwigluI8 {
    static constexpr bool PERM = true; typedef i32x4 acc_t;
    h16* O; const float* rs; float wsc;
    DI void operator()(const i32x4 (&acc)[2][2][4][2], const Unit& u, int wr, int wc, int fr, int fq) const {
        const int row0 = u.pm * BM + wr * 64 + fr, col0 = u.pn * HALF + wc * 32 + 8 * fq;
#pragma unroll
        for (int ai = 0; ai < 2; ++ai)
#pragma unroll
            for (int m = 0; m < 4; ++m) { const int row = row0 + ai * HALF + m * 16; h16* rowp = O + (size_t)row * DFF + col0; float v[8];
                const float sc = rs[row] * wsc;
#pragma unroll
                for (int e = 0; e < 8; ++e) { const float g = (float)acc[ai][0][m][e >> 2][e & 3] * sc, up = (float)acc[ai][1][m][e >> 2][e & 3] * sc; v[e] = g * sigmoidf_(g) * up; }
                u32x4 w; w.x = pkh(v[0], v[1]); w.y = pkh(v[2], v[3]); w.z = pkh(v[4], v[5]); w.w = pkh(v[6], v[7]);
                *(u32x4*)rowp = w; }
    }
};
DI f32x4 mma_(const h16x8 b, const h16x8 a, const f32x4 c) { return __builtin_amdgcn_mfma_f32_16x16x32_f16(b, a, c, 0, 0, 0); }
DI i32x4 mma_(const h16x8 b, const h16x8 a, const i32x4 c) { return __builtin_amdgcn_mfma_i32_16x16x64_i8(__builtin_bit_cast(i32x4, b), __builtin_bit_cast(i32x4, a), c, 0, 0, 0); }

template <class Epi>
DI void gemm_phase(LAS unsigned char* lds, const Gemm g, const StaticOrder& S, const Epi& E, const int wid) {
    const int lane = lane_id(), tid = wid * 64 + lane, wr = wid >> 2, wc = wid & 3, fr = lane & 15, fq = lane >> 4;
    const int K = g.K, nt = K / BK;
    unsigned voffA[2], voffB[2];
#pragma unroll
    for (int i = 0; i < 2; ++i) { int R, C; stage_rc(tid * 16 + i * 8192, R, C); const int Rb = Epi::PERM ? ((R & ~31) + perm32(R & 31)) : R;
        voffA[i] = (unsigned)(R * g.lda + C) * 2u; voffB[i] = (unsigned)(Rb * g.ldb + C) * 2u; }
    const size_t kstep = (size_t)(BK * 2);
    const size_t hstepA = (size_t)HALF * g.lda * 2, hstepB = (size_t)HALF * g.ldb * 2;
    const size_t tstepA = 2 * hstepA, tstepB = 2 * hstepB;
    const unsigned ldsw = (unsigned)wid * 1024u;
    const int aoff = lds_byte(wr * 64 + fr, fq * 8), boff = lds_byte(wc * 32 + fr, fq * 8);
#define PG8_SA(b, h) (((b) * 2 + (h)) * HTB)
#define PG8_SB(b, h) ((4 + (b) * 2 + (h)) * HTB)
#define PG8_STAGE(bufoff, gbase, voff) do { _Pragma("unroll") for (int _i = 0; _i < 2; ++_i) \
        __builtin_amdgcn_global_load_lds((const unsigned*)((const char*)(gbase) + (voff)[_i]), (LAS unsigned*)(lds + (bufoff) + ldsw + _i * 8192), 16, 0, 0); } while (0)
#define PG8_LDA(dst, b, h) do { _Pragma("unroll") for (int m = 0; m < 4; ++m) _Pragma("unroll") for (int k = 0; k < 2; ++k) dst[m][k] = *(const LAS h16x8*)(lds + PG8_SA(b, h) + aoff + m * 2048 + k * 1024); } while (0)
#define PG8_LDB(dst, b, h) do { _Pragma("unroll") for (int n = 0; n < 2; ++n) _Pragma("unroll") for (int k = 0; k < 2; ++k) dst[n][k] = *(const LAS h16x8*)(lds + PG8_SB(b, h) + boff + n * 2048 + k * 1024); } while (0)
#define PG8_MMA(ai, bj, At, Bt) do { __builtin_amdgcn_s_setprio(1); _Pragma("unroll") for (int m = 0; m < 4; ++m) _Pragma("unroll") for (int n = 0; n < 2; ++n) _Pragma("unroll") for (int k = 0; k < 2; ++k) \
        acc[ai][bj][m][n] = mma_(Bt[n][k], At[m][k], acc[ai][bj][m][n]); __builtin_amdgcn_s_setprio(0); } while (0)
#define PG8_WAIT_V(n) asm volatile("s_waitcnt vmcnt(" #n ")" ::: "memory")
#define PG8_WAIT_L(n) asm volatile("s_waitcnt lgkmcnt(" #n ")" ::: "memory")
#define PG8_BAR __builtin_amdgcn_s_barrier()
#define PG8_SCHED __builtin_amdgcn_sched_barrier(0)
    Unit cur, nxt; int ui = 0;
    if (!S.next(0, cur)) return;
    typedef typename Epi::acc_t acc_t;
    acc_t acc[2][2][4][2];
#pragma unroll
    for (int a = 0; a < 2; ++a)
#pragma unroll
        for (int b = 0; b < 2; ++b)
#pragma unroll
            for (int m = 0; m < 4; ++m)
#pragma unroll
                for (int n = 0; n < 2; ++n) acc[a][b][m][n] = acc_t{};
    h16x8 At[4][2], B0[2][2], B1[2][2];
    const char* cA = (const char*)g.A + (size_t)cur.pm * tstepA; const char* cB = (const char*)g.Bt + (size_t)cur.pn * tstepB;
    PG8_STAGE(PG8_SB(0, 0), cB, voffB); PG8_STAGE(PG8_SB(0, 1), cB + hstepB, voffB); PG8_STAGE(PG8_SA(0, 0), cA, voffA); PG8_STAGE(PG8_SA(0, 1), cA + hstepA, voffA);
    if (wr == 1) PG8_BAR;
    PG8_WAIT_V(2); PG8_BAR;
    PG8_STAGE(PG8_SB(1, 0), cB + kstep, voffB); PG8_STAGE(PG8_SA(1, 0), cA + kstep, voffA); PG8_STAGE(PG8_SB(1, 1), cB + hstepB + kstep, voffB);
    PG8_WAIT_V(6); PG8_BAR;
    for (;;) {
        const bool has_next = S.next(ui + 1, nxt);
        const char* nA = has_next ? (const char*)g.A + (size_t)nxt.pm * tstepA : cA; const char* nB = has_next ? (const char*)g.Bt + (size_t)nxt.pn * tstepB : cB;
        for (int t = 0; t < nt; t += 2) {
            const bool last = (t == nt - 2);
            const char* a1 = cA + (size_t)(t + 1) * kstep;
            const char* a2 = last ? nA : cA + (size_t)(t + 2) * kstep; const char* b2 = last ? nB : cB + (size_t)(t + 2) * kstep;
            const char* a3 = a2 + kstep; const char* b3 = b2 + kstep;
            PG8_LDB(B0, 0, 0); PG8_LDB(B1, 0, 1); PG8_SCHED; PG8_LDA(At, 0, 0); PG8_STAGE(PG8_SA(1, 1), a1 + hstepA, voffA);
            PG8_WAIT_V(8); PG8_WAIT_L(0); PG8_BAR; PG8_MMA(0, 0, At, B0); PG8_MMA(0, 1, At, B1); PG8_BAR; PG8_SCHED;
            PG8_LDA(At, 0, 1); PG8_STAGE(PG8_SB(0, 0), b2, voffB); PG8_STAGE(PG8_SB(0, 1), b2 + hstepB, voffB); PG8_STAGE(PG8_SA(0, 0), a2, voffA);
            PG8_WAIT_V(8); PG8_WAIT_L(0); PG8_BAR; PG8_MMA(1, 0, At, B0); PG8_MMA(1, 1, At, B1); PG8_BAR; PG8_SCHED;
            PG8_LDB(B0, 1, 0); PG8_LDB(B1, 1, 1); PG8_SCHED; PG8_LDA(At, 1, 0); PG8_STAGE(PG8_SA(0, 1), a2 + hstepA, voffA);
            PG8_WAIT_V(8); PG8_WAIT_L(0); PG8_BAR; PG8_MMA(0, 0, At, B0); PG8_MMA(0, 1, At, B1); PG8_BAR; PG8_SCHED;
            PG8_LDA(At, 1, 1); PG8_STAGE(PG8_SB(1, 0), b3, voffB); PG8_STAGE(PG8_SB(1, 1), b3 + hstepB, voffB); PG8_STAGE(PG8_SA(1, 0), a3, voffA);
            PG8_WAIT_V(8); PG8_WAIT_L(0); PG8_BAR; PG8_MMA(1, 0, At, B0); PG8_MMA(1, 1, At, B1); PG8_BAR; PG8_SCHED;
        }
        if (wr == 0) PG8_BAR;
        { const int l2 = lane_id(); E(acc, cur, wr, wc, l2 & 15, l2 >> 4); }
        if (!has_next) break;
#pragma unroll
        for (int a = 0; a < 2; ++a)
#pragma unroll
            for (int b = 0; b < 2; ++b)
#pragma unroll
                for (int m = 0; m < 4; ++m)
#pragma unroll
                    for (int n = 0; n < 2; ++n) acc[a][b][m][n] = acc_t{};
        cur = nxt; cA = nA; cB = nB; ++ui;
        if (wr == 1) PG8_BAR;
    }
    PG8_WAIT_V(0);
    PG8_BAR;
#undef PG8_SA
#undef PG8_SB
#undef PG8_STAGE
#undef PG8_LDA
#undef PG8_LDB
#undef PG8_MMA
#undef PG8_WAIT_V
#undef PG8_WAIT_L
#undef PG8_BAR
#undef PG8_SCHED
}
}

struct Params {
    const float* in[35];
    float* out;
    unsigned char* ws;
    int step_lo, step_hi;
};
enum { I_X = 0, I_C, I_ADAW, I_ADAB, I_PREMIX, I_POSTMIX, I_PREFFN, I_POSTFFN, I_WIN, I_WINV, I_MU, I_MUV, I_WOUT, I_QNG, I_KVNG, I_WQUP, I_WQIUP, I_WKUP, I_WVUP,
       I_KLNG, I_KLNB, I_W0, I_W2, I_A0, I_A2, I_G2, I_V0, I_V2, I_KK, I_KA, I_RK, I_LNXG, I_LNXB, I_WFC, I_WDOWN };

template <int OFF> DI unsigned long long ka_load64() {
    unsigned long long v;
    asm volatile("s_load_dwordx2 %0, %1, %2\n\ts_waitcnt lgkmcnt(0)" : "=s"(v) : "s"(__builtin_amdgcn_kernarg_segment_ptr()), "n"(OFF));
    return v;
}
#define GAS __attribute__((address_space(1)))
template <int I> DI const float* kin() { return (const float*)(const GAS float*)ka_load64<8 * I>(); }
DI float* kout() { return (float*)(GAS float*)ka_load64<8 * 35>(); }
DI unsigned char* kws() { return (unsigned char*)(GAS unsigned char*)ka_load64<8 * 36>(); }

struct Ctx {
    LAS unsigned char* lds;
    int wave, gw, ngw, G;
};

DI void phase_mod(const Params& p, const Ctx& c) {
    const int lane = lane_id(), tid = c.wave * 64 + lane; (void)tid;
    unsigned char* const ws = kws();
    LAS float* cond = (LAS float*)c.lds;
    LAS float* red = (LAS float*)(c.lds + 65536);
    const float* cin = kin<I_C>();
    for (int i = tid; i < 16384; i += NTHR) { const int b = i & 15, k = i >> 4; const float cv = cin[b * 1024 + k]; cond[k * 16 + b] = cv * sigmoidf_(cv); }
    __syncthreads();
    float* MOD = (float*)(ws + WS_MOD);
    for (int item = blockIdx.x; item < 384; item += c.G) {
        const int l = item / 96, n0 = (item % 96) * 64;
        const float* W = kin<I_ADAW>() + (size_t)l * 1024 * 6144 + n0 + lane;
        float acc[16];
#pragma unroll
        for (int b = 0; b < 16; ++b) acc[b] = 0.f;
        const int k0 = c.wave * 128;
#pragma unroll 8
        for (int k = k0; k < k0 + 128; ++k) {
            const float wv = W[(size_t)k * 6144];
            const LAS f32x4* cb = (const LAS f32x4*)(cond + k * 16);
            const f32x4 c0 = cb[0], c1 = cb[1], c2 = cb[2], c3 = cb[3];
            acc[0] += c0[0] * wv; acc[1] += c0[1] * wv; acc[2] += c0[2] * wv; acc[3] += c0[3] * wv;
            acc[4] += c1[0] * wv; acc[5] += c1[1] * wv; acc[6] += c1[2] * wv; acc[7] += c1[3] * wv;
            acc[8] += c2[0] * wv; acc[9] += c2[1] * wv; acc[10] += c2[2] * wv; acc[11] += c2[3] * wv;
            acc[12] += c3[0] * wv; acc[13] += c3[1] * wv; acc[14] += c3[2] * wv; acc[15] += c3[3] * wv;
        }
#pragma unroll
        for (int b = 0; b < 16; ++b) red[(c.wave * 16 + b) * 64 + lane] = acc[b];
        __syncthreads();
        for (int idx = tid; idx < 1024; idx += NTHR) { const int b = idx >> 6, n = idx & 63; float s = kin<I_ADAB>()[l * 6144 + n0 + n];
#pragma unroll
            for (int w = 0; w < 8; ++w) s += red[(w * 16 + b) * 64 + n];
            MOD[(size_t)(l * 16 + b) * 6144 + n0 + n] = s; }
        __syncthreads();
    }
}

DI void tr_load(const float* src, int ldsrc, float (&tv)[32], int lane) {
#pragma unroll
    for (int i = 0; i < 32; ++i) { const int kk = 2 * i + (lane >> 5); tv[i] = src[(size_t)kk * ldsrc + (lane & 31)]; }
}
DI void tr_out16(const float (&tv)[32], h16* dst, int ldd, LAS float* scr, int lane) {
#pragma unroll
    for (int i = 0; i < 32; ++i) { const int kk = 2 * i + (lane >> 5); scr[kk * 33 + (lane & 31)] = tv[i]; }
    asm volatile("s_waitcnt lgkmcnt(0)" ::: "memory");
    const int cc = lane & 7;
#pragma unroll
    for (int j = 0; j < 4; ++j) { const int n = (lane >> 3) + 8 * j; const LAS float* s = scr + (8 * cc) * 33 + n;
        u32x4 o; o.x = pkh(s[0 * 33], s[1 * 33]); o.y = pkh(s[2 * 33], s[3 * 33]); o.z = pkh(s[4 * 33], s[5 * 33]); o.w = pkh(s[6 * 33], s[7 * 33]);
        *(u32x4*)(dst + (size_t)n * ldd + 8 * cc) = o; }
    asm volatile("s_waitcnt lgkmcnt(0)" ::: "memory");
}
DI void tr_out8(const float (&tv)[32], unsigned char* dst, int ldd, LAS float* scr, int lane, const float qs) {
#pragma unroll
    for (int i = 0; i < 32; ++i) { const int kk = 2 * i + (lane >> 5); scr[kk * 33 + (lane & 31)] = tv[i]; }
    asm volatile("s_waitcnt lgkmcnt(0)" ::: "memory");
    const int n = lane >> 1, kh = lane & 1; const LAS float* sp = scr + (32 * kh) * 33 + n;
#pragma unroll
    for (int g = 0; g < 2; ++g) { unsigned o[4];
#pragma unroll
        for (int w4 = 0; w4 < 4; ++w4) { unsigned bq[4];
#pragma unroll
            for (int e = 0; e < 4; ++e) bq[e] = __builtin_bit_cast(unsigned, fminf(fmaxf(sp[(16 * g + 4 * w4 + e) * 33] * qs, -127.0f), 127.0f) + 12582912.0f);
            o[w4] = __builtin_amdgcn_perm(bq[1], bq[0], 0x0c0c0400u) | __builtin_amdgcn_perm(bq[3], bq[2], 0x04000c0cu); }
        u32x4 ov; ov.x = o[0]; ov.y = o[1]; ov.z = o[2]; ov.w = o[3];
        *(u32x4*)(dst + (size_t)n * ldd + 32 * kh + 16 * g) = ov; }
    asm volatile("s_waitcnt lgkmcnt(0)" ::: "memory");
}
DI unsigned* wmax_word(unsigned char* ws, int l, int which) { return (unsigned*)(ws + WS_CTL) + 8192 + 64 * l + 32 + which; }
DI float absmax4(float am, const f32x4 v) { return fmaxf(fmaxf(am, fmaxf(__builtin_fabsf(v[0]), __builtin_fabsf(v[1]))), fmaxf(__builtin_fabsf(v[2]), __builtin_fabsf(v[3]))); }
DI void phase_wmax(const Params& p, const Ctx& c, int l) {
    const int lane = lane_id();
    { const f32x4* w = (const f32x4*)(kin<I_WFC>() + (size_t)l * DM * NFC); float am = 0.f;
#pragma unroll 8
      for (int i = c.gw * 64 + lane; i < DM * NFC / 4; i += c.ngw * 64) am = absmax4(am, w[i]);
      const unsigned mx = max64u(__builtin_bit_cast(unsigned, am));
      if (lane == 0) __hip_atomic_fetch_max(wmax_word(kws(), l, 0), mx, __ATOMIC_RELAXED, __HIP_MEMORY_SCOPE_AGENT); }
    { const f32x4* w = (const f32x4*)(kin<I_WIN>() + (size_t)l * DM * PIN); float am = 0.f;
#pragma unroll 8
      for (int i = c.gw * 64 + lane; i < DM * PIN / 4; i += c.ngw * 64) am = absmax4(am, w[i]);
      if (l > 0) { const f32x4* wv = (const f32x4*)(kin<I_WINV>() + (size_t)(l - 1) * DM * 32);
          for (int i = c.gw * 64 + lane; i < DM * 32 / 4; i += c.ngw * 64) am = absmax4(am, wv[i]); }
      const unsigned mx = max64u(__builtin_bit_cast(unsigned, am));
      if (lane == 0) __hip_atomic_fetch_max(wmax_word(kws(), l, 1), mx, __ATOMIC_RELAXED, __HIP_MEMORY_SCOPE_AGENT); }
}
DI float wmax_load(unsigned char* ws, int l, int which) { return fmaxf(__builtin_bit_cast(float, __hip_atomic_load(wmax_word(ws, l, which), __ATOMIC_RELAXED, __HIP_MEMORY_SCOPE_AGENT)), 1e-30f); }
DI void phase_wconv(const Params& p, const Ctx& c, int l, const int it_lo, const int it_hi, const bool do_elem) {
    const int lane = lane_id(), tid = c.wave * 64 + lane; (void)tid;
    unsigned char* const ws = kws();
    LAS float* scr = (LAS float*)(c.lds + c.wave * 16384);
    unsigned char* const wb = ws + wofs(l);
    h16* Win = (h16*)(wb + WT_IN); h16* Wq = (h16*)(wb + WT_Q); h16* Wlo = (h16*)(wb + WT_LORA); h16* Wout = (h16*)(wb + WT_OUT); h16* Wfc = (h16*)(wb + WT_FC); h16* Wdn = (h16*)(wb + WT_DOWN);
    const float* w_in = kin<I_WIN>() + (size_t)l * DM * PIN;
    const float* w_vr = kin<I_WINV>() + (size_t)(l > 0 ? l - 1 : 0) * DM * 32;
    const float* w_fc = kin<I_WFC>() + (size_t)l * DM * NFC;
    const float* w_dn = kin<I_WDOWN>() + (size_t)l * DFF * DM;
    const float* w_out = kin<I_WOUT>() + (size_t)l * 1024 * DM;
    constexpr int IT_IN = 16 * (NIN / 32), IT_FC = 16 * (NFC / 32), IT_DN = (DFF / 64) * (DM / 32), IT_O2 = 16 * (DM / 32);
    float qs = 0.f, qsi = 0.f;
    if (it_hi > WC_NOQ) { qs = 127.0f * __builtin_amdgcn_rcpf(wmax_load(ws, l, 0)); qsi = 127.0f * __builtin_amdgcn_rcpf(wmax_load(ws, l, 1)); }
    struct Item { const float* src; int ld; unsigned char* dst; int ldd; float q; bool i8; };
    auto decode = [&](int r, Item& I) {
        if (r < IT_DN) { const int nb = r % (DM / 32), kb = r / (DM / 32), nd = nb * 32, k0 = kb * 64;
            I.src = w_dn + (size_t)k0 * DM + nd; I.ld = DM; I.dst = (unsigned char*)(Wdn + (size_t)nd * DFF + k0); I.ldd = DFF; I.i8 = false; I.q = 0.f; }
        else if ((r -= IT_DN) < IT_O2) { const int nb = r % (DM / 32), kb = r / (DM / 32), nd = nb * 32, k0 = kb * 64;
            I.src = w_out + (size_t)k0 * DM + nd; I.ld = DM; I.dst = (unsigned char*)(Wout + (size_t)nd * KOUT + k0); I.ldd = KOUT; I.i8 = false; I.q = 0.f; }
        else if ((r -= IT_O2) < IT_IN) { const int nb = r % (NIN / 32), kb = r / (NIN / 32), nd = nb * 32, k0 = kb * 64;
            int sc; const float* sp = w_in; int ld = PIN; bool zero = false;
            if (nd < 448) sc = nd;
            else if (nd < 736) sc = 1988 + (nd - 448);
            else if (nd < 768) { if (l > 0) { sp = w_vr; ld = 32; sc = 0; } else { zero = true; sc = 0; } }
            else sc = 452 + (nd - 768);
            I.src = sp + (size_t)k0 * ld + sc; I.ld = ld; I.ldd = DM;
            if (nd < NIN16) { I.dst = (unsigned char*)(Win + (size_t)nd * DM + k0); I.i8 = false; I.q = 0.f; }
            else { I.dst = (unsigned char*)(Win + (size_t)NIN16 * DM) + (size_t)(nd - NIN16) * DM + k0; I.i8 = true; I.q = zero ? 0.f : qsi; } }
        else { r -= IT_IN; const int nb = r % (NFC / 32), kb = r / (NFC / 32), nd = nb * 32, k0 = kb * 64;
            const int pn = nd >> 8, i = nd & 255; const int sc = (i < 128) ? (128 * pn + i) : (DFF + 128 * pn + (i - 128));
            I.src = w_fc + (size_t)k0 * NFC + sc; I.ld = NFC; I.dst = (unsigned char*)Wfc + (size_t)nd * DM + k0; I.ldd = DM; I.i8 = true; I.q = qs; } };
    auto emit = [&](const Item& I, const float (&tv)[32]) { if (I.i8) tr_out8(tv, I.dst, I.ldd, scr, lane, I.q); else tr_out16(tv, (h16*)I.dst, I.ldd, scr, lane); };
    {
        float ta[32], tb[32]; Item A, B;
        int it = it_lo + c.gw;
        if (it < it_hi) { decode(it, A); tr_load(A.src, A.ld, ta, lane); }
#pragma unroll 1
        while (it < it_hi) {
            const int i1 = it + c.ngw; const bool h1 = i1 < it_hi;
            decode(h1 ? i1 : it, B); tr_load(B.src, B.ld, tb, lane);
            asm volatile("" ::: "memory");
            emit(A, ta);
            if (!h1) break;
            const int i2 = i1 + c.ngw; const bool h2 = i2 < it_hi;
            decode(h2 ? i2 : i1, A); tr_load(A.src, A.ld, ta, lane);
            asm volatile("" ::: "memory");
            emit(B, tb);
            it = i2;
        }
    }
    if (!do_elem) return;
    const int gt = c.gw * 64 + lane, ngt = c.ngw * 64;
    const float* wq = kin<I_WQUP>() + (size_t)l * 256 * 512; const float* wk = kin<I_WKUP>() + (size_t)l * 128 * 512; const float* wqi = kin<I_WQIUP>() + (size_t)l * 256 * 256;
    const float* wv = kin<I_WVUP>() + (size_t)l * 128 * 512;
    const float qscl = 0.125f * 1.4426950408889634f;
    for (int it = c.gw; it < 8 * 8 * 4; it += c.ngw) {
        const int h = it >> 5, rb = (it >> 2) & 7, cb = it & 3, cc = cb * 64 + lane;
        f32x4 qv[16];
#pragma unroll
        for (int d4 = 0; d4 < 16; ++d4) qv[d4] = *(const f32x4*)(wq + cc * 512 + h * 64 + 4 * d4);
#pragma unroll 2
        for (int r = 0; r < 16; ++r) { const float* kr = wk + (rb * 16 + r) * 512 + h * 64; float sacc = 0.f;
#pragma unroll
            for (int d4 = 0; d4 < 16; ++d4) { const f32x4 kv = *(const f32x4*)(kr + 4 * d4); sacc += (qv[d4][0] * kv[0] + qv[d4][1] * kv[1]) + (qv[d4][2] * kv[2] + qv[d4][3] * kv[3]); }
            Wq[(size_t)(h * 128 + rb * 16 + r) * 256 + cc] = (h16)(sacc * qscl); }
    }
    for (int idx = gt; idx < 256 * 256; idx += ngt) { const int n = idx >> 8, cc = idx & 255; Wq[(size_t)(1024 + n) * 256 + cc] = (h16)wqi[cc * 256 + n]; }
    const float* w2 = kin<I_W2>() + (size_t)l * 64 * 512; const float* a2 = kin<I_A2>() + (size_t)l * 64 * 512; const float* g2 = kin<I_G2>() + (size_t)l * 160 * 512;
    const float* v2 = kin<I_V2>() + (size_t)(l > 0 ? l - 1 : 0) * 32 * 512;
    for (int idx = gt; idx < 1024 * 128; idx += ngt) {
        const int n = idx >> 7, k = idx & 127, j = n & 511; float o = 0.f;
        if (n < 512) { if (k < 64) o = w2[k * 512 + j]; } else { if (k >= 64) o = a2[(k - 64) * 512 + j]; }
        Wlo[idx] = (h16)o; }
    for (int idx = gt; idx < 1024 * 256; idx += ngt) {
        const int n = idx >> 8, k = idx & 255, j = n & 511; float o = 0.f;
        if (n < 512) { if (k < 160) o = g2[k * 512 + j]; } else { if (l > 0 && k >= 160 && k < 192) o = v2[(k - 160) * 512 + j]; }
        Wlo[1024 * 128 + idx] = (h16)o; }
    { h16* WVt = (h16*)(wb + WT_VUP);
      for (int idx = gt; idx < 8 * 64 * 128; idx += ngt) { const int k = idx & 127, n = (idx >> 7) & 63, h = idx >> 13; WVt[idx] = (h16)wv[k * 512 + h * 64 + n]; } }
}

template <int MODE, bool HAS_NEXT, bool WIDX_, int Q8 = 0>
DI void phase_rows(const Params& p, const Ctx& c, const h16* Y, const float* postg, int gate_off, int mod_l_gate,
                   const float* preg, int sh_off, int sc_off, int mod_l_next, int widx_l) {
    const int lane = lane_id(), tid = c.wave * 64 + lane; (void)tid;
    unsigned char* const ws = kws();
    h16* X = (h16*)(ws + WS_X16); float* OUT = kout(); h16* H = (h16*)(ws + WS_H); const float* MOD = (const float*)(ws + WS_MOD); float* WIDX = (float*)(ws + WS_WIDX);
    for (int rg = c.gw; rg < MT / 16; rg += c.ngw) {
        const int m0 = rg * 16, b = m0 / SEQ;
        f32x4 gp[4], ps[4], shv[4], wi[4][4];
#pragma unroll
        for (int j = 0; j < 4; ++j) { const int col = 4 * lane + 256 * j;
            if (MODE == 1) gp[j] = *(const f32x4*)(MOD + (size_t)(mod_l_gate * 16 + b) * 6144 + gate_off + col) * *(const f32x4*)(postg + col);
            if (HAS_NEXT) { shv[j] = *(const f32x4*)(MOD + (size_t)(mod_l_next * 16 + b) * 6144 + sh_off + col);
                ps[j] = *(const f32x4*)(preg + col) * (*(const f32x4*)(MOD + (size_t)(mod_l_next * 16 + b) * 6144 + sc_off + col) + 1.0f); }
            if (WIDX_) {
#pragma unroll
                for (int e = 0; e < 4; ++e) wi[j][e] = *(const f32x4*)(kin<I_WIN>() + ((size_t)widx_l * DM + col + e) * PIN + 448); }
        }
        for (int rr = 0; rr < 16; ++rr) {
            const size_t m = (size_t)(m0 + rr);
            f32x4 xv[4];
            if (MODE == 0) {
#pragma unroll
                for (int j = 0; j < 4; ++j) xv[j] = *(const f32x4*)(kin<I_X>() + m * DM + 4 * lane + 256 * j);
            } else {
                f32x4 yv[4]; float ss = 0.f;
#pragma unroll
                for (int j = 0; j < 4; ++j) { const u32x2 yr = *(const u32x2*)(Y + m * DM + 4 * lane + 256 * j); yv[j] = (f32x4){hlo(yr.x), hhi(yr.x), hlo(yr.y), hhi(yr.y)}; const u32x2 xr = *(const u32x2*)(X + m * DM + 4 * lane + 256 * j); xv[j] = (f32x4){hlo(xr.x), hhi(xr.x), hlo(xr.y), hhi(xr.y)};
                    ss += (yv[j][0] * yv[j][0] + yv[j][1] * yv[j][1]) + (yv[j][2] * yv[j][2] + yv[j][3] * yv[j][3]); }
                const float rn = rsqrtf(sum64(ss) * (1.0f / DM) + NORM_EPS);
#pragma unroll
                for (int j = 0; j < 4; ++j) xv[j] = xv[j] + (yv[j] * rn) * gp[j];
            }
            if (HAS_NEXT) {
#pragma unroll
                for (int j = 0; j < 4; ++j) { u32x2 w; w.x = pkh(xv[j][0], xv[j][1]); w.y = pkh(xv[j][2], xv[j][3]); *(u32x2*)(X + m * DM + 4 * lane + 256 * j) = w; }
            } else {
#pragma unroll
                for (int j = 0; j < 4; ++j) *(f32x4*)(OUT + m * DM + 4 * lane + 256 * j) = xv[j];
            }
            if (HAS_NEXT) {
                float ss = 0.f;
#pragma unroll
                for (int j = 0; j < 4; ++j) ss += (xv[j][0] * xv[j][0] + xv[j][1] * xv[j][1]) + (xv[j][2] * xv[j][2] + xv[j][3] * xv[j][3]);
                const float rn = rsqrtf(sum64(ss) * (1.0f / DM) + NORM_EPS);
                float d0 = 0.f, d1 = 0.f, d2 = 0.f, d3 = 0.f;
                if (Q8 != 0) {
                    float am = 0.f;
#pragma unroll
                    for (int j = 0; j < 4; ++j) { const f32x4 hq = (xv[j] * rn) * ps[j] + shv[j];
                        am = fmaxf(fmaxf(am, fmaxf(__builtin_fabsf(hq[0]), __builtin_fabsf(hq[1]))), fmaxf(__builtin_fabsf(hq[2]), __builtin_fabsf(hq[3]))); }
                    const float amax = fmaxf(__builtin_bit_cast(float, max64u(__builtin_bit_cast(unsigned, am))), 1e-20f);
                    const float qs = 127.0f * __builtin_amdgcn_rcpf(amax);
                    unsigned char* H8 = (Q8 == 2) ? (unsigned char*)(ws + WS_H8IN) : (unsigned char*)H;
#pragma unroll
                    for (int j = 0; j < 4; ++j) {
                        const f32x4 hq = (xv[j] * rn) * ps[j] + shv[j];
                        unsigned bq[4];
#pragma unroll
                        for (int e = 0; e < 4; ++e) bq[e] = __builtin_bit_cast(unsigned, fminf(fmaxf(hq[e] * qs, -127.0f), 127.0f) + 12582912.0f);
                        const unsigned w = __builtin_amdgcn_perm(bq[1], bq[0], 0x0c0c0400u) | __builtin_amdgcn_perm(bq[3], bq[2], 0x04000c0cu);
                        *(unsigned*)(H8 + m * DM + 4 * lane + 256 * j) = w; }
                    if (lane == 0) ((float*)(ws + WS_RS))[m] = amax * (1.0f / 127.0f);
                }
                if (Q8 != 1)
#pragma unroll
                for (int j = 0; j < 4; ++j) { const f32x4 hv = (xv[j] * rn) * ps[j] + shv[j];
                    u32x2 w; w.x = pkh(hv[0], hv[1]); w.y = pkh(hv[2], hv[3]);
                    *(u32x2*)(H + m * DM + 4 * lane + 256 * j) = w;
                    if (WIDX_) {
#pragma unroll
                        for (int e = 0; e < 4; ++e) { d0 += hv[e] * wi[j][e][0]; d1 += hv[e] * wi[j][e][1]; d2 += hv[e] * wi[j][e][2]; d3 += hv[e] * wi[j][e][3]; } } }
                if (WIDX_) { d0 = sum64(d0); d1 = sum64(d1); d2 = sum64(d2); d3 = sum64(d3);
                    if (lane == 0) *(f32x4*)(WIDX + m * 4) = (f32x4){d0 * 0.0625f, d1 * 0.0625f, d2 * 0.0625f, d3 * 0.0625f}; }
            }
        }
    }
}

DI void phase_prep(const Params& p, const Ctx& c, int l) {
    unsigned char* const ws = kws();
    const int lane = lane_id();
    const h16* CA = (const h16*)(ws + WS_COLSA);
    h16* CQ = (h16*)(ws + WS_CQ); h16* CKV = (h16*)(ws + WS_CKV); h16* KIDX = (h16*)(ws + WS_KIDX); h16* AL = (h16*)(ws + WS_ALORA);
    const f32x4 qg = *(const f32x4*)(kin<I_QNG>() + l * 256 + 4 * lane);
    const f32x2 kvg = *(const f32x2*)(kin<I_KVNG>() + l * 128 + 2 * lane);
    const float lg = kin<I_KLNG>()[l * 64 + lane], lb = kin<I_KLNB>()[l * 64 + lane];
    float mu[5];
#pragma unroll
    for (int i = 0; i < 5; ++i) { const int j = lane + 64 * i;
        mu[i] = (j < 288) ? kin<I_MU>()[l * 1824 + 1536 + j] : (l > 0 ? kin<I_MUV>()[(l - 1) * 32 + (j - 288)] : 0.f); }
    for (int rg = c.gw; rg < MT / 16; rg += c.ngw) {
        const int m0 = rg * 16, b = m0 / SEQ, t0 = m0 % SEQ;
        float prevv[5];
#pragma unroll
        for (int i = 0; i < 5; ++i) prevv[i] = (t0 > 0) ? (float)CA[(size_t)(m0 - 1) * NCA + 448 + lane + 64 * i] : 0.f;
#pragma unroll
        for (int rr = 0; rr < 16; ++rr) {
            const size_t m = (size_t)(m0 + rr); const h16* row = CA + m * NCA;
            const u32x2 cqr = *(const u32x2*)(row + 4 * lane);
            const unsigned ckr = *(const unsigned*)(row + 256 + 2 * lane);
            const float kir = (float)row[384 + lane];
            float cur[5];
#pragma unroll
            for (int i = 0; i < 5; ++i) cur[i] = (float)row[448 + lane + 64 * i];
            const float q0 = hlo(cqr.x), q1 = hhi(cqr.x), q2 = hlo(cqr.y), q3 = hhi(cqr.y);
            const float rq = rsqrtf(sum64((q0 * q0 + q1 * q1) + (q2 * q2 + q3 * q3)) * (1.0f / 256.0f) + NORM_EPS);
            u32x2 qo; qo.x = pkh(q0 * rq * qg[0], q1 * rq * qg[1]); qo.y = pkh(q2 * rq * qg[2], q3 * rq * qg[3]);
            *(u32x2*)(CQ + m * 256 + 4 * lane) = qo;
            const float k0 = hlo(ckr), k1 = hhi(ckr);
            const float rk = rsqrtf(sum64(k0 * k0 + k1 * k1) * (1.0f / 128.0f) + NORM_EPS);
            const float o0 = k0 * rk * kvg[0], o1 = k1 * rk * kvg[1];
            *(unsigned*)(CKV + m * 128 + 2 * lane) = pkb(o0, o1);
            const float mean = sum64(kir) * (1.0f / 64.0f); const float dv = kir - mean; const float var = sum64(dv * dv) * (1.0f / 64.0f);
            KIDX[m * 64 + lane] = (h16)(dv * rsqrtf(var + NORM_EPS) * lg + lb);
#pragma unroll
            for (int i = 0; i < 5; ++i) { const float sh = cur[i] + (prevv[i] - cur[i]) * mu[i]; prevv[i] = cur[i]; const int j = lane + 64 * i; float o;
                if (i == 0) o = tanhf_(sh); else if (i == 1) o = sh; else if (j < 288) o = sigmoidf_(sh); else o = (l > 0) ? sh : 0.f;
                AL[m * KLORA + j] = (h16)o; }
            AL[m * KLORA + 320 + lane] = (h16)0.f;
        }
    }
}

constexpr int AT_KSTR = 272, AT_VSTR = 144;
constexpr int AT_KB = 64 * AT_KSTR, AT_VB = 128 * AT_VSTR, AT_BUF = AT_KB + AT_VB;
constexpr int AT_MASK = 131072 + 1024;
DI unsigned okey(float s) { const unsigned u = __builtin_bit_cast(unsigned, s); return (u & 0x80000000u) ? ~u : (u | 0x80000000u); }
DI float ikeyf(unsigned k) { return __builtin_bit_cast(float, (k & 0x80000000u) ? (k & 0x7FFFFFFFu) : ~k); }

template <int NRM>
DI void select_query(const LAS float* SCq, unsigned long long* mkq, const int nr, const int lane) {

                        unsigned key[NRM];
                        float sraw[NRM];
#pragma unroll
                        for (int r = 0; r < NRM; ++r) sraw[r] = SCq[64 * (r < nr ? r : 0) + lane];
#pragma unroll
                        for (int r = 0; r < NRM; ++r) key[r] = okey(sraw[r]) & (unsigned)((r - nr) >> 31);
                        auto count_ge = [&](const unsigned cand) -> unsigned { unsigned cnt = 0u;
#pragma unroll
                            for (int r = 0; r < NRM; r += 4) {
                                const unsigned long long m0 = __ballot(key[r] >= cand), m1 = __ballot(key[r + 1] >= cand), m2 = __ballot(key[r + 2] >= cand), m3 = __ballot(key[r + 3] >= cand);
                                cnt += (unsigned)(__popcll(m0) + __popcll(m1)) + (unsigned)(__popcll(m2) + __popcll(m3)); }
                            return cnt; };
                        unsigned thr = 0u; bool exact = false, found = false, neg = false;
                        unsigned klo = 0u, khi = 0u, clo = 0u, chi = 0u;
                        { const unsigned c1 = count_ge(0x80000001u);
                          if (c1 == 256u) { thr = 0x80000001u; exact = true; found = true; }
                          else if (c1 > 256u) { unsigned mx = 0u;
#pragma unroll
                              for (int r = 0; r < NRM; ++r) mx = key[r] > mx ? key[r] : mx;
                              klo = 0x80000001u; clo = c1; khi = max64u(mx) + 1u; chi = 0u; }
                          else { const unsigned c3 = count_ge(0x7FFFFFFFu);
                              if (c3 >= 256u) { found = true;
                                  if (c3 == 256u) { thr = 0x7FFFFFFFu; exact = true; }
                                  else { const unsigned c2 = count_ge(0x80000000u);
                                      if (c2 >= 256u) { thr = 0x80000000u; exact = (c2 == 256u); } else thr = 0x7FFFFFFFu; } }
                              else { unsigned mx = 0u;
#pragma unroll
                                  for (int r = 0; r < NRM; ++r) { const unsigned kc = ~key[r] & (unsigned)((r - nr) >> 31); mx = kc > mx ? kc : mx; }
                                  klo = ~max64u(mx); clo = 64u * (unsigned)nr; khi = 0x7FFFFFFFu; chi = c3; neg = true; } } }
                        if (!found) { float wlo = 1.f, whi = 1.f; int last = 0, it = 0;
#pragma unroll 1
                            for (;;) {
                                if (khi - klo <= 1u) { thr = klo; break; }
                                ++it;
                                const float vlo = ikeyf(klo), vhi = ikeyf(khi);
                                const float a = ((float)clo - 255.5f) * wlo, b = (255.5f - (float)chi) * whi;
                                float frac = a * __builtin_amdgcn_rcpf(a + b);
                                if ((it & 7) == 0) frac = 0.5f;
                                if (it == 1) {
                                    if (!neg) { const float lc = __builtin_amdgcn_logf((float)clo); frac = __builtin_amdgcn_exp2f(0.75f * __builtin_amdgcn_logf((lc - 8.f) * __builtin_amdgcn_rcpf(lc))); }
                                    else { const float lm = __builtin_amdgcn_logf((float)(clo - chi)), lb = __builtin_amdgcn_logf((float)(clo - 256u));
                                           frac = 1.f - __builtin_amdgcn_exp2f(0.8f * __builtin_amdgcn_logf((lm - lb) * __builtin_amdgcn_rcpf(lm))); } }
                                unsigned kp = (unsigned)__builtin_amdgcn_readfirstlane((int)okey(vlo + (vhi - vlo) * frac));
                                if (!(kp > klo && kp < khi)) kp = klo + ((khi - klo) >> 1);
                                const unsigned cn = count_ge(kp);
                                if (cn == 256u) { thr = kp; exact = true; break; }
                                if (cn > 256u) { klo = kp; clo = cn; whi = (last == 1) ? whi * 0.7f : 1.f; wlo = 1.f; last = 1; }
                                else { khi = kp; chi = cn; wlo = (last == -1) ? wlo * 0.7f : 1.f; whi = 1.f; last = -1; }
                            } }
                        unsigned need = 0u;
                        if (!exact) { unsigned cgt = 0u;
#pragma unroll
                            for (int r = 0; r < NRM; ++r) cgt += (unsigned)__popcll(__ballot(key[r] > thr));
                            need = 256u - cgt; }
                        unsigned base = 0u;
                        const unsigned long long lowmask = (1ull << lane) - 1ull;
#pragma unroll
                        for (int r = 0; r < NRM; ++r) {
                            bool sel = key[r] >= thr;
                            if (!exact) { const bool eq = key[r] == thr; const unsigned long long em = __ballot(eq);
                                const unsigned pre = __popcll(em & lowmask); sel = (key[r] > thr) || (eq && (base + pre < need)); base += __popcll(em); }
                            const unsigned long long sm = __ballot(sel);
                            if (lane == 0) mkq[r] = sm;
                        }
                    }

DI void phase_select(const Params& p, const Ctx& c, unsigned* qctr) {
    unsigned char* const ws = kws();
    const h16* QALL = (const h16*)kout(); const h16* KIDX = (const h16*)(ws + WS_KIDX);
    const float* WIDX = (const float*)(ws + WS_WIDX); unsigned long long* MASKG = (unsigned long long*)(ws + WS_MASK);
    const int wave = c.wave;
    LAS unsigned char* lds = c.lds;
    volatile LAS unsigned* qw = (volatile LAS unsigned*)(c.lds + LDS_MISC + 64);
    {
        for (;;) {
            const int lane = lane_id(), tid = wave * 64 + lane;
            if (wave == 0 && lane == 0) *qw = __hip_atomic_fetch_add(qctr, 1u, __ATOMIC_RELAXED, __HIP_MEMORY_SCOPE_AGENT);
            __syncthreads();
            const int unit = (int)*qw;
            __syncthreads();
            if (unit >= 1024) break;
            const int chv = 31 - (unit >> 5), subv = unit & 31;
            const int b = subv >> 1, half = subv & 1;
            const int nadm = 64 * (chv + 1), nkt = chv + 1;
            const int kbase = b * SEQ;
            const int tqu = b * SEQ + chv * 64 + half * 32;
            unsigned long long* mk64 = MASKG + (size_t)tqu * 32;
            if (nadm <= 256) {
                if (lane < 16) mk64[(4 * wave + (lane >> 2)) * 32 + (lane & 3)] = ((lane & 3) < nkt) ? ~0ull : 0ull;
            } else {
                LAS float* SC = (LAS float*)lds;
                const int q4 = lane >> 4, c16 = lane & 15;
#pragma unroll 1
                for (int rnd = 0; rnd < 2; ++rnd) {
                    {
                        h16x8 a0[4], a1[4]; f32x4 wv[4];
#pragma unroll
                        for (int g = 0; g < 4; ++g) { const int tqr = tqu + 16 * rnd + 4 * g;
                            const h16* ap = QALL + (size_t)(tqr + (c16 >> 2)) * NQ + 1024 + (c16 & 3) * 64 + 8 * q4; a0[g] = *(const h16x8*)ap; a1[g] = *(const h16x8*)(ap + 32);
                            wv[g] = *(const f32x4*)(WIDX + (size_t)(tqr + q4) * 4); }
                        const int nt16 = nadm >> 4;
                        const h16* kp = KIDX + (size_t)(kbase + c16) * 64 + 8 * q4;
#pragma unroll 1
                        for (int tb = wave; tb < nt16; tb += 64) {
                            h16x8 b0[8], b1[8];
#pragma unroll
                            for (int u = 0; u < 8; ++u) { int tt = tb + 8 * u; tt = tt < nt16 ? tt : tb; b0[u] = *(const h16x8*)(kp + (size_t)tt * 1024); b1[u] = *(const h16x8*)(kp + (size_t)tt * 1024 + 32); }
#pragma unroll
                            for (int u = 0; u < 8; ++u) { const int tt = tb + 8 * u;
                                if (tt < nt16) {
#pragma unroll
                                    for (int g = 0; g < 4; ++g) { f32x4 acc = (f32x4){0.f, 0.f, 0.f, 0.f};
                                        acc = __builtin_amdgcn_mfma_f32_16x16x32_f16(a0[g], b0[u], acc, 0, 0, 0); acc = __builtin_amdgcn_mfma_f32_16x16x32_f16(a1[g], b1[u], acc, 0, 0, 0);
                                        SC[(4 * g + q4) * 2048 + 16 * tt + c16] = ((fmaxf(acc[0], 0.f) * wv[g][0] + fmaxf(acc[1], 0.f) * wv[g][1]) + fmaxf(acc[2], 0.f) * wv[g][2]) + fmaxf(acc[3], 0.f) * wv[g][3]; }
                                }
                            }
                        }
                    }
                    __syncthreads();
                    const int nr = nadm >> 6;
#pragma unroll 1
                    for (int qi = 0; qi < 2; ++qi) {
                        const int ql = 2 * wave + qi; const LAS float* SCq = SC + ql * 2048; unsigned long long* mkq = mk64 + (16 * rnd + ql) * 32;
                        if (nr <= 8) select_query<8>(SCq, mkq, nr, lane); else if (nr <= 16) select_query<16>(SCq, mkq, nr, lane);
                        else if (nr <= 24) select_query<24>(SCq, mkq, nr, lane); else select_query<32>(SCq, mkq, nr, lane);
                    }
                    __syncthreads();
                }
            }
            __syncthreads();
        }
    }
}

namespace ab {
typedef short bf16x8 __attribute__((ext_vector_type(8)));
typedef short s16x4 __attribute__((ext_vector_type(4)));
constexpr int SHM_V = 64 * 128 * 2, SHM_K = 64 * 128 * 2;
constexpr int LDS_RED = 2 * SHM_V + 2 * SHM_K;
constexpr int LDS_MK = LDS_RED + 8 * 256;
constexpr int LDS_END = LDS_MK + 8 * 8192;
constexpr float THRL = 8.0f;
#define AB_KSWZ(row, colB) ((row) * 256 + ((colB) ^ (((row) & 7) << 4)))
#define AB_SBAR() __builtin_amdgcn_sched_barrier(0)
DI int crow(int r, int hi) { return (r & 3) + 8 * (r >> 2) + 4 * hi; }
DI unsigned cvtpk(float lo, float hi) { unsigned r; asm volatile("v_cvt_pk_bf16_f32 %0, %1, %2" : "=v"(r) : "v"(lo), "v"(hi)); return r; }
DI void partialSM(f32x16& p0, f32x16& p1, float& m_reg, float& mn, float& alpha, unsigned wlo, unsigned whi) {
#pragma unroll
    for (int r = 0; r < 16; ++r) { const int o = (r & 3) + 8 * (r >> 2); p0[r] = ((wlo >> o) & 1u) ? p0[r] : -__builtin_inff(); p1[r] = ((whi >> o) & 1u) ? p1[r] : -__builtin_inff(); }
    float pmax = p0[0];
#pragma unroll
    for (int r = 1; r < 16; ++r) pmax = fmaxf(pmax, p0[r]);
#pragma unroll
    for (int r = 0; r < 16; ++r) pmax = fmaxf(pmax, p1[r]);
    { auto rr = __builtin_amdgcn_permlane32_swap(__float_as_uint(pmax), __float_as_uint(pmax), false, false);
      pmax = fmaxf(__uint_as_float(rr[0]), __uint_as_float(rr[1])); }
    if (__builtin_expect(__all(pmax - m_reg <= THRL), 1)) { mn = m_reg; alpha = 1.f; }
    else { mn = fmaxf(m_reg, pmax); alpha = __builtin_amdgcn_exp2f(m_reg - mn); m_reg = mn; }
#pragma unroll
    for (int r = 0; r < 16; ++r) { p0[r] = p0[r] - mn; p1[r] = p1[r] - mn; }
#pragma unroll
    for (int r = 0; r < 16; ++r) p0[r] = __builtin_amdgcn_exp2f(p0[r]);
}
DI void finishSM(f32x16& p0, f32x16& p1, float alpha, float& l_reg, bf16x8& pa0, bf16x8& pa1, bf16x8& pa2, bf16x8& pa3) {
#pragma unroll
    for (int r = 0; r < 16; ++r) p1[r] = __builtin_amdgcn_exp2f(p1[r]);
    float ps = 0;
#pragma unroll
    for (int r = 0; r < 16; ++r) ps += p0[r];
#pragma unroll
    for (int r = 0; r < 16; ++r) ps += p1[r];
    { auto rr = __builtin_amdgcn_permlane32_swap(__float_as_uint(ps), __float_as_uint(ps), false, false);
      ps = __uint_as_float(rr[0]) + __uint_as_float(rr[1]); }
    l_reg = l_reg * alpha + ps;
#define AB_PK4(P, BASE, OUT) do { unsigned a0 = cvtpk(P[BASE + 0], P[BASE + 1]), a1 = cvtpk(P[BASE + 2], P[BASE + 3]);   \
    unsigned b0 = cvtpk(P[BASE + 4], P[BASE + 5]), b1 = cvtpk(P[BASE + 6], P[BASE + 7]);                              \
    auto r0 = __builtin_amdgcn_permlane32_swap(a0, b0, false, false); auto r1 = __builtin_amdgcn_permlane32_swap(a1, b1, false, false); \
    u32x4 w = {r0[0], r1[0], r0[1], r1[1]}; OUT = __builtin_bit_cast(bf16x8, w); } while (0)
    AB_PK4(p0, 0, pa0); AB_PK4(p0, 8, pa1); AB_PK4(p1, 0, pa2); AB_PK4(p1, 8, pa3);
#undef AB_PK4
}
DI void qkt(f32x16& p0, f32x16& p1, const LAS unsigned char* Ks, const bf16x8* qr, int r32, int hi) {
#pragma unroll
    for (int e = 0; e < 16; ++e) { p0[e] = 0.f; p1[e] = 0.f; }
#pragma unroll
    for (int d0 = 0; d0 < 8; ++d0) { const int cb = (d0 * 16 + hi * 8) * 2;
        const bf16x8 b0 = *(const LAS bf16x8*)(Ks + AB_KSWZ(r32, cb));
        const bf16x8 b1 = *(const LAS bf16x8*)(Ks + AB_KSWZ(32 + r32, cb));
        p0 = __builtin_amdgcn_mfma_f32_32x32x16_bf16(b0, qr[d0], p0, 0, 0, 0);
        p1 = __builtin_amdgcn_mfma_f32_32x32x16_bf16(b1, qr[d0], p1, 0, 0, 0); }
}
DI int v_st(int k, int c) { const int kk = (k & ~0xC) | ((k & 4) << 1) | ((k & 8) >> 1); return ((kk >> 3) * 4 + (c >> 5)) * 512 + ((kk & 7) * 32 + (c & 31)) * 2; }
DI int v_rd_base(int lane) { return ((lane & 3) << 3) | (((lane >> 2) & 3) << 6) | (((lane >> 4) & 1) << 5) | (((lane >> 5) & 1) << 8); }
constexpr int v_rd_off(int d0, int ks, int half) { return d0 * 512 + ks * 4096 + half * 2048; }
template <int OFF> DI s16x4 tr_read(int vb) { s16x4 r; asm volatile("ds_read_b64_tr_b16 %0, %1 offset:%2" : "=&v"(r) : "v"(vb), "i"(OFF) : "memory"); return r; }
template <int D0> DI void pv_one(f32x16& od, int vb, bf16x8 pa0, bf16x8 pa1, bf16x8 pa2, bf16x8 pa3) {
    const s16x4 l0 = tr_read<v_rd_off(D0, 0, 0)>(vb), h0 = tr_read<v_rd_off(D0, 0, 1)>(vb), l1 = tr_read<v_rd_off(D0, 1, 0)>(vb), h1 = tr_read<v_rd_off(D0, 1, 1)>(vb);
    const s16x4 l2 = tr_read<v_rd_off(D0, 2, 0)>(vb), h2 = tr_read<v_rd_off(D0, 2, 1)>(vb), l3 = tr_read<v_rd_off(D0, 3, 0)>(vb), h3 = tr_read<v_rd_off(D0, 3, 1)>(vb);
    asm volatile("s_waitcnt lgkmcnt(0)" ::: "memory"); AB_SBAR();
#define AB_PK(L, H) (bf16x8){L[0], L[1], L[2], L[3], H[0], H[1], H[2], H[3]}
    od = __builtin_amdgcn_mfma_f32_32x32x16_bf16(pa0, AB_PK(l0, h0), od, 0, 0, 0);
    od = __builtin_amdgcn_mfma_f32_32x32x16_bf16(pa1, AB_PK(l1, h1), od, 0, 0, 0);
    od = __builtin_amdgcn_mfma_f32_32x32x16_bf16(pa2, AB_PK(l2, h2), od, 0, 0, 0);
    od = __builtin_amdgcn_mfma_f32_32x32x16_bf16(pa3, AB_PK(l3, h3), od, 0, 0, 0);
#undef AB_PK
}
DI void pv_d0(f32x16* o, int vb, bf16x8 pa0, bf16x8 pa1, bf16x8 pa2, bf16x8 pa3) {
    pv_one<0>(o[0], vb, pa0, pa1, pa2, pa3); pv_one<1>(o[1], vb, pa0, pa1, pa2, pa3); pv_one<2>(o[2], vb, pa0, pa1, pa2, pa3); pv_one<3>(o[3], vb, pa0, pa1, pa2, pa3);
}
DI void body(const unsigned short* Qb, const unsigned short* Kh, h16* Ob, const h16* Wv, const unsigned long long* Mb, const int NT, LAS unsigned char* lds, const int wid, const int lane) {
    const int tid = wid * 64 + lane, r32 = lane & 31, hi = lane >> 5;
    LAS unsigned char* V_lds = lds; LAS unsigned char* K_lds = lds + 2 * SHM_V;
    LAS float* wsf = (LAS float*)(lds + LDS_RED) + wid * 64; LAS float* li_l = wsf; LAS float* al_l = wsf + 32;
    LAS unsigned long long* mkl = (LAS unsigned long long*)(lds + LDS_MK) + wid * 1024;
    float m_reg = -1e30f, l_reg = 0;
    f32x16 o[4];
#pragma unroll
    for (int d = 0; d < 4; ++d)
#pragma unroll
        for (int e = 0; e < 16; ++e) o[d][e] = 0.f;
    bf16x8 qr[8];
    const unsigned short* Qw = Qb + (size_t)(wid * 32 + r32) * NQ + hi * 8;
#pragma unroll
    for (int d0 = 0; d0 < 8; ++d0) qr[d0] = *(const bf16x8*)(Qw + d0 * 16);
    {
        const unsigned long long* mrow = Mb + (size_t)(wid * 32 + r32) * 32 + 2 * hi;
        for (int i = 0; i < (NT >> 2); ++i) { const u32x4 w = *(const u32x4*)(mrow + 4 * i);
            mkl[(4 * i + 2 * hi) * 32 + r32] = ((unsigned long long)w.y << 32) | w.x; mkl[(4 * i + 2 * hi + 1) * 32 + r32] = ((unsigned long long)w.w << 32) | w.z; }
    }
    const int sr = tid >> 4, sc = (tid & 15) * 8, vst0 = v_st(sr, sc), vst1 = v_st(32 + sr, sc);
    const int vb0 = (int)(unsigned)(uintptr_t)V_lds + v_rd_base(lane);
    bf16x8 st0[2], st1[2];
#define AB_SLOAD(i, k0) do { st0[i] = *(const bf16x8*)(Kh + (size_t)((k0) + sr) * 128 + sc); st1[i] = *(const bf16x8*)(Kh + (size_t)((k0) + 32 + sr) * 128 + sc); } while (0)
#define AB_SWRITE(b, i) do { *(LAS bf16x8*)(V_lds + (b) * SHM_V + vst0) = st0[i]; *(LAS bf16x8*)(V_lds + (b) * SHM_V + vst1) = st1[i]; const int kc = sc * 2; \
    *(LAS bf16x8*)(K_lds + (b) * SHM_K + AB_KSWZ(sr, kc)) = st0[i]; *(LAS bf16x8*)(K_lds + (b) * SHM_K + AB_KSWZ(32 + sr, kc)) = st1[i]; } while (0)
#define AB_SWAIT() asm volatile("s_waitcnt vmcnt(2)" ::: "memory")
#define AB_RESC(a) do { if (__any((a) < 1.f)) { if (hi == 0) al_l[r32] = (a); asm volatile("s_waitcnt lgkmcnt(0)" ::: "memory"); \
    _Pragma("unroll") for (int d = 0; d < 4; ++d) _Pragma("unroll") for (int r = 0; r < 16; ++r) o[d][r] *= al_l[crow(r, hi)]; } } while (0)
#define AB_MASK(j, WLO, WHI) const unsigned long long mw_##WLO = mkl[(j) * 32 + r32]; const unsigned WLO = (unsigned)mw_##WLO >> (4 * hi), WHI = (unsigned)(mw_##WLO >> 32) >> (4 * hi)
    f32x16 pA0, pA1, pB0, pB1; float mnA, mnB, alA, alB; bf16x8 pa0, pa1, pa2, pa3;
    AB_SLOAD(0, 0); asm volatile("s_waitcnt vmcnt(0)" ::: "memory"); AB_SWRITE(0, 0); __syncthreads();
    qkt(pA0, pA1, K_lds, qr, r32, hi); { AB_MASK(0, wl, wh); partialSM(pA0, pA1, m_reg, mnA, alA, wl, wh); }
    AB_SLOAD(1, 64); if (2 < NT) AB_SLOAD(0, 128);
    AB_SWAIT(); AB_SWRITE(1, 1); __syncthreads();
    for (int j = 1; j + 1 < NT; j += 2) {
        AB_SBAR(); qkt(pB0, pB1, K_lds + SHM_K, qr, r32, hi);
        finishSM(pA0, pA1, alA, l_reg, pa0, pa1, pa2, pa3); AB_SBAR();
        AB_SLOAD(1, (j + 2) * 64); AB_SBAR();
        pv_d0(o, vb0, pa0, pa1, pa2, pa3); { AB_MASK(j, wl, wh); partialSM(pB0, pB1, m_reg, mnB, alB, wl, wh); }
        __syncthreads(); AB_SWAIT(); AB_SWRITE(0, 0);
        AB_RESC(alB); __syncthreads();
        AB_SBAR(); qkt(pA0, pA1, K_lds, qr, r32, hi);
        finishSM(pB0, pB1, alB, l_reg, pa0, pa1, pa2, pa3); AB_SBAR();
        if (j + 3 < NT) AB_SLOAD(0, (j + 3) * 64); AB_SBAR();
        pv_d0(o, vb0 + SHM_V, pa0, pa1, pa2, pa3); { AB_MASK(j + 1, wl, wh); partialSM(pA0, pA1, m_reg, mnA, alA, wl, wh); }
        __syncthreads(); AB_SWAIT(); AB_SWRITE(1, 1);
        AB_RESC(alA); __syncthreads();
    }
    AB_SBAR(); qkt(pB0, pB1, K_lds + SHM_K, qr, r32, hi);
    finishSM(pA0, pA1, alA, l_reg, pa0, pa1, pa2, pa3); AB_SBAR();
    pv_d0(o, vb0, pa0, pa1, pa2, pa3); { AB_MASK(NT - 1, wl, wh); partialSM(pB0, pB1, m_reg, mnB, alB, wl, wh); }
    __syncthreads(); AB_RESC(alB);
    finishSM(pB0, pB1, alB, l_reg, pa0, pa1, pa2, pa3); AB_SBAR();
    pv_d0(o, vb0 + SHM_V, pa0, pa1, pa2, pa3);
    if (hi == 0) li_l[r32] = l_reg;
    asm volatile("s_waitcnt lgkmcnt(0)" ::: "memory");
    __syncthreads();
    LAS unsigned char* ob = lds + wid * 8192;
    const int le_ = lane_id(), r32e = le_ & 31, hie = le_ >> 5;
#pragma unroll
    for (int r = 0; r < 16; ++r) { const int orow = crow(r, hie); const float rli = __builtin_amdgcn_rcpf(li_l[orow]);
#pragma unroll
        for (int d0 = 0; d0 < 4; ++d0) { const int col = d0 * 32 + r32e; *(LAS h16*)(ob + orow * 256 + ((((col >> 3) ^ (orow & 15)) << 4) | ((col & 7) * 2))) = (h16)(o[d0][r] * rli); } }
    asm volatile("s_waitcnt lgkmcnt(0)" ::: "memory");
    f32x16 yv[2];
#pragma unroll
    for (int e = 0; e < 16; ++e) { yv[0][e] = 0.f; yv[1][e] = 0.f; }
#pragma unroll
    for (int s8 = 0; s8 < 8; ++s8) { const h16x8 af = *(const LAS h16x8*)(ob + r32e * 256 + (((2 * s8 + hie) ^ (r32e & 15)) << 4));
#pragma unroll
        for (int nt = 0; nt < 2; ++nt) { const h16x8 bf = *(const h16x8*)(Wv + (size_t)(32 * nt + r32e) * 128 + 16 * s8 + 8 * hie);
            yv[nt] = __builtin_amdgcn_mfma_f32_32x32x16_f16(af, bf, yv[nt], 0, 0, 0); } }
#pragma unroll
    for (int nt = 0; nt < 2; ++nt)
#pragma unroll
        for (int r = 0; r < 16; ++r) Ob[(size_t)(wid * 32 + crow(r, hie)) * KOUT + 32 * nt + r32e] = (h16)yv[nt][r];
#undef AB_SLOAD
#undef AB_SWRITE
#undef AB_SWAIT
#undef AB_RESC
#undef AB_MASK
}
}

DI void phase_attn(const Params& p, const Ctx& c, unsigned* qctr, const int l) {
    unsigned char* const ws = kws();
    const unsigned short* QALL = (const unsigned short*)kout(); const unsigned short* CKV = (const unsigned short*)(ws + WS_CKV);
    const unsigned long long* MASKG = (const unsigned long long*)(ws + WS_MASK); h16* AOUT = (h16*)(ws + WS_AOUT);
    const int wave = c.wave;
    volatile LAS unsigned* qw = (volatile LAS unsigned*)(c.lds + LDS_MISC + 64);
    for (;;) {
        const int lane = lane_id();
        if (wave == 0 && lane == 0) *qw = __hip_atomic_fetch_add(qctr, 1u, __ATOMIC_RELAXED, __HIP_MEMORY_SCOPE_AGENT);
        __syncthreads();
        const int unit = (int)*qw;
        __syncthreads();
        if (unit >= NB * 8 * 8) break;
        const int qb = 7 - (unit >> 7), b = (unit >> 3) & 15, h = unit & 7;
        const size_t row0 = (size_t)b * SEQ + 256 * qb;
        ab::body(QALL + row0 * NQ + h * 128, CKV + (size_t)b * SEQ * 128, AOUT + row0 * KOUT + h * 64, (const h16*)(ws + wofs(l) + WT_VUP) + h * 64 * 128, MASKG + row0 * 32, 4 * (qb + 1), c.lds, wave, lane);
        __syncthreads();
    }
}

DI int sw128(int row, int boff) { return row * 128 + ((((boff >> 4) ^ ((row >> 1) & 7)) << 4) | (boff & 15)); }
DI int sw64(int row, int boff)  { return row * 64 + ((((boff >> 4) ^ ((row >> 2) & 3)) << 4) | (boff & 15)); }
DI int sw32(int row, int boff)  { return row * 32 + ((((boff >> 4) ^ ((row >> 3) & 1)) << 4) | (boff & 15)); }
constexpr int SL_A1 = 0, SL_A4 = 4096, SL_WY = 8192, SL_VT = 12288, SL_A23 = 14336, SL_A5 = 15360, SL_P16 = 16384, SLOT = 16640;
DI float rl(float x, int l) { return __builtin_bit_cast(float, __builtin_amdgcn_readlane(__builtin_bit_cast(int, x), l)); }
template <int CTRL, int RM> DI float dppf_rm(float x) { return __builtin_bit_cast(float, __builtin_amdgcn_update_dpp(0, __builtin_bit_cast(int, x), CTRL, RM, 0xf, false)); }
DI float sum64u(float x) { x = sum16(x);
    asm("s_nop 1\n\tv_add_f32_dpp %0, %0, %0 row_bcast:15 row_mask:0xa bank_mask:0xf\n\ts_nop 1\n\tv_add_f32_dpp %0, %0, %0 row_bcast:31 row_mask:0xc bank_mask:0xf\n\ts_nop 0" : "+v"(x));
    return rl(x, 63); }
DI void sum64u2(float x, float y, float& rx, float& ry) {
#define S2_STEP(ctl) "v_add_f32_dpp %0, %0, %0 " ctl "\n\tv_add_f32_dpp %1, %1, %1 " ctl "\n\ts_nop 0\n\t"
    asm("s_nop 1\n\t"
        S2_STEP("quad_perm:[1,0,3,2] row_mask:0xf bank_mask:0xf bound_ctrl:1")
        S2_STEP("quad_perm:[2,3,0,1] row_mask:0xf bank_mask:0xf bound_ctrl:1")
        S2_STEP("row_half_mirror row_mask:0xf bank_mask:0xf bound_ctrl:1")
        S2_STEP("row_mirror row_mask:0xf bank_mask:0xf bound_ctrl:1")
        S2_STEP("row_bcast:15 row_mask:0xa bank_mask:0xf")
        S2_STEP("row_bcast:31 row_mask:0xc bank_mask:0xf")
        : "+v"(x), "+v"(y));
#undef S2_STEP
    rx = rl(x, 63); ry = rl(y, 63);
}
DI u32x4 pk8(float a, float b, float c, float d, float e, float f, float g, float h) { u32x4 w; w.x = pkh(a, b); w.y = pkh(c, d); w.z = pkh(e, f); w.w = pkh(g, h); return w; }

DI void phase_scan2(const Params& p, const Ctx& c, int l) {
    unsigned char* const ws = kws();
    const h16* RKV = (const h16*)(ws + WS_RKV); const h16* LO = (const h16*)(ws + WS_LORAO); h16* V1 = (h16*)(ws + WS_V1ST); h16* AOUT = (h16*)(ws + WS_AOUT);
    const int wave = c.wave;
    LAS unsigned char* const slot = c.lds + wave * SLOT;
    for (int u = blockIdx.x; u < NB * 8; u += c.G) {
        const int b = u >> 3, h = u & 7; const int col0 = h * 64 + lane_id();
        const float mur = kin<I_MU>()[l * 1824 + col0], muk = kin<I_MU>()[l * 1824 + 512 + col0], muv = kin<I_MU>()[l * 1824 + 1024 + col0];
        const float kkw = kin<I_KK>()[l * 512 + col0], kaw = kin<I_KA>()[l * 512 + col0], rkw = kin<I_RK>()[l * 512 + col0];
        const float lng = kin<I_LNXG>()[l * 512 + col0], lnb = kin<I_LNXB>()[l * 512 + col0];
        f32x16 Sg[2]; h16x8 sfrag[4];
#pragma unroll
        for (int i = 0; i < 16; ++i) { Sg[0][i] = 0.f; Sg[1][i] = 0.f; }
#pragma unroll
        for (int i = 0; i < 4; ++i) sfrag[i] = (h16x8){0, 0, 0, 0, 0, 0, 0, 0};
#pragma unroll 1
        for (int ss = 0; ss < SEQ / 128; ++ss) {
            const int lane = lane_id(), n = lane & 31, hh = lane >> 5, col = h * 64 + lane;
            const int t0 = 128 * ss + 16 * wave; const size_t m0 = (size_t)b * SEQ + t0;
            unsigned g12[16];
            {
                float Pin[16], vv[16];
                h16 wd[16], xr[2][8], xk[2][8], xv[2][8], xa[2][8], xg[2][8], xs[2][8], xf[2][8];
#define SC_LOAD_HALF(hb) { _Pragma("unroll") for (int tt = 0; tt < 8; ++tt) { const size_t m = m0 + 8 * (hb) + tt; const h16* q = RKV + m * NRKV + col; const h16* lp = LO + m * NLORA + col; \
                        xr[hb][tt] = q[0]; xk[hb][tt] = q[512]; xv[hb][tt] = q[1024]; xa[hb][tt] = lp[512]; xg[hb][tt] = lp[1024]; \
                        if (l != 0) { xs[hb][tt] = lp[1536]; xf[hb][tt] = V1[m * 512 + col]; } else { xs[hb][tt] = (h16)0.f; xf[hb][tt] = (h16)0.f; } } }
#pragma unroll
                for (int t = 0; t < 16; ++t) wd[t] = LO[(m0 + t) * NLORA + col];
                const h16* qprev = RKV + (m0 - (t0 > 0 ? 1 : 0)) * NRKV + col; const float zprev = (t0 > 0) ? 1.0f : 0.0f;
                const h16 pr_h = qprev[0], pk_h = qprev[512], pv_h = qprev[1024];
                SC_LOAD_HALF(0)
                asm volatile("" ::: "memory");
#pragma unroll
                for (int t = 0; t < 16; ++t) { const float wt = 1.0f - (float)wd[t]; Pin[t] = (t == 0) ? wt : Pin[t - 1] * wt; }
                const float P8 = Pin[7], iP8 = __builtin_amdgcn_rcpf(P8), P16 = Pin[15];
                const int q15 = lane & 15, pos = 16 * (lane >> 4) + 8 * ((q15 >> 2) & 1) + 4 * (q15 >> 3) + (q15 & 3);
                int xbL[8], xbP[8], xa4[4];
#pragma unroll
                for (int e = 0; e < 8; ++e) { xbL[e] = ((((2 * lane) >> 4) ^ e) << 4) | ((2 * lane) & 15); xbP[e] = ((((2 * pos) >> 4) ^ e) << 4) | ((2 * pos) & 15); }
#pragma unroll
                for (int e = 0; e < 4; ++e) xa4[e] = lane * 64 + ((e ^ ((lane >> 2) & 3)) << 4);
                {
                    float pr = (float)pr_h * zprev, pk = (float)pk_h * zprev, pv = (float)pv_h * zprev;
#pragma unroll
                    for (int hb = 0; hb < 2; ++hb) {
                    if (hb == 0) { SC_LOAD_HALF(1) asm volatile("" ::: "memory"); }
#pragma unroll
                    for (int tt = 0; tt < 8; ++tt) {
                        const int t = 8 * hb + tt; const size_t m = m0 + t;
                        const float r0 = (float)xr[hb][tt], k0 = (float)xk[hb][tt], v0 = (float)xv[hb][tt];
                        const float aa = (float)xa[hb][tt], gg = (float)xg[hb][tt], sg = (float)xs[hb][tt];
                        const float r = r0 + (pr - r0) * mur, k = k0 + (pk - k0) * muk; float v = v0 + (pv - v0) * muv;
                        pr = r0; pk = k0; pv = v0;
                        if (l == 0) V1[m * 512 + col] = (h16)v; else { const float vf = (float)xf[hb][tt]; v = v + (vf - v) * sg; }
                        const float kkr = k * kkw, kpv = k * (1.0f + (aa - 1.0f) * kaw);
                        float ssq, bon; sum64u2(kkr * kkr, r * kpv * rkw, ssq, bon);
                        const float kn = kkr * __builtin_amdgcn_rcpf(fmaxf(__builtin_amdgcn_sqrtf(ssq), 1e-12f)), bt = kn * aa;
                        vv[t] = v; g12[t] = pkh(lng * gg, (lnb + bon * v) * gg);
                        const float iPt = __builtin_amdgcn_rcpf(Pin[t]);
                        const float gin = Pin[t] * iP8, pex = (t == 0) ? 1.0f : Pin[t - 1], gex = pex * iP8, ig = P8 * iPt, sfx = P16 * iPt;
                        *(LAS h16*)(slot + SL_WY + t * 128 + xbL[(t >> 1) & 7]) = (h16)(bt * ig);
                        *(LAS h16*)(slot + SL_WY + (16 + t) * 128 + xbL[(t >> 1) & 7]) = (h16)(kpv * ig);
                        *(LAS h16*)(slot + SL_WY + 4096 + t * 128 + xbL[(t >> 1) & 7]) = (h16)(kn * gex);
                        *(LAS h16*)(slot + SL_WY + 4096 + (16 + t) * 128 + xbL[(t >> 1) & 7]) = (h16)(r * gin);
                        *(LAS h16*)(slot + SL_A1 + t * 128 + xbP[(t >> 1) & 7]) = (h16)(kn * pex);
                        *(LAS h16*)(slot + SL_A1 + (16 + t) * 128 + xbP[(t >> 1) & 7]) = (h16)(r * Pin[t]);
                        const int ps = 8 * ((t >> 2) & 1) + 4 * (t >> 3) + (t & 3);
                        *(LAS h16*)(slot + SL_A4 + xa4[(2 * ps) >> 4] + ((2 * ps) & 15)) = (h16)(bt * sfx);
                        *(LAS h16*)(slot + SL_A4 + xa4[2 + ((2 * ps) >> 4)] + ((2 * ps) & 15)) = (h16)(kpv * sfx);
                    }
                    }
                }
                *(LAS float*)(slot + SL_P16 + 4 * lane) = P16;
                asm volatile("s_waitcnt lgkmcnt(0)" ::: "memory");
                f32x16 G;
#pragma unroll
                for (int i = 0; i < 16; ++i) G[i] = 0.f;
#pragma unroll
                for (int ks = 0; ks < 4; ++ks) { const h16x8 af = *(const LAS h16x8*)(slot + SL_WY + sw128(n, (16 * ks + 8 * hh) * 2)), bf = *(const LAS h16x8*)(slot + SL_WY + 4096 + sw128(n, (16 * ks + 8 * hh) * 2));
                    G = __builtin_amdgcn_mfma_f32_32x32x16_f16(af, bf, G, 0, 0, 0); }
                {
                    const int t = n & 15; const bool isR = n >= 16;
                    float top[8], bot[8];
#pragma unroll
                    for (int i = 0; i < 8; ++i) { const int ip = (i & 3) + 8 * (i >> 2) + 4 * hh; const bool keep = isR ? (ip <= t) : (ip < t);
                        top[i] = keep ? G[i] : 0.f; bot[i] = keep ? (isR ? G[8 + i] : -G[8 + i]) : 0.f; }
                    asm volatile("s_waitcnt lgkmcnt(0)" ::: "memory");
                    if (isR) *(LAS u32x4*)(slot + SL_A23 + sw32(n, 16 * hh)) = pk8(top[0], top[1], top[2], top[3], top[4], top[5], top[6], top[7]);
                    *(LAS u32x4*)(slot + SL_A5 + sw32(n, 16 * hh)) = pk8(bot[0], bot[1], bot[2], bot[3], bot[4], bot[5], bot[6], bot[7]);
                    {
                        const int r16 = lane & 15; float Tr[16];
#pragma unroll
                        for (int j = 0; j < 16; ++j) { float acc = (j == r16) ? 1.0f : 0.0f;
#pragma unroll
                            for (int i = 0; i < j; ++i) acc -= rl(top[(i & 3) + 4 * (i >> 3)], j + 32 * ((i >> 2) & 1)) * Tr[i];
                            Tr[j] = acc; }
                        const int ps2 = 2 * (8 * ((r16 >> 2) & 1) + 4 * (r16 >> 3) + (r16 & 3));
                        if (lane < 16) {
#pragma unroll
                            for (int t2 = 0; t2 < 16; ++t2) *(LAS h16*)(slot + SL_A23 + sw32(t2, ps2)) = (h16)Tr[t2];
                        }
                    }
                }
                *(LAS u32x4*)(slot + SL_VT + sw32(lane, 0)) = pk8(vv[0], vv[1], vv[2], vv[3], vv[8], vv[9], vv[10], vv[11]);
                *(LAS u32x4*)(slot + SL_VT + sw32(lane, 16)) = pk8(vv[4], vv[5], vv[6], vv[7], vv[12], vv[13], vv[14], vv[15]);
                asm volatile("s_waitcnt lgkmcnt(0)" ::: "memory");
                {
                    const h16x8 a5 = *(const LAS h16x8*)(slot + SL_A5 + sw32(n, 16 * hh));
#pragma unroll
                    for (int vt = 0; vt < 2; ++vt) { const h16x8 vf = *(const LAS h16x8*)(slot + SL_VT + sw32(32 * vt + n, 16 * hh));
                        f32x16 Wm;
#pragma unroll
                        for (int i = 0; i < 16; ++i) Wm[i] = 0.f;
                        Wm = __builtin_amdgcn_mfma_f32_32x32x16_f16(a5, vf, Wm, 0, 0, 0);
                        *(LAS u32x4*)(slot + SL_WY + vt * 2048 + sw32(lane, 0)) = pk8(Wm[0], Wm[1], Wm[2], Wm[3], Wm[4], Wm[5], Wm[6], Wm[7]);
                        *(LAS u32x4*)(slot + SL_WY + vt * 2048 + sw32(lane, 16)) = pk8(Wm[8], Wm[9], Wm[10], Wm[11], Wm[12], Wm[13], Wm[14], Wm[15]); }
                }
            }
            __syncthreads();
            if (wave < 2) {
                const int vt = wave;
#pragma unroll 1
                for (int j = 0; j < 8; ++j) {
                    const LAS unsigned char* sb = c.lds + j * SLOT;
                    h16x8 a1[4], a4[2][2];
#pragma unroll
                    for (int ks = 0; ks < 4; ++ks) a1[ks] = *(const LAS h16x8*)(sb + SL_A1 + sw128(n, (16 * ks + 8 * hh) * 2));
                    const u32x4 wy0 = *(const LAS u32x4*)(sb + SL_WY + vt * 2048 + sw32(lane, 0)), wy1 = *(const LAS u32x4*)(sb + SL_WY + vt * 2048 + sw32(lane, 16));
                    const h16x8 a23 = *(const LAS h16x8*)(sb + SL_A23 + sw32(n, 16 * hh));
#pragma unroll
                    for (int kt = 0; kt < 2; ++kt)
#pragma unroll
                        for (int s2 = 0; s2 < 2; ++s2) a4[kt][s2] = *(const LAS h16x8*)(sb + SL_A4 + sw64(32 * kt + n, 32 * s2 + 16 * hh));
                    const h16x8 vf = *(const LAS h16x8*)(sb + SL_VT + sw32(32 * vt + n, 16 * hh));
                    f32x16 D1;
#pragma unroll
                    for (int i = 0; i < 16; ++i) D1[i] = 0.f;
#pragma unroll
                    for (int ks = 0; ks < 4; ++ks) D1 = __builtin_amdgcn_mfma_f32_32x32x16_f16(a1[ks], sfrag[ks], D1, 0, 0, 0);
                    const float w0v[8] = {hlo(wy0.x), hhi(wy0.x), hlo(wy0.y), hhi(wy0.y), hlo(wy0.z), hhi(wy0.z), hlo(wy0.w), hhi(wy0.w)};
                    const float y0v[8] = {hlo(wy1.x), hhi(wy1.x), hlo(wy1.y), hhi(wy1.y), hlo(wy1.z), hhi(wy1.z), hlo(wy1.w), hhi(wy1.w)};
                    const u32x4 ubw = pk8(w0v[0] - D1[0], w0v[1] - D1[1], w0v[2] - D1[2], w0v[3] - D1[3], w0v[4] - D1[4], w0v[5] - D1[5], w0v[6] - D1[6], w0v[7] - D1[7]);
                    f32x16 D2;
#pragma unroll
                    for (int i = 0; i < 16; ++i) D2[i] = 0.f;
                    D2 = __builtin_amdgcn_mfma_f32_32x32x16_f16(a23, __builtin_bit_cast(h16x8, ubw), D2, 0, 0, 0);
                    const h16x8 uf = __builtin_bit_cast(h16x8, pk8(D2[0], D2[1], D2[2], D2[3], D2[4], D2[5], D2[6], D2[7]));
                    D1 = __builtin_amdgcn_mfma_f32_32x32x16_f16(a23, uf, D1, 0, 0, 0);
#pragma unroll
                    for (int kt = 0; kt < 2; ++kt) {
                        f32x4 p16[4];
#pragma unroll
                        for (int g = 0; g < 4; ++g) p16[g] = *(const LAS f32x4*)(sb + SL_P16 + (32 * kt + 8 * g + 4 * hh) * 4);
#pragma unroll
                        for (int i = 0; i < 16; ++i) Sg[kt][i] *= p16[i >> 2][i & 3];
                        Sg[kt] = __builtin_amdgcn_mfma_f32_32x32x16_f16(a4[kt][0], uf, Sg[kt], 0, 0, 0);
                        Sg[kt] = __builtin_amdgcn_mfma_f32_32x32x16_f16(a4[kt][1], vf, Sg[kt], 0, 0, 0);
                    }
                    LAS float* yo = (LAS float*)(c.lds + j * SLOT + SL_WY + vt * 2048);
#pragma unroll
                    for (int i = 0; i < 8; ++i) { const int t = (i & 3) + 8 * (i >> 2) + 4 * hh; yo[t * 32 + n] = D1[8 + i] + y0v[i]; }
#pragma unroll
                    for (int kt = 0; kt < 2; ++kt)
#pragma unroll
                        for (int s = 0; s < 2; ++s) sfrag[2 * kt + s] = __builtin_bit_cast(h16x8, pk8(Sg[kt][8 * s], Sg[kt][8 * s + 1], Sg[kt][8 * s + 2], Sg[kt][8 * s + 3], Sg[kt][8 * s + 4], Sg[kt][8 * s + 5], Sg[kt][8 * s + 6], Sg[kt][8 * s + 7]));
                }
            }
            __syncthreads();
            {
                const LAS float* yi = (const LAS float*)(slot + SL_WY + hh * 2048);
                float yv[16];
#pragma unroll
                for (int t = 0; t < 16; ++t) yv[t] = yi[t * 32 + n];
#pragma unroll
                for (int t = 0; t < 16; t += 2) {
                    float s0, s1; sum64u2(yv[t], yv[t + 1], s0, s1);
                    const float dv0 = yv[t] - s0 * (1.0f / 64.0f), dv1 = yv[t + 1] - s1 * (1.0f / 64.0f);
                    float q0, q1; sum64u2(dv0 * dv0, dv1 * dv1, q0, q1);
                    const float o0 = dv0 * rsqrtf(q0 * (1.0f / 64.0f) + LNX_EPS) * hlo(g12[t]) + hhi(g12[t]);
                    const float o1 = dv1 * rsqrtf(q1 * (1.0f / 64.0f) + LNX_EPS) * hlo(g12[t + 1]) + hhi(g12[t + 1]);
                    AOUT[(m0 + t) * KOUT + 512 + col] = (h16)o0; AOUT[(m0 + t + 1) * KOUT + 512 + col] = (h16)o1;
                }
            }
            asm volatile("s_waitcnt lgkmcnt(0)" ::: "memory");
        }
        __syncthreads();
    }
}

constexpr int STEPS_PER_LAYER = 10, NSTEPS = 2 + NL * STEPS_PER_LAYER;
#define IN(k) (lo <= (k) && (k) < hi)
#define SEAM(k) do { if (IN(k) && IN((k) + 1)) xcd_barrier(bar, c.wave); } while (0)
template <int l>
DI void layer_steps(const Params& p, const Ctx& c, const XcdBarrier& bar, const int lo, const int hi) {
        const int s0 = 2 + l * STEPS_PER_LAYER;
        if (IN(s0 + 0)) { unsigned char* const ws = kws();
            {
              pg8::Gemm g{(const h16*)(ws + WS_H), (const h16*)(ws + wofs(l) + WT_IN), MT, NIN16, DM, DM, DM}; pg8::StaticOrder S; S.init(MT, NIN16, c.G, (int)blockIdx.x);
              pg8::EpiH16 E{(h16*)(ws + WS_COLSA), NCA, 1000, nullptr, 0};
              pg8::gemm_phase(c.lds, g, S, E, c.wave); }
            {
              pg8::Gemm g{(const h16*)(ws + WS_H8IN), (const h16*)(ws + wofs(l) + WT_IN + (size_t)NIN16 * DM * 2), MT, NIN - NIN16, DM / 2, DM / 2, DM / 2}; pg8::StaticOrder S; S.init(MT, NIN - NIN16, c.G, (int)blockIdx.x);
              pg8::EpiH16I8 E{(h16*)(ws + WS_COLSA) + NIN16, NCA, 1, (h16*)(ws + WS_RKV), NRKV, (const float*)(ws + WS_RS), wmax_load(ws, l, 1) * (1.0f / 127.0f)};
              pg8::gemm_phase(c.lds, g, S, E, c.wave); }
            if (l + 1 < NL && c.G > NB * 8 && blockIdx.x >= NB * 8) { __syncthreads(); Ctx c2 = c; c2.gw = (blockIdx.x - NB * 8) * 8 + c.wave; c2.ngw = (c.G - NB * 8) * 8; phase_wmax(p, c2, l + 1); phase_wconv(p, c2, l + 1, 0, WC_P1, false); }
        }
        SEAM(s0 + 0);
        if (IN(s0 + 1)) phase_prep(p, c, l);
        SEAM(s0 + 1);
        if (IN(s0 + 2)) { unsigned char* const ws = kws();
            { pg8::Gemm g{(const h16*)(ws + WS_CQ), (const h16*)(ws + wofs(l) + WT_Q), MT, NQ, 256, 256, 256}; pg8::StaticOrder S; S.init(MT, NQ, c.G, (int)blockIdx.x);
              pg8::EpiQ E{(h16*)kout()};
              pg8::gemm_phase(c.lds, g, S, E, c.wave); }
            {
              pg8::Gemm g{(const h16*)(ws + WS_ALORA), (const h16*)(ws + wofs(l) + WT_LORA), MT, 1024, 128, KLORA, 128}; pg8::StaticOrder S; S.init(MT, 1024, c.G, (int)blockIdx.x);
              pg8::EpiLora E{(h16*)(ws + WS_LORAO), kin<I_W0>() + l * 512, kin<I_A0>() + l * 512, kin<I_V0>() + (l > 0 ? l - 1 : 0) * 512, l > 0 ? 1 : 0, 0};
              pg8::gemm_phase(c.lds, g, S, E, c.wave); }
            {
              constexpr int N2 = (l > 0) ? 1024 : 512;
              pg8::Gemm g{(const h16*)(ws + WS_ALORA) + 128, (const h16*)(ws + wofs(l) + WT_LORA) + 1024 * 128, MT, N2, 256, KLORA, 256}; pg8::StaticOrder S; S.init(MT, N2, c.G, (int)blockIdx.x);
              pg8::EpiLora E{(h16*)(ws + WS_LORAO), kin<I_W0>() + l * 512, kin<I_A0>() + l * 512, kin<I_V0>() + (l > 0 ? l - 1 : 0) * 512, l > 0 ? 1 : 0, 4};
              pg8::gemm_phase(c.lds, g, S, E, c.wave); }
        }
        SEAM(s0 + 2);
        if (IN(s0 + 3)) { unsigned char* const ws = kws(); if (blockIdx.x < NB * 8) { phase_scan2(p, c, l); __syncthreads(); }
            else if (l + 1 < NL) { Ctx c2 = c; c2.gw = (blockIdx.x - NB * 8) * 8 + c.wave; c2.ngw = (c.G - NB * 8) * 8; phase_wconv(p, c2, l + 1, WC_P1, WC_NIT, true); __syncthreads(); }
            phase_select(p, c, (unsigned*)(ws + WS_CTL) + 8192 + 64 * l); }
        SEAM(s0 + 3);
        if (IN(s0 + 4)) { unsigned char* const ws = kws(); phase_attn(p, c, (unsigned*)(ws + WS_CTL) + 8192 + 64 * l + 16, l); }
        SEAM(s0 + 4);
        if (IN(s0 + 5)) { unsigned char* const ws = kws();
            pg8::Gemm g{(const h16*)(ws + WS_AOUT), (const h16*)(ws + wofs(l) + WT_OUT), MT, DM, KOUT, KOUT, KOUT}; pg8::StaticOrder S; S.init(MT, DM, c.G, (int)blockIdx.x);
            pg8::EpiH16 E{(h16*)(ws + WS_Y), DM, 1000, nullptr, 0};
            pg8::gemm_phase(c.lds, g, S, E, c.wave);
        }
        SEAM(s0 + 5);
        if (IN(s0 + 6)) { phase_rows<1, true, false, 1>(p, c, (const h16*)(kws() + WS_Y), kin<I_POSTMIX>() + l * DM, 2048, l, kin<I_PREFFN>() + l * DM, 3072, 4096, l, -1);
                          if (l + 1 < NL && c.G <= NB * 8) phase_wmax(p, c, l + 1); }
        SEAM(s0 + 6);
        if (IN(s0 + 7)) { unsigned char* const ws = kws();
            pg8::Gemm g{(const h16*)(ws + WS_H), (const h16*)(ws + wofs(l) + WT_FC), MT, NFC, DM / 2, DM / 2, DM / 2}; pg8::StaticOrder S; S.init(MT, NFC, c.G, (int)blockIdx.x);
            pg8::EpiSwigluI8 E{(h16*)(ws + WS_HID), (const float*)(ws + WS_RS), wmax_load(ws, l, 0) * (1.0f / 127.0f)};
            pg8::gemm_phase(c.lds, g, S, E, c.wave);
        }
        SEAM(s0 + 7);
        if (IN(s0 + 8)) { unsigned char* const ws = kws();
            pg8::Gemm g{(const h16*)(ws + WS_HID), (const h16*)(ws + wofs(l) + WT_DOWN), MT, DM, DFF, DFF, DFF}; pg8::StaticOrder S; S.init(MT, DM, c.G, (int)blockIdx.x);
            pg8::EpiH16 E{(h16*)(ws + WS_Y2), DM, 1000, nullptr, 0};
            pg8::gemm_phase(c.lds, g, S, E, c.wave);
        }
        SEAM(s0 + 8);
        if (IN(s0 + 9)) { unsigned char* const ws = kws();
            if (l + 1 < NL) { phase_rows<1, true, true, 2>(p, c, (const h16*)(ws + WS_Y2), kin<I_POSTFFN>() + l * DM, 5120, l, kin<I_PREMIX>() + (l + 1) * DM, 0, 1024, l + 1, l + 1);
                              if (c.G <= NB * 8) { __syncthreads(); phase_wconv(p, c, l + 1, 0, WC_NIT, true); } }
            else phase_rows<1, false, false>(p, c, (const h16*)(ws + WS_Y2), kin<I_POSTFFN>() + l * DM, 5120, l, nullptr, 0, 0, 0, -1);
        }
        SEAM(s0 + 9);
    }
#undef IN
#undef SEAM

__global__ void __launch_bounds__(NTHR, 2) fwd_kernel(Params p) {
    extern __shared__ __attribute__((aligned(16))) unsigned char lds_raw[];
    Ctx c; c.lds = (LAS unsigned char*)lds_raw; c.wave = __builtin_amdgcn_readfirstlane((int)threadIdx.x >> 6);
    c.G = gridDim.x; c.gw = blockIdx.x * 8 + c.wave; c.ngw = c.G * 8;
    volatile LAS unsigned* misc = (volatile LAS unsigned*)(c.lds + LDS_MISC);
    if (c.wave == 0) misc[lane_id()] = 0u;
    __syncthreads();
    unsigned* ctl = (unsigned*)(kws() + WS_CTL);
    XcdBarrier bar; bar.bar = ctl; bar.x = 0; bar.st = nullptr;
    const bool multi = (p.step_hi - p.step_lo) > 1;
    if (multi) bar = xcd_barrier_post(ctl, misc + 8, c.wave);
    const int lo = p.step_lo, hi = p.step_hi;
#define IN(k) (lo <= (k) && (k) < hi)
#define SEAM(k) do { if (IN(k) && IN((k) + 1)) xcd_barrier(bar, c.wave); } while (0)

    if (IN(0)) { phase_mod(p, c); __syncthreads(); phase_wmax(p, c, 0); phase_wconv(p, c, 0, 0, WC_NOQ, true); }
    SEAM(0);
    if (IN(1)) { phase_rows<0, true, true, 2>(p, c, nullptr, nullptr, 0, 0, kin<I_PREMIX>(), 0, 1024, 0, 0); phase_wconv(p, c, 0, WC_NOQ, WC_NIT, false); }
    SEAM(1);
    layer_steps<0>(p, c, bar, lo, hi);
    layer_steps<1>(p, c, bar, lo, hi);
    layer_steps<2>(p, c, bar, lo, hi);
    layer_steps<3>(p, c, bar, lo, hi);
#undef IN
#undef SEAM
}

extern "C" void kernel_launch(void* const* d_in, const int* in_sizes, int n_in, void* d_out, int out_size, void* d_ws, size_t ws_size, hipStream_t stream) {
    static int grid = 0;
    if (grid == 0) {
        if (n_in != 35 || out_size != MT * DM || ws_size < WS_NEED) { fprintf(stderr, "kernel_launch: unexpected problem (n_in %d out %d ws %zu)\n", n_in, out_size, ws_size); grid = -1; return; }
        int dev = 0, cus = 0, per_cu = 0;
        if (hipGetDevice(&dev) != hipSuccess || hipDeviceGetAttribute(&cus, hipDeviceAttributeMultiprocessorCount, dev) != hipSuccess) { grid = -1; return; }
        if (hipFuncSetAttribute((const void*)fwd_kernel, hipFuncAttributeMaxDynamicSharedMemorySize, LDS_BYTES) != hipSuccess) { fprintf(stderr, "kernel_launch: hipFuncSetAttribute failed\n"); grid = -1; return; }
        if (hipOccupancyMaxActiveBlocksPerMultiprocessor(&per_cu, (const void*)fwd_kernel, NTHR, LDS_BYTES) != hipSuccess || per_cu < 1) { fprintf(stderr, "kernel_launch: occupancy query says %d\n", per_cu); (void)hipGetLastError(); per_cu = 1; }
        grid = cus;
        if (grid > 256) grid = 256;
    }
    if (grid < 0) return;
    (void)hipMemsetAsync((char*)d_ws + WS_CTL, 0, CTL_BYTES, stream);
    Params p{};
    for (int i = 0; i < 35; ++i) p.in[i] = (const float*)d_in[i];
    p.out = (float*)d_out; p.ws = (unsigned char*)d_ws;
#if MK_PER_STEP_LAUNCH
    for (int s = 0; s < NSTEPS; ++s) { p.step_lo = s; p.step_hi = s + 1; hipLaunchKernelGGL(fwd_kernel, dim3(grid), dim3(NTHR), LDS_BYTES, stream, p); }
#else
    p.step_lo = 0; p.step_hi = NSTEPS;
    hipLaunchKernelGGL(fwd_kernel, dim3(grid), dim3(NTHR), LDS_BYTES, stream, p);
#endif
}
```

```cpp
#include <hip/hip_runtime.h>
#include <cstdio>
#include <cstdint>

#ifndef MK_PER_STEP_LAUNCH
#define MK_PER_STEP_LAUNCH 0
#endif

#define DI __device__ __forceinline__
#define LAS __attribute__((address_space(3)))
typedef _Float16 h16;
typedef h16 h16x8 __attribute__((ext_vector_type(8)));
typedef h16 h16x4 __attribute__((ext_vector_type(4)));
typedef h16 h16x2 __attribute__((ext_vector_type(2)));
typedef float f32x2 __attribute__((ext_vector_type(2)));
typedef float f32x4 __attribute__((ext_vector_type(4)));
typedef float f32x16 __attribute__((ext_vector_type(16)));
typedef unsigned u32x2 __attribute__((ext_vector_type(2)));
typedef unsigned u32x4 __attribute__((ext_vector_type(4)));
typedef int i32x4 __attribute__((ext_vector_type(4)));

constexpr int NB = 16, SEQ = 2048, DM = 1024, NL = 4, MT = NB * SEQ;
constexpr int PIN = 2276;
constexpr int NCA = 768, NRKV = 1536, NIN = NCA + NRKV;
constexpr int WC_NOQ = (2816 / 64) * (1024 / 32) + 16 * (1024 / 32), WC_NIT = WC_NOQ + 16 * ((768 + 1536) / 32) + 16 * (5632 / 32), WC_P1 = 0, NIN16 = 0;
constexpr int NQ = 1280, KLORA = 384, NLORA = 2048, KOUT = 1024, NFC = 5632, DFF = 2816;
constexpr float NORM_EPS = 1e-6f, LNX_EPS = 64e-5f;

constexpr size_t MiB = 1u << 20;
constexpr size_t WS_CTL = 0, CTL_BYTES = 64 * 1024;
constexpr size_t WS_MOD = 1 * MiB;
constexpr size_t WS_WIDX = 3 * MiB;
constexpr size_t WS_RS = 3 * MiB + 512 * 1024;
constexpr size_t WS_H8IN = 148 * MiB;
constexpr size_t WS_KIDX = 4 * MiB;
constexpr size_t WS_CKV = 8 * MiB;
constexpr size_t WS_CKVT = 16 * MiB;
constexpr size_t WS_V1ST = 24 * MiB;
constexpr size_t WS_WTS = 56 * MiB;
constexpr size_t WT_IN = WS_WTS, WT_Q = WT_IN + (size_t)NIN * DM * 2, WT_LORA = WT_Q + (size_t)NQ * 256 * 2, WT_OUT = WT_LORA + (size_t)NLORA * KLORA * 2,
                 WT_VUP = WT_OUT + (size_t)DM * KOUT * 2  , WT_FC = WT_OUT + (size_t)DM * 1536 * 2, WT_DOWN = WT_FC + (size_t)NFC * DM * 2, WT_END = WT_DOWN + (size_t)DM * DFF * 2;
static_assert(WT_END <= 84 * MiB, "weights region");
constexpr size_t WS_H = 84 * MiB;
constexpr size_t WS_CQ = 148 * MiB;
constexpr size_t WS_ALORA = 164 * MiB;
constexpr size_t WS_AOUT = 84 * MiB;
constexpr size_t WS_RKV = 188 * MiB;
constexpr size_t WS_COLSA = 284 * MiB;
constexpr size_t WS_LORAO = 284 * MiB;
constexpr size_t WS_X16 = 412 * MiB;
constexpr size_t WS_Y = 188 * MiB;
constexpr size_t WS_HID = 188 * MiB;
constexpr size_t WS_Y2 = 84 * MiB;
constexpr size_t WS_MASK = 476 * MiB;
constexpr size_t WS_WTS2 = 484 * MiB;
constexpr size_t WS_NEED = 484 * MiB + (84 - 56) * MiB;
DI size_t wofs(int l) { return (l & 1) ? (WS_WTS2 - WS_WTS) : 0; }

constexpr int LDS_BYTES = 147456;
constexpr int LDS_MISC = LDS_BYTES - 256;
constexpr int NTHR = 512;

DI unsigned pkh(float a, float b) { h16x2 v; v.x = (h16)a; v.y = (h16)b; return __builtin_bit_cast(unsigned, v); }
DI unsigned pkb(float lo, float hi) { unsigned r; asm("v_cvt_pk_bf16_f32 %0, %1, %2" : "=v"(r) : "v"(lo), "v"(hi)); return r; }
DI float hlo(unsigned u) { h16x2 v = __builtin_bit_cast(h16x2, u); return (float)v.x; }
DI float hhi(unsigned u) { h16x2 v = __builtin_bit_cast(h16x2, u); return (float)v.y; }
DI float h2f(unsigned short s) { return (float)__builtin_bit_cast(h16, s); }
DI unsigned short f2h(float f) { return __builtin_bit_cast(unsigned short, (h16)f); }
template <int CTRL> DI float dppf(float x) { return __builtin_bit_cast(float, __builtin_amdgcn_update_dpp(0, __builtin_bit_cast(int, x), CTRL, 0xf, 0xf, false)); }
template <int CTRL> DI unsigned dppu(unsigned x) { return (unsigned)__builtin_amdgcn_update_dpp(0, (int)x, CTRL, 0xf, 0xf, false); }
template <int CTRL, int RM> DI unsigned dppu_rm(unsigned x) { return (unsigned)__builtin_amdgcn_update_dpp(0, (int)x, CTRL, RM, 0xf, false); }
DI unsigned umax_(unsigned a, unsigned b) { return a > b ? a : b; }
DI unsigned max64u(unsigned x) {
    x = umax_(x, dppu<0xB1>(x)); x = umax_(x, dppu<0x4E>(x)); x = umax_(x, dppu<0x141>(x)); x = umax_(x, dppu<0x140>(x));
    x = umax_(x, dppu_rm<0x142, 0xA>(x)); x = umax_(x, dppu_rm<0x143, 0xC>(x)); return (unsigned)__builtin_amdgcn_readlane((int)x, 63);
}
DI float sum4(float x) { x += dppf<0xB1>(x); x += dppf<0x4E>(x); return x; }
DI float sum8(float x) { x = sum4(x); x += dppf<0x141>(x); return x; }
DI float sum16(float x) { x = sum8(x); x += dppf<0x140>(x); return x; }
DI unsigned usum16(unsigned x) { x += dppu<0xB1>(x); x += dppu<0x4E>(x); x += dppu<0x141>(x); x += dppu<0x140>(x); return x; }
DI float sum64(float x) { x = sum16(x); x += __shfl_xor(x, 16); x += __shfl_xor(x, 32); return x; }
DI int lane_id() { int l; asm volatile("v_mbcnt_lo_u32_b32 %0, -1, 0\n\tv_mbcnt_hi_u32_b32 %0, -1, %0" : "=v"(l)); return l; }
DI float sigmoidf_(float z) { return __builtin_amdgcn_rcpf(1.0f + __expf(-z)); }
DI float tanhf_(float z) { return 1.0f - 2.0f * __builtin_amdgcn_rcpf(1.0f + __expf(2.0f * z)); }

#define XB_TMO      128
#define XB_XCNT(j)  (256  + 64 * (j))
#define XB_XSUB(j)  (1280 + 64 * (j))
#define XB_XGEN(j)  (2304 + 64 * (j))
#define XB_TOP      3328
#define XB_TOPGEN   3392
#define XCD_BAR_WORDS 3456
#define XB_SPIN_CAP (1u << 18)
DI unsigned xb_ld(unsigned* p)              { return __hip_atomic_load(p, __ATOMIC_RELAXED, __HIP_MEMORY_SCOPE_AGENT); }
DI unsigned xb_add(unsigned* p, unsigned v) { return __hip_atomic_fetch_add(p, v, __ATOMIC_RELAXED, __HIP_MEMORY_SCOPE_AGENT); }
DI unsigned xb_xcc_id() { return (unsigned)__builtin_amdgcn_s_getreg((3 << 11) | 20) & 0xFu; }
#define XB_SPIN(cond, bar) do { unsigned _sp = 0; while (cond) { __builtin_amdgcn_s_sleep(1); \
    if ((++_sp & 255u) == 0u) { if (xb_ld(&(bar)[XB_TMO])) break; if (_sp > XB_SPIN_CAP) { atomicAdd(&(bar)[XB_TMO], 1u); break; } } } } while (0)
struct XcdBarrier { unsigned* bar; unsigned x; volatile LAS unsigned* st; };
DI XcdBarrier xcd_barrier_post(unsigned* bar, volatile LAS unsigned* st, int wave) {
    XcdBarrier b; b.bar = bar; b.x = xb_xcc_id(); b.st = st;
    if (wave == 0 && lane_id() == 0) (void)xb_add(&bar[XB_XCNT(b.x)], 1u);
    return b;
}
DI void xcd_barrier_complete(unsigned* bar, unsigned x, unsigned& nloc, unsigned& nx) {
    const unsigned G = gridDim.x * gridDim.y * gridDim.z;
    unsigned sum, cnt, mine, sp = 0u;
    for (;;) {
        sum = 0u; cnt = 0u; mine = 0u;
#pragma unroll
        for (unsigned j = 0; j < 16; ++j) { const unsigned c = xb_ld(&bar[XB_XCNT(j)]); sum += c; cnt += (c > 0u) ? 1u : 0u; mine = (j == x) ? c : mine; }
        if (sum == G) break;
        __builtin_amdgcn_s_sleep(1);
        if ((++sp & 255u) == 0u) { if (xb_ld(&bar[XB_TMO])) break; if (sp > XB_SPIN_CAP) { atomicAdd(&bar[XB_TMO], 1u); break; } }
    }
    nloc = mine > 0u ? mine : 1u; nx = cnt > 0u ? cnt : 1u;
}
DI void xcd_barrier(const XcdBarrier& b, int wave) {
    asm volatile("s_waitcnt vmcnt(0)" ::: "memory");
    __syncthreads();
    if (wave == 0 && lane_id() == 0) {
        unsigned* bar = b.bar;
        __builtin_amdgcn_s_waitcnt(0);
        unsigned nloc = b.st[0], nx = b.st[1];
        if (nloc == 0u) { xcd_barrier_complete(bar, b.x, nloc, nx); b.st[0] = nloc; b.st[1] = nx; }
        const unsigned old = xb_add(&bar[XB_XSUB(b.x)], 1u);
        const unsigned gen = old / nloc;
        if (old + 1u == (gen + 1u) * nloc) {
            __builtin_amdgcn_fence(__ATOMIC_RELEASE, "agent");
            asm volatile("s_waitcnt vmcnt(0)" ::: "memory");
            const unsigned og = xb_add(&bar[XB_TOP], 1u);
            const unsigned tg = og / nx;
            if (og + 1u == (tg + 1u) * nx) xb_add(&bar[XB_TOPGEN], 1u);
            else XB_SPIN(xb_ld(&bar[XB_TOPGEN]) == tg, bar);
            __builtin_amdgcn_fence(__ATOMIC_ACQUIRE, "agent");
            xb_add(&bar[XB_XGEN(b.x)], 1u);
            asm volatile("s_waitcnt vmcnt(0)" ::: "memory");
        } else {
            XB_SPIN(xb_ld(&bar[XB_XGEN(b.x)]) == gen, bar);
            __builtin_amdgcn_fence(__ATOMIC_ACQUIRE, "agent");
            asm volatile("s_waitcnt vmcnt(0)" ::: "memory");
        }
    }
    __syncthreads();
}

namespace pg8 {
constexpr int BM = 256, BK = 64, HALF = 128, HTB = HALF * BK * 2, STAGE_BYTES = 8 * HTB, NXCD = 8, WGM = 8;
DI int lds_byte(int r, int c) { const int st = (r >> 4) * 2 + (c >> 5), rr = r & 15, cc = c & 31, ob = rr * 64 + cc * 2; return st * 1024 + (ob ^ (((ob >> 9) & 1) << 5)); }
DI void stage_rc(int b, int& R, int& C) { const int st = b / 1024, sb = b % 1024, swz = sb ^ (((sb >> 9) & 1) << 5); R = (st >> 1) * 16 + swz / 64; C = (st & 1) * 32 + (swz % 64) / 2; }
DI int perm32(int rho) { const int n = rho >> 4, i = rho & 15; return 8 * (i >> 2) + 4 * n + (i & 3); }
struct Unit { int pm, pn; };
struct Gemm { const h16* A; const h16* Bt; int M, N, K, lda, ldb; };
struct StaticOrder {
    int nM, nN, nwg, G, c;
    DI void init(int M, int N, int G_, int c_) { nM = M / BM; nN = N / BM; nwg = nM * nN; G = G_; c = c_; }
    DI bool next(int i, Unit& u) const {
        const long L = (long)i * G + c; if (L >= nwg) return false;
        int wgid = (int)L; { const int q = nwg / NXCD, r = nwg % NXCD, xcd = wgid % NXCD, off = wgid / NXCD; wgid = (xcd < r ? xcd * (q + 1) : r * (q + 1) + (xcd - r) * q) + off; }
        const int nig = WGM * nN, gid = wgid / nig, fm = gid * WGM, gsz = (nM - fm) < WGM ? (nM - fm) : WGM;
        u.pm = fm + ((wgid % nig) % gsz); u.pn = (wgid % nig) / gsz; return true;
    }
};
struct EpiF32 {
    static constexpr bool PERM = false; typedef f32x4 acc_t;
    float* C; int ldc;
    DI void operator()(const f32x4 (&acc)[2][2][4][2], const Unit& u, int wr, int wc, int fr, int fq) const {
        const int row0 = u.pm * BM + wr * 64 + fr, col0 = u.pn * BM + wc * 32 + 4 * fq;
#pragma unroll
        for (int ai = 0; ai < 2; ++ai)
#pragma unroll
            for (int m = 0; m < 4; ++m) { float* rowp = C + (size_t)(row0 + ai * HALF + m * 16) * ldc + col0;
#pragma unroll
                for (int bj = 0; bj < 2; ++bj)
#pragma unroll
                    for (int n = 0; n < 2; ++n) *(f32x4*)(rowp + bj * HALF + n * 16) = acc[ai][bj][m][n]; }
    }
};
struct EpiH16 {
    static constexpr bool PERM = true; typedef f32x4 acc_t;
    h16* O0; int ld0; int nsplit; h16* O1; int ld1;
    DI void operator()(const f32x4 (&acc)[2][2][4][2], const Unit& u, int wr, int wc, int fr, int fq) const {
        const int row0 = u.pm * BM + wr * 64 + fr;
        h16* base; int ld, colt;
        if (u.pn < nsplit) { base = O0; ld = ld0; colt = u.pn * BM; } else { base = O1; ld = ld1; colt = (u.pn - nsplit) * BM; }
        const int col0 = colt + wc * 32 + 8 * fq;
#pragma unroll
        for (int ai = 0; ai < 2; ++ai)
#pragma unroll
            for (int m = 0; m < 4; ++m) { h16* rowp = base + (size_t)(row0 + ai * HALF + m * 16) * ld + col0;
#pragma unroll
                for (int bj = 0; bj < 2; ++bj) { const f32x4 v0 = acc[ai][bj][m][0], v1 = acc[ai][bj][m][1];
                    u32x4 w; w.x = pkh(v0[0], v0[1]); w.y = pkh(v0[2], v0[3]); w.z = pkh(v1[0], v1[1]); w.w = pkh(v1[2], v1[3]);
                    *(u32x4*)(rowp + bj * HALF) = w; } }
    }
};
struct EpiH16I8 {
    static constexpr bool PERM = true; typedef i32x4 acc_t;
    h16* O0; int ld0; int nsplit; h16* O1; int ld1; const float* rs; float wsc;
    DI void operator()(const i32x4 (&acc)[2][2][4][2], const Unit& u, int wr, int wc, int fr, int fq) const {
        const int row0 = u.pm * BM + wr * 64 + fr;
        h16* base; int ld, colt;
        if (u.pn < nsplit) { base = O0; ld = ld0; colt = u.pn * BM; } else { base = O1; ld = ld1; colt = (u.pn - nsplit) * BM; }
        const int col0 = colt + wc * 32 + 8 * fq;
#pragma unroll
        for (int ai = 0; ai < 2; ++ai)
#pragma unroll
            for (int m = 0; m < 4; ++m) { const int row = row0 + ai * HALF + m * 16; h16* rowp = base + (size_t)row * ld + col0; const float sc = rs[row] * wsc;
#pragma unroll
                for (int bj = 0; bj < 2; ++bj) { const i32x4 v0 = acc[ai][bj][m][0], v1 = acc[ai][bj][m][1];
                    u32x4 w; w.x = pkh((float)v0[0] * sc, (float)v0[1] * sc); w.y = pkh((float)v0[2] * sc, (float)v0[3] * sc); w.z = pkh((float)v1[0] * sc, (float)v1[1] * sc); w.w = pkh((float)v1[2] * sc, (float)v1[3] * sc);
                    *(u32x4*)(rowp + bj * HALF) = w; } }
    }
};
struct EpiQ {
    static constexpr bool PERM = true; typedef f32x4 acc_t;
    h16* O;
    DI void operator()(const f32x4 (&acc)[2][2][4][2], const Unit& u, int wr, int wc, int fr, int fq) const {
        const int row0 = u.pm * BM + wr * 64 + fr, col0 = u.pn * BM + wc * 32 + 8 * fq; const bool bf = u.pn < 4;
#pragma unroll
        for (int ai = 0; ai < 2; ++ai)
#pragma unroll
            for (int m = 0; m < 4; ++m) { h16* rowp = O + (size_t)(row0 + ai * HALF + m * 16) * NQ + col0;
#pragma unroll
                for (int bj = 0; bj < 2; ++bj) { const f32x4 v0 = acc[ai][bj][m][0], v1 = acc[ai][bj][m][1]; u32x4 w;
                    if (bf) { w.x = pkb(v0[0], v0[1]); w.y = pkb(v0[2], v0[3]); w.z = pkb(v1[0], v1[1]); w.w = pkb(v1[2], v1[3]); }
                    else { w.x = pkh(v0[0], v0[1]); w.y = pkh(v0[2], v0[3]); w.z = pkh(v1[0], v1[1]); w.w = pkh(v1[2], v1[3]); }
                    *(u32x4*)(rowp + bj * HALF) = w; } }
    }
};
struct EpiLora {
    static constexpr bool PERM = true; typedef f32x4 acc_t;
    h16* O; const float* w0; const float* a0; const float* v0; int has_v; int pn_off;
    DI void operator()(const f32x4 (&acc)[2][2][4][2], const Unit& u, int wr, int wc, int fr, int fq) const {
        const int pnt = u.pn + pn_off; const int row0 = u.pm * BM + wr * 64 + fr; const int type = pnt >> 1;
        const int col0 = pnt * BM + wc * 32 + 8 * fq, j0 = (pnt & 1) * BM + wc * 32 + 8 * fq;
        float bias[2][8];
#pragma unroll
        for (int bj = 0; bj < 2; ++bj)
#pragma unroll
            for (int e = 0; e < 8; ++e) { const int j = j0 + bj * HALF + e; bias[bj][e] = type == 0 ? w0[j] : type == 1 ? a0[j] : (type == 3 && has_v) ? v0[j] : 0.f; }
        if (type == 0) body<0>(acc, bias, row0, col0); else if (type == 2) body<2>(acc, bias, row0, col0); else body<1>(acc, bias, row0, col0);
    }
    template <int TYPE> DI void body(const f32x4 (&acc)[2][2][4][2], const float (&bias)[2][8], const int row0, const int col0) const {
#pragma unroll
        for (int ai = 0; ai < 2; ++ai)
#pragma unroll
            for (int m = 0; m < 4; ++m) { h16* rowp = O + (size_t)(row0 + ai * HALF + m * 16) * NLORA + col0;
#pragma unroll
                for (int bj = 0; bj < 2; ++bj) { float v[8];
#pragma unroll
                    for (int e = 0; e < 8; ++e) { const float z = acc[ai][bj][m][e >> 2][e & 3] + bias[bj][e];
                        float o;
                        if (TYPE == 0) { const float ee = 0.6065306597126334f * sigmoidf_(z); o = 1.0f - __expf(-ee); }
                        else if (TYPE == 2) o = z;
                        else o = sigmoidf_(z);
                        v[e] = o; }
                    u32x4 w; w.x = pkh(v[0], v[1]); w.y = pkh(v[2], v[3]); w.z = pkh(v[4], v[5]); w.w = pkh(v[6], v[7]);
                    *(u32x4*)(rowp + bj * HALF) = w; asm volatile("" ::: "memory"); } }
    }
};
struct EpiSwiglu {
    static constexpr bool PERM = true; typedef f32x4 acc_t;
    h16* O;
    DI void operator()(const f32x4 (&acc)[2][2][4][2], const Unit& u, int wr, int wc, int fr, int fq) const {
        const int row0 = u.pm * BM + wr * 64 + fr, col0 = u.pn * HALF + wc * 32 + 8 * fq;
#pragma unroll
        for (int ai = 0; ai < 2; ++ai)
#pragma unroll
            for (int m = 0; m < 4; ++m) { h16* rowp = O + (size_t)(row0 + ai * HALF + m * 16) * DFF + col0; float v[8];
#pragma unroll
                for (int e = 0; e < 8; ++e) { const float g = acc[ai][0][m][e >> 2][e & 3], up = acc[ai][1][m][e >> 2][e & 3]; v[e] = g * sigmoidf_(g) * up; }
                u32x4 w; w.x = pkh(v[0], v[1]); w.y = pkh(v[2], v[3]); w.z = pkh(v[4], v[5]); w.w = pkh(v[6], v[7]);
                *(u32x4*)rowp = w; }
    }
};
struct EpiSwigluI8 {
    static constexpr bool PERM = true; typedef i32x4 acc_t;
    h16* O; const float* rs; float wsc;
    DI void operator()(const i32x4 (&acc)[2][2][4][2], const Unit& u, int wr, int wc, int fr, int fq) const {
        const int row0 = u.pm * BM + wr * 64 + fr, col0 = u.pn * HALF + wc * 32 + 8 * fq;
#pragma unroll
        for (int ai = 0; ai < 2; ++ai)
#pragma unroll
            for (int m = 0; m < 4; ++m) { const int row = row0 + ai * HALF + m * 16; h16* rowp = O + (size_t)row * DFF + col0; float v[8];
                const float sc = rs[row] * wsc;
#pragma unroll
                for (int e = 0; e < 8; ++e) { const float g = (float)acc[ai][0][m][e >> 2][e & 3] * sc, up = (float)acc[ai][1][m][e >> 2][e & 3] * sc; v[e] = g * sigmoidf_(g) * up; }
                u32x4 w; w.x = pkh(v[0], v[1]); w.y = pkh(v[2], v[3]); w.z = pkh(v[4], v[5]); w.w = pkh(v[6], v[7]);
                *(u32x4*)rowp = w; }
    }
};
DI f32x4 mma_(const h16x8 b, const h16x8 a, const f32x4 c) { return __builtin_amdgcn_mfma_f32_16x16x32_f16(b, a, c, 0, 0, 0); }
DI i32x4 mma_(const h16x8 b, const h16x8 a, const i32x4 c) { return __builtin_amdgcn_mfma_i32_16x16x64_i8(__builtin_bit_cast(i32x4, b), __builtin_bit_cast(i32x4, a), c, 0, 0, 0); }

template <class Epi>
DI void gemm_phase(LAS unsigned char* lds, const Gemm g, const StaticOrder& S, const Epi& E, const int wid) {
    const int lane = lane_id(), tid = wid * 64 + lane, wr = wid >> 2, wc = wid & 3, fr = lane & 15, fq = lane >> 4;
    const int K = g.K, nt = K / BK;
    unsigned voffA[2], voffB[2];
#pragma unroll
    for (int i = 0; i < 2; ++i) { int R, C; stage_rc(tid * 16 + i * 8192, R, C); const int Rb = Epi::PERM ? ((R & ~31) + perm32(R & 31)) : R;
        voffA[i] = (unsigned)(R * g.lda + C) * 2u; voffB[i] = (unsigned)(Rb * g.ldb + C) * 2u; }
    const size_t kstep = (size_t)(BK * 2);
    const size_t hstepA = (size_t)HALF * g.lda * 2, hstepB = (size_t)HALF * g.ldb * 2;
    const size_t tstepA = 2 * hstepA, tstepB = 2 * hstepB;
    const unsigned ldsw = (unsigned)wid * 1024u;
    const int aoff = lds_byte(wr * 64 + fr, fq * 8), boff = lds_byte(wc * 32 + fr, fq * 8);
#define PG8_SA(b, h) (((b) * 2 + (h)) * HTB)
#define PG8_SB(b, h) ((4 + (b) * 2 + (h)) * HTB)
#define PG8_STAGE(bufoff, gbase, voff) do { _Pragma("unroll") for (int _i = 0; _i < 2; ++_i) \
        __builtin_amdgcn_global_load_lds((const unsigned*)((const char*)(gbase) + (voff)[_i]), (LAS unsigned*)(lds + (bufoff) + ldsw + _i * 8192), 16, 0, 0); } while (0)
#define PG8_LDA(dst, b, h) do { _Pragma("unroll") for (int m = 0; m < 4; ++m) _Pragma("unroll") for (int k = 0; k < 2; ++k) dst[m][k] = *(const LAS h16x8*)(lds + PG8_SA(b, h) + aoff + m * 2048 + k * 1024); } while (0)
#define PG8_LDB(dst, b, h) do { _Pragma("unroll") for (int n = 0; n < 2; ++n) _Pragma("unroll") for (int k = 0; k < 2; ++k) dst[n][k] = *(const LAS h16x8*)(lds + PG8_SB(b, h) + boff + n * 2048 + k * 1024); } while (0)
#define PG8_MMA(ai, bj, At, Bt) do { __builtin_amdgcn_s_setprio(1); _Pragma("unroll") for (int m = 0; m < 4; ++m) _Pragma("unroll") for (int n = 0; n < 2; ++n) _Pragma("unroll") for (int k = 0; k < 2; ++k) \
        acc[ai][bj][m][n] = mma_(Bt[n][k], At[m][k], acc[ai][bj][m][n]); __builtin_amdgcn_s_setprio(0); } while (0)
#define PG8_WAIT_V(n) asm volatile("s_waitcnt vmcnt(" #n ")" ::: "memory")
#define PG8_WAIT_L(n) asm volatile("s_waitcnt lgkmcnt(" #n ")" ::: "memory")
#define PG8_BAR __builtin_amdgcn_s_barrier()
#define PG8_SCHED __builtin_amdgcn_sched_barrier(0)
    Unit cur, nxt; int ui = 0;
    if (!S.next(0, cur)) return;
    typedef typename Epi::acc_t acc_t;
    acc_t acc[2][2][4][2];
#pragma unroll
    for (int a = 0; a < 2; ++a)
#pragma unroll
        for (int b = 0; b < 2; ++b)
#pragma unroll
            for (int m = 0; m < 4; ++m)
#pragma unroll
                for (int n = 0; n < 2; ++n) acc[a][b][m][n] = acc_t{};
    h16x8 At[4][2], B0[2][2], B1[2][2];
    const char* cA = (const char*)g.A + (size_t)cur.pm * tstepA; const char* cB = (const char*)g.Bt + (size_t)cur.pn * tstepB;
    PG8_STAGE(PG8_SB(0, 0), cB, voffB); PG8_STAGE(PG8_SB(0, 1), cB + hstepB, voffB); PG8_STAGE(PG8_SA(0, 0), cA, voffA); PG8_STAGE(PG8_SA(0, 1), cA + hstepA, voffA);
    if (wr == 1) PG8_BAR;
    PG8_WAIT_V(2); PG8_BAR;
    PG8_STAGE(PG8_SB(1, 0), cB + kstep, voffB); PG8_STAGE(PG8_SA(1, 0), cA + kstep, voffA); PG8_STAGE(PG8_SB(1, 1), cB + hstepB + kstep, voffB);
    PG8_WAIT_V(6); PG8_BAR;
    for (;;) {
        const bool has_next = S.next(ui + 1, nxt);
        const char* nA = has_next ? (const char*)g.A + (size_t)nxt.pm * tstepA : cA; const char* nB = has_next ? (const char*)g.Bt + (size_t)nxt.pn * tstepB : cB;
        for (int t = 0; t < nt; t += 2) {
            const bool last = (t == nt - 2);
            const char* a1 = cA + (size_t)(t + 1) * kstep;
            const char* a2 = last ? nA : cA + (size_t)(t + 2) * kstep; const char* b2 = last ? nB : cB + (size_t)(t + 2) * kstep;
            const char* a3 = a2 + kstep; const char* b3 = b2 + kstep;
            PG8_LDB(B0, 0, 0); PG8_LDB(B1, 0, 1); PG8_SCHED; PG8_LDA(At, 0, 0); PG8_STAGE(PG8_SA(1, 1), a1 + hstepA, voffA);
            PG8_WAIT_V(8); PG8_WAIT_L(0); PG8_BAR; PG8_MMA(0, 0, At, B0); PG8_MMA(0, 1, At, B1); PG8_BAR; PG8_SCHED;
            PG8_LDA(At, 0, 1); PG8_STAGE(PG8_SB(0, 0), b2, voffB); PG8_STAGE(PG8_SB(0, 1), b2 + hstepB, voffB); PG8_STAGE(PG8_SA(0, 0), a2, voffA);
            PG8_WAIT_V(8); PG8_WAIT_L(0); PG8_BAR; PG8_MMA(1, 0, At, B0); PG8_MMA(1, 1, At, B1); PG8_BAR; PG8_SCHED;
            PG8_LDB(B0, 1, 0); PG8_LDB(B1, 1, 1); PG8_SCHED; PG8_LDA(At, 1, 0); PG8_STAGE(PG8_SA(0, 1), a2 + hstepA, voffA);
            PG8_WAIT_V(8); PG8_WAIT_L(0); PG8_BAR; PG8_MMA(0, 0, At, B0); PG8_MMA(0, 1, At, B1); PG8_BAR; PG8_SCHED;
            PG8_LDA(At, 1, 1); PG8_STAGE(PG8_SB(1, 0), b3, voffB); PG8_STAGE(PG8_SB(1, 1), b3 + hstepB, voffB); PG8_STAGE(PG8_SA(1, 0), a3, voffA);
            PG8_WAIT_V(8); PG8_WAIT_L(0); PG8_BAR; PG8_MMA(1, 0, At, B0); PG8_MMA(1, 1, At, B1); PG8_BAR; PG8_SCHED;
        }
        if (wr == 0) PG8_BAR;
        { const int l2 = lane_id(); E(acc, cur, wr, wc, l2 & 15, l2 >> 4); }
        if (!has_next) break;
#pragma unroll
        for (int a = 0; a < 2; ++a)
#pragma unroll
            for (int b = 0; b < 2; ++b)
#pragma unroll
                for (int m = 0; m < 4; ++m)
#pragma unroll
                    for (int n = 0; n < 2; ++n) acc[a][b][m][n] = acc_t{};
        cur = nxt; cA = nA; cB = nB; ++ui;
        if (wr == 1) PG8_BAR;
    }
    PG8_WAIT_V(0);
    PG8_BAR;
#undef PG8_SA
#undef PG8_SB
#undef PG8_STAGE
#undef PG8_LDA
#undef PG8_LDB
#undef PG8_MMA
#undef PG8_WAIT_V
#undef PG8_WAIT_L
#undef PG8_BAR
#undef PG8_SCHED
}
}

struct Params {
    const float* in[35];
    float* out;
    unsigned char* ws;
    int step_lo, step_hi;
};
enum { I_X = 0, I_C, I_ADAW, I_ADAB, I_PREMIX, I_POSTMIX, I_PREFFN, I_POSTFFN, I_WIN, I_WINV, I_MU, I_MUV, I_WOUT, I_QNG, I_KVNG, I_WQUP, I_WQIUP, I_WKUP, I_WVUP,
       I_KLNG, I_KLNB, I_W0, I_W2, I_A0, I_A2, I_G2, I_V0, I_V2, I_KK, I_KA, I_RK, I_LNXG, I_LNXB, I_WFC, I_WDOWN };

template <int OFF> DI unsigned long long ka_load64() {
    unsigned long long v;
    asm volatile("s_load_dwordx2 %0, %1, %2\n\ts_waitcnt lgkmcnt(0)" : "=s"(v) : "s"(__builtin_amdgcn_kernarg_segment_ptr()), "n"(OFF));
    return v;
}
#define GAS __attribute__((address_space(1)))
template <int I> DI const float* kin() { return (const float*)(const GAS float*)ka_load64<8 * I>(); }
DI float* kout() { return (float*)(GAS float*)ka_load64<8 * 35>(); }
DI unsigned char* kws() { return (unsigned char*)(GAS unsigned char*)ka_load64<8 * 36>(); }

struct Ctx {
    LAS unsigned char* lds;
    int wave, gw, ngw, G;
};

DI void phase_mod(const Params& p, const Ctx& c) {
    const int lane = lane_id(), tid = c.wave * 64 + lane; (void)tid;
    unsigned char* const ws = kws();
    LAS float* cond = (LAS float*)c.lds;
    LAS float* red = (LAS float*)(c.lds + 65536);
    const float* cin = kin<I_C>();
    for (int i = tid; i < 16384; i += NTHR) { const int b = i & 15, k = i >> 4; const float cv = cin[b * 1024 + k]; cond[k * 16 + b] = cv * sigmoidf_(cv); }
    __syncthreads();
    float* MOD = (float*)(ws + WS_MOD);
    for (int item = blockIdx.x; item < 384; item += c.G) {
        const int l = item / 96, n0 = (item % 96) * 64;
        const float* W = kin<I_ADAW>() + (size_t)l * 1024 * 6144 + n0 + lane;
        float acc[16];
#pragma unroll
        for (int b = 0; b < 16; ++b) acc[b] = 0.f;
        const int k0 = c.wave * 128;
#pragma unroll 8
        for (int k = k0; k < k0 + 128; ++k) {
            const float wv = W[(size_t)k * 6144];
            const LAS f32x4* cb = (const LAS f32x4*)(cond + k * 16);
            const f32x4 c0 = cb[0], c1 = cb[1], c2 = cb[2], c3 = cb[3];
            acc[0] += c0[0] * wv; acc[1] += c0[1] * wv; acc[2] += c0[2] * wv; acc[3] += c0[3] * wv;
            acc[4] += c1[0] * wv; acc[5] += c1[1] * wv; acc[6] += c1[2] * wv; acc[7] += c1[3] * wv;
            acc[8] += c2[0] * wv; acc[9] += c2[1] * wv; acc[10] += c2[2] * wv; acc[11] += c2[3] * wv;
            acc[12] += c3[0] * wv; acc[13] += c3[1] * wv; acc[14] += c3[2] * wv; acc[15] += c3[3] * wv;
        }
#pragma unroll
        for (int b = 0; b < 16; ++b) red[(c.wave * 16 + b) * 64 + lane] = acc[b];
        __syncthreads();
        for (int idx = tid; idx < 1024; idx += NTHR) { const int b = idx >> 6, n = idx & 63; float s = kin<I_ADAB>()[l * 6144 + n0 + n];
#pragma unroll
            for (int w = 0; w < 8; ++w) s += red[(w * 16 + b) * 64 + n];
            MOD[(size_t)(l * 16 + b) * 6144 + n0 + n] = s; }
        __syncthreads();
    }
}

DI void tr_item(const float* src, int ldsrc, h16* dst, int ldd, LAS float* scr, int lane, bool zero) {
#pragma unroll
    for (int hb = 0; hb < 2; ++hb) { float tv[16];
#pragma unroll
        for (int i = 0; i < 16; ++i) { const int kk = 2 * (16 * hb + i) + (lane >> 5); tv[i] = zero ? 0.f : src[(size_t)kk * ldsrc + (lane & 31)]; }
#pragma unroll
        for (int i = 0; i < 16; ++i) { const int kk = 2 * (16 * hb + i) + (lane >> 5); scr[kk * 33 + (lane & 31)] = tv[i]; } }
    asm volatile("s_waitcnt lgkmcnt(0)" ::: "memory");
    const int cc = lane & 7;
#pragma unroll
    for (int j = 0; j < 4; ++j) { const int n = (lane >> 3) + 8 * j; const LAS float* s = scr + (8 * cc) * 33 + n;
        u32x4 o; o.x = pkh(s[0 * 33], s[1 * 33]); o.y = pkh(s[2 * 33], s[3 * 33]); o.z = pkh(s[4 * 33], s[5 * 33]); o.w = pkh(s[6 * 33], s[7 * 33]);
        *(u32x4*)(dst + (size_t)n * ldd + 8 * cc) = o; }
    asm volatile("s_waitcnt lgkmcnt(0)" ::: "memory");
}
DI void tr_item_q8(const float* src, int ldsrc, unsigned char* dst, int ldd, LAS float* scr, int lane, const float qs) {
#pragma unroll
    for (int hb = 0; hb < 2; ++hb) { float tv[16];
#pragma unroll
        for (int i = 0; i < 16; ++i) { const int kk = 2 * (16 * hb + i) + (lane >> 5); tv[i] = src[(size_t)kk * ldsrc + (lane & 31)]; }
#pragma unroll
        for (int i = 0; i < 16; ++i) { const int kk = 2 * (16 * hb + i) + (lane >> 5); scr[kk * 33 + (lane & 31)] = tv[i]; } }
    asm volatile("s_waitcnt lgkmcnt(0)" ::: "memory");
    const int n = lane >> 1, kh = lane & 1; const LAS float* sp = scr + (32 * kh) * 33 + n;
#pragma unroll
    for (int g = 0; g < 2; ++g) { unsigned o[4];
#pragma unroll
        for (int w4 = 0; w4 < 4; ++w4) { unsigned bq[4];
#pragma unroll
            for (int e = 0; e < 4; ++e) bq[e] = __builtin_bit_cast(unsigned, fminf(fmaxf(sp[(16 * g + 4 * w4 + e) * 33] * qs, -127.0f), 127.0f) + 12582912.0f);
            o[w4] = __builtin_amdgcn_perm(bq[1], bq[0], 0x0c0c0400u) | __builtin_amdgcn_perm(bq[3], bq[2], 0x04000c0cu); }
        u32x4 ov; ov.x = o[0]; ov.y = o[1]; ov.z = o[2]; ov.w = o[3];
        *(u32x4*)(dst + (size_t)n * ldd + 32 * kh + 16 * g) = ov; }
    asm volatile("s_waitcnt lgkmcnt(0)" ::: "memory");
}
DI unsigned* wmax_word(unsigned char* ws, int l, int which) { return (unsigned*)(ws + WS_CTL) + 8192 + 64 * l + 32 + which; }
DI float absmax4(float am, const f32x4 v) { return fmaxf(fmaxf(am, fmaxf(__builtin_fabsf(v[0]), __builtin_fabsf(v[1]))), fmaxf(__builtin_fabsf(v[2]), __builtin_fabsf(v[3]))); }
DI void phase_wmax(const Params& p, const Ctx& c, int l) {
    const int lane = lane_id();
    { const f32x4* w = (const f32x4*)(kin<I_WFC>() + (size_t)l * DM * NFC); float am = 0.f;
#pragma unroll 8
      for (int i = c.gw * 64 + lane; i < DM * NFC / 4; i += c.ngw * 64) am = absmax4(am, w[i]);
      const unsigned mx = max64u(__builtin_bit_cast(unsigned, am));
      if (lane == 0) __hip_atomic_fetch_max(wmax_word(kws(), l, 0), mx, __ATOMIC_RELAXED, __HIP_MEMORY_SCOPE_AGENT); }
    { const f32x4* w = (const f32x4*)(kin<I_WIN>() + (size_t)l * DM * PIN); float am = 0.f;
#pragma unroll 8
      for (int i = c.gw * 64 + lane; i < DM * PIN / 4; i += c.ngw * 64) am = absmax4(am, w[i]);
      if (l > 0) { const f32x4* wv = (const f32x4*)(kin<I_WINV>() + (size_t)(l - 1) * DM * 32);
          for (int i = c.gw * 64 + lane; i < DM * 32 / 4; i += c.ngw * 64) am = absmax4(am, wv[i]); }
      const unsigned mx = max64u(__builtin_bit_cast(unsigned, am));
      if (lane == 0) __hip_atomic_fetch_max(wmax_word(kws(), l, 1), mx, __ATOMIC_RELAXED, __HIP_MEMORY_SCOPE_AGENT); }
}
DI float wmax_load(unsigned char* ws, int l, int which) { return fmaxf(__builtin_bit_cast(float, __hip_atomic_load(wmax_word(ws, l, which), __ATOMIC_RELAXED, __HIP_MEMORY_SCOPE_AGENT)), 1e-30f); }
DI void phase_wconv(const Params& p, const Ctx& c, int l, const int it_lo, const int it_hi, const bool do_elem) {
    const int lane = lane_id(), tid = c.wave * 64 + lane; (void)tid;
    unsigned char* const ws = kws();
    LAS float* scr = (LAS float*)(c.lds + c.wave * 16384);
    unsigned char* const wb = ws + wofs(l);
    h16* Win = (h16*)(wb + WT_IN); h16* Wq = (h16*)(wb + WT_Q); h16* Wlo = (h16*)(wb + WT_LORA); h16* Wout = (h16*)(wb + WT_OUT); h16* Wfc = (h16*)(wb + WT_FC); h16* Wdn = (h16*)(wb + WT_DOWN);
    const float* w_in = kin<I_WIN>() + (size_t)l * DM * PIN;
    const float* w_vr = kin<I_WINV>() + (size_t)(l > 0 ? l - 1 : 0) * DM * 32;
    const float* w_fc = kin<I_WFC>() + (size_t)l * DM * NFC;
    const float* w_dn = kin<I_WDOWN>() + (size_t)l * DFF * DM;
    const float* w_out = kin<I_WOUT>() + (size_t)l * 1024 * DM;
    constexpr int IT_IN = 16 * (NIN / 32), IT_FC = 16 * (NFC / 32), IT_DN = (DFF / 64) * (DM / 32), IT_O2 = 16 * (DM / 32);
    float qs = 0.f, qsi = 0.f;
    if (it_hi > WC_NOQ) { qs = 127.0f * __builtin_amdgcn_rcpf(wmax_load(ws, l, 0)); qsi = 127.0f * __builtin_amdgcn_rcpf(wmax_load(ws, l, 1)); }
#pragma unroll 1
    for (int it = it_lo + c.gw; it < it_hi; it += c.ngw) {
        int r = it; const float* src; int ld; h16* d16 = nullptr; unsigned char* d8 = nullptr; int ldd; bool zero = false; float q = 0.f;
        if (r < IT_DN) { const int nb = r % (DM / 32), kb = r / (DM / 32), nd = nb * 32, k0 = kb * 64;
            src = w_dn + (size_t)k0 * DM + nd; ld = DM; d16 = Wdn + (size_t)nd * DFF + k0; ldd = DFF; }
        else if ((r -= IT_DN) < IT_O2) { const int nb = r % (DM / 32), kb = r / (DM / 32), nd = nb * 32, k0 = kb * 64;
            src = w_out + (size_t)k0 * DM + nd; ld = DM; d16 = Wout + (size_t)nd * KOUT + k0; ldd = KOUT; }
        else if ((r -= IT_O2) < IT_IN) { const int nb = r % (NIN / 32), kb = r / (NIN / 32), nd = nb * 32, k0 = kb * 64;
            int sc; const float* sp = w_in; ld = PIN;
            if (nd < 448) sc = nd;
            else if (nd < 736) sc = 1988 + (nd - 448);
            else if (nd < 768) { if (l > 0) { sp = w_vr; ld = 32; sc = 0; } else { zero = true; sc = 0; } }
            else sc = 452 + (nd - 768);
            src = sp + (size_t)k0 * ld + sc; ldd = DM;
            if (nd < NIN16) d16 = Win + (size_t)nd * DM + k0; else { d8 = (unsigned char*)(Win + (size_t)NIN16 * DM) + (size_t)(nd - NIN16) * DM + k0; q = zero ? 0.f : qsi; } }
        else { r -= IT_IN; const int nb = r % (NFC / 32), kb = r / (NFC / 32), nd = nb * 32, k0 = kb * 64;
            const int pn = nd >> 8, i = nd & 255; const int sc = (i < 128) ? (128 * pn + i) : (DFF + 128 * pn + (i - 128));
            src = w_fc + (size_t)k0 * NFC + sc; ld = NFC; d8 = (unsigned char*)Wfc + (size_t)nd * DM + k0; ldd = DM; q = qs; }
        if (d8) tr_item_q8(src, ld, d8, ldd, scr, lane, q); else tr_item(src, ld, d16, ldd, scr, lane, zero);
    }
    if (!do_elem) return;
    const int gt = c.gw * 64 + lane, ngt = c.ngw * 64;
    const float* wq = kin<I_WQUP>() + (size_t)l * 256 * 512; const float* wk = kin<I_WKUP>() + (size_t)l * 128 * 512; const float* wqi = kin<I_WQIUP>() + (size_t)l * 256 * 256;
    const float* wv = kin<I_WVUP>() + (size_t)l * 128 * 512;
    const float qscl = 0.125f * 1.4426950408889634f;
    for (int it = c.gw; it < 8 * 8 * 4; it += c.ngw) {
        const int h = it >> 5, rb = (it >> 2) & 7, cb = it & 3, cc = cb * 64 + lane;
        f32x4 qv[16];
#pragma unroll
        for (int d4 = 0; d4 < 16; ++d4) qv[d4] = *(const f32x4*)(wq + cc * 512 + h * 64 + 4 * d4);
#pragma unroll 2
        for (int r = 0; r < 16; ++r) { const float* kr = wk + (rb * 16 + r) * 512 + h * 64; float sacc = 0.f;
#pragma unroll
            for (int d4 = 0; d4 < 16; ++d4) { const f32x4 kv = *(const f32x4*)(kr + 4 * d4); sacc += (qv[d4][0] * kv[0] + qv[d4][1] * kv[1]) + (qv[d4][2] * kv[2] + qv[d4][3] * kv[3]); }
            Wq[(size_t)(h * 128 + rb * 16 + r) * 256 + cc] = (h16)(sacc * qscl); }
    }
    for (int idx = gt; idx < 256 * 256; idx += ngt) { const int n = idx >> 8, cc = idx & 255; Wq[(size_t)(1024 + n) * 256 + cc] = (h16)wqi[cc * 256 + n]; }
    const float* w2 = kin<I_W2>() + (size_t)l * 64 * 512; const float* a2 = kin<I_A2>() + (size_t)l * 64 * 512; const float* g2 = kin<I_G2>() + (size_t)l * 160 * 512;
    const float* v2 = kin<I_V2>() + (size_t)(l > 0 ? l - 1 : 0) * 32 * 512;
    for (int idx = gt; idx < 1024 * 128; idx += ngt) {
        const int n = idx >> 7, k = idx & 127, j = n & 511; float o = 0.f;
        if (n < 512) { if (k < 64) o = w2[k * 512 + j]; } else { if (k >= 64) o = a2[(k - 64) * 512 + j]; }
        Wlo[idx] = (h16)o; }
    for (int idx = gt; idx < 1024 * 256; idx += ngt) {
        const int n = idx >> 8, k = idx & 255, j = n & 511; float o = 0.f;
        if (n < 512) { if (k < 160) o = g2[k * 512 + j]; } else { if (l > 0 && k >= 160 && k < 192) o = v2[(k - 160) * 512 + j]; }
        Wlo[1024 * 128 + idx] = (h16)o; }
    { h16* WVt = (h16*)(wb + WT_VUP);
      for (int idx = gt; idx < 8 * 64 * 128; idx += ngt) { const int k = idx & 127, n = (idx >> 7) & 63, h = idx >> 13; WVt[idx] = (h16)wv[k * 512 + h * 64 + n]; } }
}

template <int MODE, bool HAS_NEXT, bool WIDX_, int Q8 = 0>
DI void phase_rows(const Params& p, const Ctx& c, const h16* Y, const float* postg, int gate_off, int mod_l_gate,
                   const float* preg, int sh_off, int sc_off, int mod_l_next, int widx_l) {
    const int lane = lane_id(), tid = c.wave * 64 + lane; (void)tid;
    unsigned char* const ws = kws();
    h16* X = (h16*)(ws + WS_X16); float* OUT = kout(); h16* H = (h16*)(ws + WS_H); const float* MOD = (const float*)(ws + WS_MOD); float* WIDX = (float*)(ws + WS_WIDX);
    for (int rg = c.gw; rg < MT / 16; rg += c.ngw) {
        const int m0 = rg * 16, b = m0 / SEQ;
        f32x4 gp[4], ps[4], shv[4], wi[4][4];
#pragma unroll
        for (int j = 0; j < 4; ++j) { const int col = 4 * lane + 256 * j;
            if (MODE == 1) gp[j] = *(const f32x4*)(MOD + (size_t)(mod_l_gate * 16 + b) * 6144 + gate_off + col) * *(const f32x4*)(postg + col);
            if (HAS_NEXT) { shv[j] = *(const f32x4*)(MOD + (size_t)(mod_l_next * 16 + b) * 6144 + sh_off + col);
                ps[j] = *(const f32x4*)(preg + col) * (*(const f32x4*)(MOD + (size_t)(mod_l_next * 16 + b) * 6144 + sc_off + col) + 1.0f); }
            if (WIDX_) {
#pragma unroll
                for (int e = 0; e < 4; ++e) wi[j][e] = *(const f32x4*)(kin<I_WIN>() + ((size_t)widx_l * DM + col + e) * PIN + 448); }
        }
        for (int rr = 0; rr < 16; ++rr) {
            const size_t m = (size_t)(m0 + rr);
            f32x4 xv[4];
            if (MODE == 0) {
#pragma unroll
                for (int j = 0; j < 4; ++j) xv[j] = *(const f32x4*)(kin<I_X>() + m * DM + 4 * lane + 256 * j);
            } else {
                f32x4 yv[4]; float ss = 0.f;
#pragma unroll
                for (int j = 0; j < 4; ++j) { const u32x2 yr = *(const u32x2*)(Y + m * DM + 4 * lane + 256 * j); yv[j] = (f32x4){hlo(yr.x), hhi(yr.x), hlo(yr.y), hhi(yr.y)}; const u32x2 xr = *(const u32x2*)(X + m * DM + 4 * lane + 256 * j); xv[j] = (f32x4){hlo(xr.x), hhi(xr.x), hlo(xr.y), hhi(xr.y)};
                    ss += (yv[j][0] * yv[j][0] + yv[j][1] * yv[j][1]) + (yv[j][2] * yv[j][2] + yv[j][3] * yv[j][3]); }
                const float rn = rsqrtf(sum64(ss) * (1.0f / DM) + NORM_EPS);
#pragma unroll
                for (int j = 0; j < 4; ++j) xv[j] = xv[j] + (yv[j] * rn) * gp[j];
            }
            if (HAS_NEXT) {
#pragma unroll
                for (int j = 0; j < 4; ++j) { u32x2 w; w.x = pkh(xv[j][0], xv[j][1]); w.y = pkh(xv[j][2], xv[j][3]); *(u32x2*)(X + m * DM + 4 * lane + 256 * j) = w; }
            } else {
#pragma unroll
                for (int j = 0; j < 4; ++j) *(f32x4*)(OUT + m * DM + 4 * lane + 256 * j) = xv[j];
            }
            if (HAS_NEXT) {
                float ss = 0.f;
#pragma unroll
                for (int j = 0; j < 4; ++j) ss += (xv[j][0] * xv[j][0] + xv[j][1] * xv[j][1]) + (xv[j][2] * xv[j][2] + xv[j][3] * xv[j][3]);
                const float rn = rsqrtf(sum64(ss) * (1.0f / DM) + NORM_EPS);
                float d0 = 0.f, d1 = 0.f, d2 = 0.f, d3 = 0.f;
                if (Q8 != 0) {
                    float am = 0.f;
#pragma unroll
                    for (int j = 0; j < 4; ++j) { const f32x4 hq = (xv[j] * rn) * ps[j] + shv[j];
                        am = fmaxf(fmaxf(am, fmaxf(__builtin_fabsf(hq[0]), __builtin_fabsf(hq[1]))), fmaxf(__builtin_fabsf(hq[2]), __builtin_fabsf(hq[3]))); }
                    const float amax = fmaxf(__builtin_bit_cast(float, max64u(__builtin_bit_cast(unsigned, am))), 1e-20f);
                    const float qs = 127.0f * __builtin_amdgcn_rcpf(amax);
                    unsigned char* H8 = (Q8 == 2) ? (unsigned char*)(ws + WS_H8IN) : (unsigned char*)H;
#pragma unroll
                    for (int j = 0; j < 4; ++j) {
                        const f32x4 hq = (xv[j] * rn) * ps[j] + shv[j];
                        unsigned bq[4];
#pragma unroll
                        for (int e = 0; e < 4; ++e) bq[e] = __builtin_bit_cast(unsigned, fminf(fmaxf(hq[e] * qs, -127.0f), 127.0f) + 12582912.0f);
                        const unsigned w = __builtin_amdgcn_perm(bq[1], bq[0], 0x0c0c0400u) | __builtin_amdgcn_perm(bq[3], bq[2], 0x04000c0cu);
                        *(unsigned*)(H8 + m * DM + 4 * lane + 256 * j) = w; }
                    if (lane == 0) ((float*)(ws + WS_RS))[m] = amax * (1.0f / 127.0f);
                }
                if (Q8 != 1)
#pragma unroll
                for (int j = 0; j < 4; ++j) { const f32x4 hv = (xv[j] * rn) * ps[j] + shv[j];
                    u32x2 w; w.x = pkh(hv[0], hv[1]); w.y = pkh(hv[2], hv[3]);
                    if (Q8 != 2) *(u32x2*)(H + m * DM + 4 * lane + 256 * j) = w;
                    if (WIDX_) {
#pragma unroll
                        for (int e = 0; e < 4; ++e) { d0 += hv[e] * wi[j][e][0]; d1 += hv[e] * wi[j][e][1]; d2 += hv[e] * wi[j][e][2]; d3 += hv[e] * wi[j][e][3]; } } }
                if (WIDX_) { d0 = sum64(d0); d1 = sum64(d1); d2 = sum64(d2); d3 = sum64(d3);
                    if (lane == 0) *(f32x4*)(WIDX + m * 4) = (f32x4){d0 * 0.0625f, d1 * 0.0625f, d2 * 0.0625f, d3 * 0.0625f}; }
            }
        }
    }
}

DI void phase_prep(const Params& p, const Ctx& c, int l) {
    unsigned char* const ws = kws();
    const int lane = lane_id();
    const h16* CA = (const h16*)(ws + WS_COLSA);
    h16* CQ = (h16*)(ws + WS_CQ); h16* CKV = (h16*)(ws + WS_CKV); h16* KIDX = (h16*)(ws + WS_KIDX); h16* AL = (h16*)(ws + WS_ALORA);
    const f32x4 qg = *(const f32x4*)(kin<I_QNG>() + l * 256 + 4 * lane);
    const f32x2 kvg = *(const f32x2*)(kin<I_KVNG>() + l * 128 + 2 * lane);
    const float lg = kin<I_KLNG>()[l * 64 + lane], lb = kin<I_KLNB>()[l * 64 + lane];
    float mu[5];
#pragma unroll
    for (int i = 0; i < 5; ++i) { const int j = lane + 64 * i;
        mu[i] = (j < 288) ? kin<I_MU>()[l * 1824 + 1536 + j] : (l > 0 ? kin<I_MUV>()[(l - 1) * 32 + (j - 288)] : 0.f); }
    for (int rg = c.gw; rg < MT / 16; rg += c.ngw) {
        const int m0 = rg * 16, b = m0 / SEQ, t0 = m0 % SEQ;
        float prevv[5];
#pragma unroll
        for (int i = 0; i < 5; ++i) prevv[i] = (t0 > 0) ? (float)CA[(size_t)(m0 - 1) * NCA + 448 + lane + 64 * i] : 0.f;
#pragma unroll
        for (int rr = 0; rr < 16; ++rr) {
            const size_t m = (size_t)(m0 + rr); const h16* row = CA + m * NCA;
            const u32x2 cqr = *(const u32x2*)(row + 4 * lane);
            const unsigned ckr = *(const unsigned*)(row + 256 + 2 * lane);
            const float kir = (float)row[384 + lane];
            float cur[5];
#pragma unroll
            for (int i = 0; i < 5; ++i) cur[i] = (float)row[448 + lane + 64 * i];
            const float q0 = hlo(cqr.x), q1 = hhi(cqr.x), q2 = hlo(cqr.y), q3 = hhi(cqr.y);
            const float rq = rsqrtf(sum64((q0 * q0 + q1 * q1) + (q2 * q2 + q3 * q3)) * (1.0f / 256.0f) + NORM_EPS);
            u32x2 qo; qo.x = pkh(q0 * rq * qg[0], q1 * rq * qg[1]); qo.y = pkh(q2 * rq * qg[2], q3 * rq * qg[3]);
            *(u32x2*)(CQ + m * 256 + 4 * lane) = qo;
            const float k0 = hlo(ckr), k1 = hhi(ckr);
            const float rk = rsqrtf(sum64(k0 * k0 + k1 * k1) * (1.0f / 128.0f) + NORM_EPS);
            const float o0 = k0 * rk * kvg[0], o1 = k1 * rk * kvg[1];
            *(unsigned*)(CKV + m * 128 + 2 * lane) = pkb(o0, o1);
            const float mean = sum64(kir) * (1.0f / 64.0f); const float dv = kir - mean; const float var = sum64(dv * dv) * (1.0f / 64.0f);
            KIDX[m * 64 + lane] = (h16)(dv * rsqrtf(var + NORM_EPS) * lg + lb);
#pragma unroll
            for (int i = 0; i < 5; ++i) { const float sh = cur[i] + (prevv[i] - cur[i]) * mu[i]; prevv[i] = cur[i]; const int j = lane + 64 * i; float o;
                if (i == 0) o = tanhf_(sh); else if (i == 1) o = sh; else if (j < 288) o = sigmoidf_(sh); else o = (l > 0) ? sh : 0.f;
                AL[m * KLORA + j] = (h16)o; }
            AL[m * KLORA + 320 + lane] = (h16)0.f;
        }
    }
}

constexpr int AT_KSTR = 272, AT_VSTR = 144;
constexpr int AT_KB = 64 * AT_KSTR, AT_VB = 128 * AT_VSTR, AT_BUF = AT_KB + AT_VB;
constexpr int AT_MASK = 131072 + 1024;
DI unsigned okey(float s) { const unsigned u = __builtin_bit_cast(unsigned, s); return (u & 0x80000000u) ? ~u : (u | 0x80000000u); }
DI float ikeyf(unsigned k) { return __builtin_bit_cast(float, (k & 0x80000000u) ? (k & 0x7FFFFFFFu) : ~k); }

template <int NRM>
DI void select_query(const LAS float* SCq, unsigned long long* mkq, const int nr, const int lane) {

                        unsigned key[NRM];
                        float sraw[NRM];
#pragma unroll
                        for (int r = 0; r < NRM; ++r) sraw[r] = SCq[64 * (r < nr ? r : 0) + lane];
#pragma unroll
                        for (int r = 0; r < NRM; ++r) key[r] = okey(sraw[r]) & (unsigned)((r - nr) >> 31);
                        auto count_ge = [&](const unsigned cand) -> unsigned { unsigned cnt = 0u;
#pragma unroll
                            for (int r = 0; r < NRM; r += 4) {
                                const unsigned long long m0 = __ballot(key[r] >= cand), m1 = __ballot(key[r + 1] >= cand), m2 = __ballot(key[r + 2] >= cand), m3 = __ballot(key[r + 3] >= cand);
                                cnt += (unsigned)(__popcll(m0) + __popcll(m1)) + (unsigned)(__popcll(m2) + __popcll(m3)); }
                            return cnt; };
                        unsigned thr = 0u; bool exact = false, found = false, neg = false;
                        unsigned klo = 0u, khi = 0u, clo = 0u, chi = 0u;
                        { const unsigned c1 = count_ge(0x80000001u);
                          if (c1 == 256u) { thr = 0x80000001u; exact = true; found = true; }
                          else if (c1 > 256u) { unsigned mx = 0u;
#pragma unroll
                              for (int r = 0; r < NRM; ++r) mx = key[r] > mx ? key[r] : mx;
                              klo = 0x80000001u; clo = c1; khi = max64u(mx) + 1u; chi = 0u; }
                          else { const unsigned c3 = count_ge(0x7FFFFFFFu);
                              if (c3 >= 256u) { found = true;
                                  if (c3 == 256u) { thr = 0x7FFFFFFFu; exact = true; }
                                  else { const unsigned c2 = count_ge(0x80000000u);
                                      if (c2 >= 256u) { thr = 0x80000000u; exact = (c2 == 256u); } else thr = 0x7FFFFFFFu; } }
                              else { unsigned mx = 0u;
#pragma unroll
                                  for (int r = 0; r < NRM; ++r) { const unsigned kc = ~key[r] & (unsigned)((r - nr) >> 31); mx = kc > mx ? kc : mx; }
                                  klo = ~max64u(mx); clo = 64u * (unsigned)nr; khi = 0x7FFFFFFFu; chi = c3; neg = true; } } }
                        if (!found) { float wlo = 1.f, whi = 1.f; int last = 0, it = 0;
#pragma unroll 1
                            for (;;) {
                                if (khi - klo <= 1u) { thr = klo; break; }
                                ++it;
                                const float vlo = ikeyf(klo), vhi = ikeyf(khi);
                                const float a = ((float)clo - 255.5f) * wlo, b = (255.5f - (float)chi) * whi;
                                float frac = a * __builtin_amdgcn_rcpf(a + b);
                                if ((it & 7) == 0) frac = 0.5f;
                                if (it == 1) {
                                    if (!neg) { const float lc = __builtin_amdgcn_logf((float)clo); frac = __builtin_amdgcn_exp2f(0.75f * __builtin_amdgcn_logf((lc - 8.f) * __builtin_amdgcn_rcpf(lc))); }
                                    else { const float lm = __builtin_amdgcn_logf((float)(clo - chi)), lb = __builtin_amdgcn_logf((float)(clo - 256u));
                                           frac = 1.f - __builtin_amdgcn_exp2f(0.8f * __builtin_amdgcn_logf((lm - lb) * __builtin_amdgcn_rcpf(lm))); } }
                                unsigned kp = (unsigned)__builtin_amdgcn_readfirstlane((int)okey(vlo + (vhi - vlo) * frac));
                                if (!(kp > klo && kp < khi)) kp = klo + ((khi - klo) >> 1);
                                const unsigned cn = count_ge(kp);
                                if (cn == 256u) { thr = kp; exact = true; break; }
                                if (cn > 256u) { klo = kp; clo = cn; whi = (last == 1) ? whi * 0.7f : 1.f; wlo = 1.f; last = 1; }
                                else { khi = kp; chi = cn; wlo = (last == -1) ? wlo * 0.7f : 1.f; whi = 1.f; last = -1; }
                            } }
                        unsigned need = 0u;
                        if (!exact) { unsigned cgt = 0u;
#pragma unroll
                            for (int r = 0; r < NRM; ++r) cgt += (unsigned)__popcll(__ballot(key[r] > thr));
                            need = 256u - cgt; }
                        unsigned base = 0u;
                        const unsigned long long lowmask = (1ull << lane) - 1ull;
#pragma unroll
                        for (int r = 0; r < NRM; ++r) {
                            bool sel = key[r] >= thr;
                            if (!exact) { const bool eq = key[r] == thr; const unsigned long long em = __ballot(eq);
                                const unsigned pre = __popcll(em & lowmask); sel = (key[r] > thr) || (eq && (base + pre < need)); base += __popcll(em); }
                            const unsigned long long sm = __ballot(sel);
                            if (lane == 0) mkq[r] = sm;
                        }
                    }

DI void phase_select(const Params& p, const Ctx& c, unsigned* qctr) {
    unsigned char* const ws = kws();
    const h16* QALL = (const h16*)kout(); const h16* KIDX = (const h16*)(ws + WS_KIDX);
    const float* WIDX = (const float*)(ws + WS_WIDX); unsigned long long* MASKG = (unsigned long long*)(ws + WS_MASK);
    const int wave = c.wave;
    LAS unsigned char* lds = c.lds;
    volatile LAS unsigned* qw = (volatile LAS unsigned*)(c.lds + LDS_MISC + 64);
    {
        for (;;) {
            const int lane = lane_id(), tid = wave * 64 + lane;
            if (wave == 0 && lane == 0) *qw = __hip_atomic_fetch_add(qctr, 1u, __ATOMIC_RELAXED, __HIP_MEMORY_SCOPE_AGENT);
            __syncthreads();
            const int unit = (int)*qw;
            __syncthreads();
            if (unit >= 1024) break;
            const int chv = 31 - (unit >> 5), subv = unit & 31;
            const int b = subv >> 1, half = subv & 1;
            const int nadm = 64 * (chv + 1), nkt = chv + 1;
            const int kbase = b * SEQ;
            const int tqu = b * SEQ + chv * 64 + half * 32;
            unsigned long long* mk64 = MASKG + (size_t)tqu * 32;
            if (nadm <= 256) {
                if (lane < 16) mk64[(4 * wave + (lane >> 2)) * 32 + (lane & 3)] = ((lane & 3) < nkt) ? ~0ull : 0ull;
            } else {
                LAS float* SC = (LAS float*)lds;
                const int q4 = lane >> 4, c16 = lane & 15;
#pragma unroll 1
                for (int rnd = 0; rnd < 2; ++rnd) {
                    {
                        h16x8 a0[4], a1[4]; f32x4 wv[4];
#pragma unroll
                        for (int g = 0; g < 4; ++g) { const int tqr = tqu + 16 * rnd + 4 * g;
                            const h16* ap = QALL + (size_t)(tqr + (c16 >> 2)) * NQ + 1024 + (c16 & 3) * 64 + 8 * q4; a0[g] = *(const h16x8*)ap; a1[g] = *(const h16x8*)(ap + 32);
                            wv[g] = *(const f32x4*)(WIDX + (size_t)(tqr + q4) * 4); }
                        const int nt16 = nadm >> 4;
                        const h16* kp = KIDX + (size_t)(kbase + c16) * 64 + 8 * q4;
#pragma unroll 1
                        for (int tb = wave; tb < nt16; tb += 64) {
                            h16x8 b0[8], b1[8];
#pragma unroll
                            for (int u = 0; u < 8; ++u) { int tt = tb + 8 * u; tt = tt < nt16 ? tt : tb; b0[u] = *(const h16x8*)(kp + (size_t)tt * 1024); b1[u] = *(const h16x8*)(kp + (size_t)tt * 1024 + 32); }
#pragma unroll
                            for (int u = 0; u < 8; ++u) { const int tt = tb + 8 * u;
                                if (tt < nt16) {
#pragma unroll
                                    for (int g = 0; g < 4; ++g) { f32x4 acc = (f32x4){0.f, 0.f, 0.f, 0.f};
                                        acc = __builtin_amdgcn_mfma_f32_16x16x32_f16(a0[g], b0[u], acc, 0, 0, 0); acc = __builtin_amdgcn_mfma_f32_16x16x32_f16(a1[g], b1[u], acc, 0, 0, 0);
                                        SC[(4 * g + q4) * 2048 + 16 * tt + c16] = ((fmaxf(acc[0], 0.f) * wv[g][0] + fmaxf(acc[1], 0.f) * wv[g][1]) + fmaxf(acc[2], 0.f) * wv[g][2]) + fmaxf(acc[3], 0.f) * wv[g][3]; }
                                }
                            }
                        }
                    }
                    __syncthreads();
                    const int nr = nadm >> 6;
#pragma unroll 1
                    for (int qi = 0; qi < 2; ++qi) {
                        const int ql = 2 * wave + qi; const LAS float* SCq = SC + ql * 2048; unsigned long long* mkq = mk64 + (16 * rnd + ql) * 32;
                        if (nr <= 8) select_query<8>(SCq, mkq, nr, lane); else if (nr <= 16) select_query<16>(SCq, mkq, nr, lane);
                        else if (nr <= 24) select_query<24>(SCq, mkq, nr, lane); else select_query<32>(SCq, mkq, nr, lane);
                    }
                    __syncthreads();
                }
            }
            __syncthreads();
        }
    }
}

namespace ab {
typedef short bf16x8 __attribute__((ext_vector_type(8)));
typedef short s16x4 __attribute__((ext_vector_type(4)));
constexpr int SHM_V = 64 * 128 * 2, SHM_K = 64 * 128 * 2;
constexpr int LDS_RED = 2 * SHM_V + 2 * SHM_K;
constexpr int LDS_MK = LDS_RED + 8 * 256;
constexpr int LDS_END = LDS_MK + 8 * 8192;
constexpr float THRL = 8.0f;
#define AB_KSWZ(row, colB) ((row) * 256 + ((colB) ^ (((row) & 7) << 4)))
#define AB_SBAR() __builtin_amdgcn_sched_barrier(0)
DI int crow(int r, int hi) { return (r & 3) + 8 * (r >> 2) + 4 * hi; }
DI unsigned cvtpk(float lo, float hi) { unsigned r; asm volatile("v_cvt_pk_bf16_f32 %0, %1, %2" : "=v"(r) : "v"(lo), "v"(hi)); return r; }
DI void partialSM(f32x16& p0, f32x16& p1, float& m_reg, float& mn, float& alpha, unsigned wlo, unsigned whi) {
#pragma unroll
    for (int r = 0; r < 16; ++r) { const int o = (r & 3) + 8 * (r >> 2); p0[r] = ((wlo >> o) & 1u) ? p0[r] : -__builtin_inff(); p1[r] = ((whi >> o) & 1u) ? p1[r] : -__builtin_inff(); }
    float pmax = p0[0];
#pragma unroll
    for (int r = 1; r < 16; ++r) pmax = fmaxf(pmax, p0[r]);
#pragma unroll
    for (int r = 0; r < 16; ++r) pmax = fmaxf(pmax, p1[r]);
    { auto rr = __builtin_amdgcn_permlane32_swap(__float_as_uint(pmax), __float_as_uint(pmax), false, false);
      pmax = fmaxf(__uint_as_float(rr[0]), __uint_as_float(rr[1])); }
    if (__builtin_expect(__all(pmax - m_reg <= THRL), 1)) { mn = m_reg; alpha = 1.f; }
    else { mn = fmaxf(m_reg, pmax); alpha = __builtin_amdgcn_exp2f(m_reg - mn); m_reg = mn; }
#pragma unroll
    for (int r = 0; r < 16; ++r) { p0[r] = p0[r] - mn; p1[r] = p1[r] - mn; }
#pragma unroll
    for (int r = 0; r < 16; ++r) p0[r] = __builtin_amdgcn_exp2f(p0[r]);
}
DI void finishSM(f32x16& p0, f32x16& p1, float alpha, float& l_reg, bf16x8& pa0, bf16x8& pa1, bf16x8& pa2, bf16x8& pa3) {
#pragma unroll
    for (int r = 0; r < 16; ++r) p1[r] = __builtin_amdgcn_exp2f(p1[r]);
    float ps = 0;
#pragma unroll
    for (int r = 0; r < 16; ++r) ps += p0[r];
#pragma unroll
    for (int r = 0; r < 16; ++r) ps += p1[r];
    { auto rr = __builtin_amdgcn_permlane32_swap(__float_as_uint(ps), __float_as_uint(ps), false, false);
      ps = __uint_as_float(rr[0]) + __uint_as_float(rr[1]); }
    l_reg = l_reg * alpha + ps;
#define AB_PK4(P, BASE, OUT) do { unsigned a0 = cvtpk(P[BASE + 0], P[BASE + 1]), a1 = cvtpk(P[BASE + 2], P[BASE + 3]);   \
    unsigned b0 = cvtpk(P[BASE + 4], P[BASE + 5]), b1 = cvtpk(P[BASE + 6], P[BASE + 7]);                              \
    auto r0 = __builtin_amdgcn_permlane32_swap(a0, b0, false, false); auto r1 = __builtin_amdgcn_permlane32_swap(a1, b1, false, false); \
    u32x4 w = {r0[0], r1[0], r0[1], r1[1]}; OUT = __builtin_bit_cast(bf16x8, w); } while (0)
    AB_PK4(p0, 0, pa0); AB_PK4(p0, 8, pa1); AB_PK4(p1, 0, pa2); AB_PK4(p1, 8, pa3);
#undef AB_PK4
}
DI void qkt(f32x16& p0, f32x16& p1, const LAS unsigned char* Ks, const bf16x8* qr, int r32, int hi) {
#pragma unroll
    for (int e = 0; e < 16; ++e) { p0[e] = 0.f; p1[e] = 0.f; }
#pragma unroll
    for (int d0 = 0; d0 < 8; ++d0) { const int cb = (d0 * 16 + hi * 8) * 2;
        const bf16x8 b0 = *(const LAS bf16x8*)(Ks + AB_KSWZ(r32, cb));
        const bf16x8 b1 = *(const LAS bf16x8*)(Ks + AB_KSWZ(32 + r32, cb));
        p0 = __builtin_amdgcn_mfma_f32_32x32x16_bf16(b0, qr[d0], p0, 0, 0, 0);
        p1 = __builtin_amdgcn_mfma_f32_32x32x16_bf16(b1, qr[d0], p1, 0, 0, 0); }
}
DI int v_st(int k, int c) { const int kk = (k & ~0xC) | ((k & 4) << 1) | ((k & 8) >> 1); return ((kk >> 3) * 4 + (c >> 5)) * 512 + ((kk & 7) * 32 + (c & 31)) * 2; }
DI int v_rd_base(int lane) { return ((lane & 3) << 3) | (((lane >> 2) & 3) << 6) | (((lane >> 4) & 1) << 5) | (((lane >> 5) & 1) << 8); }
constexpr int v_rd_off(int d0, int ks, int half) { return d0 * 512 + ks * 4096 + half * 2048; }
template <int OFF> DI s16x4 tr_read(int vb) { s16x4 r; asm volatile("ds_read_b64_tr_b16 %0, %1 offset:%2" : "=&v"(r) : "v"(vb), "i"(OFF) : "memory"); return r; }
template <int D0> DI void pv_one(f32x16& od, int vb, bf16x8 pa0, bf16x8 pa1, bf16x8 pa2, bf16x8 pa3) {
    const s16x4 l0 = tr_read<v_rd_off(D0, 0, 0)>(vb), h0 = tr_read<v_rd_off(D0, 0, 1)>(vb), l1 = tr_read<v_rd_off(D0, 1, 0)>(vb), h1 = tr_read<v_rd_off(D0, 1, 1)>(vb);
    const s16x4 l2 = tr_read<v_rd_off(D0, 2, 0)>(vb), h2 = tr_read<v_rd_off(D0, 2, 1)>(vb), l3 = tr_read<v_rd_off(D0, 3, 0)>(vb), h3 = tr_read<v_rd_off(D0, 3, 1)>(vb);
    asm volatile("s_waitcnt lgkmcnt(0)" ::: "memory"); AB_SBAR();
#define AB_PK(L, H) (bf16x8){L[0], L[1], L[2], L[3], H[0], H[1], H[2], H[3]}
    od = __builtin_amdgcn_mfma_f32_32x32x16_bf16(pa0, AB_PK(l0, h0), od, 0, 0, 0);
    od = __builtin_amdgcn_mfma_f32_32x32x16_bf16(pa1, AB_PK(l1, h1), od, 0, 0, 0);
    od = __builtin_amdgcn_mfma_f32_32x32x16_bf16(pa2, AB_PK(l2, h2), od, 0, 0, 0);
    od = __builtin_amdgcn_mfma_f32_32x32x16_bf16(pa3, AB_PK(l3, h3), od, 0, 0, 0);
#undef AB_PK
}
DI void pv_d0(f32x16* o, int vb, bf16x8 pa0, bf16x8 pa1, bf16x8 pa2, bf16x8 pa3) {
    pv_one<0>(o[0], vb, pa0, pa1, pa2, pa3); pv_one<1>(o[1], vb, pa0, pa1, pa2, pa3); pv_one<2>(o[2], vb, pa0, pa1, pa2, pa3); pv_one<3>(o[3], vb, pa0, pa1, pa2, pa3);
}
DI void body(const unsigned short* Qb, const unsigned short* Kh, h16* Ob, const h16* Wv, const unsigned long long* Mb, const int NT, LAS unsigned char* lds, const int wid, const int lane) {
    const int tid = wid * 64 + lane, r32 = lane & 31, hi = lane >> 5;
    LAS unsigned char* V_lds = lds; LAS unsigned char* K_lds = lds + 2 * SHM_V;
    LAS float* wsf = (LAS float*)(lds + LDS_RED) + wid * 64; LAS float* li_l = wsf; LAS float* al_l = wsf + 32;
    LAS unsigned long long* mkl = (LAS unsigned long long*)(lds + LDS_MK) + wid * 1024;
    float m_reg = -1e30f, l_reg = 0;
    f32x16 o[4];
#pragma unroll
    for (int d = 0; d < 4; ++d)
#pragma unroll
        for (int e = 0; e < 16; ++e) o[d][e] = 0.f;
    bf16x8 qr[8];
    const unsigned short* Qw = Qb + (size_t)(wid * 32 + r32) * NQ + hi * 8;
#pragma unroll
    for (int d0 = 0; d0 < 8; ++d0) qr[d0] = *(const bf16x8*)(Qw + d0 * 16);
    {
        const unsigned long long* mrow = Mb + (size_t)(wid * 32 + r32) * 32 + 2 * hi;
        for (int i = 0; i < (NT >> 2); ++i) { const u32x4 w = *(const u32x4*)(mrow + 4 * i);
            mkl[(4 * i + 2 * hi) * 32 + r32] = ((unsigned long long)w.y << 32) | w.x; mkl[(4 * i + 2 * hi + 1) * 32 + r32] = ((unsigned long long)w.w << 32) | w.z; }
    }
    const int sr = tid >> 4, sc = (tid & 15) * 8, vst0 = v_st(sr, sc), vst1 = v_st(32 + sr, sc);
    const int vb0 = (int)(unsigned)(uintptr_t)V_lds + v_rd_base(lane);
    bf16x8 st0[2], st1[2];
#define AB_SLOAD(i, k0) do { st0[i] = *(const bf16x8*)(Kh + (size_t)((k0) + sr) * 128 + sc); st1[i] = *(const bf16x8*)(Kh + (size_t)((k0) + 32 + sr) * 128 + sc); } while (0)
#define AB_SWRITE(b, i) do { *(LAS bf16x8*)(V_lds + (b) * SHM_V + vst0) = st0[i]; *(LAS bf16x8*)(V_lds + (b) * SHM_V + vst1) = st1[i]; const int kc = sc * 2; \
    *(LAS bf16x8*)(K_lds + (b) * SHM_K + AB_KSWZ(sr, kc)) = st0[i]; *(LAS bf16x8*)(K_lds + (b) * SHM_K + AB_KSWZ(32 + sr, kc)) = st1[i]; } while (0)
#define AB_SWAIT() asm volatile("s_waitcnt vmcnt(2)" ::: "memory")
#define AB_RESC(a) do { if (__any((a) < 1.f)) { if (hi == 0) al_l[r32] = (a); asm volatile("s_waitcnt lgkmcnt(0)" ::: "memory"); \
    _Pragma("unroll") for (int d = 0; d < 4; ++d) _Pragma("unroll") for (int r = 0; r < 16; ++r) o[d][r] *= al_l[crow(r, hi)]; } } while (0)
#define AB_MASK(j, WLO, WHI) const unsigned long long mw_##WLO = mkl[(j) * 32 + r32]; const unsigned WLO = (unsigned)mw_##WLO >> (4 * hi), WHI = (unsigned)(mw_##WLO >> 32) >> (4 * hi)
    f32x16 pA0, pA1, pB0, pB1; float mnA, mnB, alA, alB; bf16x8 pa0, pa1, pa2, pa3;
    AB_SLOAD(0, 0); asm volatile("s_waitcnt vmcnt(0)" ::: "memory"); AB_SWRITE(0, 0); __syncthreads();
    qkt(pA0, pA1, K_lds, qr, r32, hi); { AB_MASK(0, wl, wh); partialSM(pA0, pA1, m_reg, mnA, alA, wl, wh); }
    AB_SLOAD(1, 64); if (2 < NT) AB_SLOAD(0, 128);
    AB_SWAIT(); AB_SWRITE(1, 1); __syncthreads();
    for (int j = 1; j + 1 < NT; j += 2) {
        AB_SBAR(); qkt(pB0, pB1, K_lds + SHM_K, qr, r32, hi);
        finishSM(pA0, pA1, alA, l_reg, pa0, pa1, pa2, pa3); AB_SBAR();
        AB_SLOAD(1, (j + 2) * 64); AB_SBAR();
        pv_d0(o, vb0, pa0, pa1, pa2, pa3); { AB_MASK(j, wl, wh); partialSM(pB0, pB1, m_reg, mnB, alB, wl, wh); }
        __syncthreads(); AB_SWAIT(); AB_SWRITE(0, 0);
        AB_RESC(alB); __syncthreads();
        AB_SBAR(); qkt(pA0, pA1, K_lds, qr, r32, hi);
        finishSM(pB0, pB1, alB, l_reg, pa0, pa1, pa2, pa3); AB_SBAR();
        if (j + 3 < NT) AB_SLOAD(0, (j + 3) * 64); AB_SBAR();
        pv_d0(o, vb0 + SHM_V, pa0, pa1, pa2, pa3); { AB_MASK(j + 1, wl, wh); partialSM(pA0, pA1, m_reg, mnA, alA, wl, wh); }
        __syncthreads(); AB_SWAIT(); AB_SWRITE(1, 1);
        AB_RESC(alA); __syncthreads();
    }
    AB_SBAR(); qkt(pB0, pB1, K_lds + SHM_K, qr, r32, hi);
    finishSM(pA0, pA1, alA, l_reg, pa0, pa1, pa2, pa3); AB_SBAR();
    pv_d0(o, vb0, pa0, pa1, pa2, pa3); { AB_MASK(NT - 1, wl, wh); partialSM(pB0, pB1, m_reg, mnB, alB, wl, wh); }
    __syncthreads(); AB_RESC(alB);
    finishSM(pB0, pB1, alB, l_reg, pa0, pa1, pa2, pa3); AB_SBAR();
    pv_d0(o, vb0 + SHM_V, pa0, pa1, pa2, pa3);
    if (hi == 0) li_l[r32] = l_reg;
    asm volatile("s_waitcnt lgkmcnt(0)" ::: "memory");
    __syncthreads();
    LAS unsigned char* ob = lds + wid * 8192;
    const int le_ = lane_id(), r32e = le_ & 31, hie = le_ >> 5;
#pragma unroll
    for (int r = 0; r < 16; ++r) { const int orow = crow(r, hie); const float rli = __builtin_amdgcn_rcpf(li_l[orow]);
#pragma unroll
        for (int d0 = 0; d0 < 4; ++d0) { const int col = d0 * 32 + r32e; *(LAS h16*)(ob + orow * 256 + ((((col >> 3) ^ (orow & 15)) << 4) | ((col & 7) * 2))) = (h16)(o[d0][r] * rli); } }
    asm volatile("s_waitcnt lgkmcnt(0)" ::: "memory");
    f32x16 yv[2];
#pragma unroll
    for (int e = 0; e < 16; ++e) { yv[0][e] = 0.f; yv[1][e] = 0.f; }
#pragma unroll
    for (int s8 = 0; s8 < 8; ++s8) { const h16x8 af = *(const LAS h16x8*)(ob + r32e * 256 + (((2 * s8 + hie) ^ (r32e & 15)) << 4));
#pragma unroll
        for (int nt = 0; nt < 2; ++nt) { const h16x8 bf = *(const h16x8*)(Wv + (size_t)(32 * nt + r32e) * 128 + 16 * s8 + 8 * hie);
            yv[nt] = __builtin_amdgcn_mfma_f32_32x32x16_f16(af, bf, yv[nt], 0, 0, 0); } }
#pragma unroll
    for (int nt = 0; nt < 2; ++nt)
#pragma unroll
        for (int r = 0; r < 16; ++r) Ob[(size_t)(wid * 32 + crow(r, hie)) * KOUT + 32 * nt + r32e] = (h16)yv[nt][r];
#undef AB_SLOAD
#undef AB_SWRITE
#undef AB_SWAIT
#undef AB_RESC
#undef AB_MASK
}
}

DI void phase_attn(const Params& p, const Ctx& c, unsigned* qctr, const int l) {
    unsigned char* const ws = kws();
    const unsigned short* QALL = (const unsigned short*)kout(); const unsigned short* CKV = (const unsigned short*)(ws + WS_CKV);
    const unsigned long long* MASKG = (const unsigned long long*)(ws + WS_MASK); h16* AOUT = (h16*)(ws + WS_AOUT);
    const int wave = c.wave;
    volatile LAS unsigned* qw = (volatile LAS unsigned*)(c.lds + LDS_MISC + 64);
    for (;;) {
        const int lane = lane_id();
        if (wave == 0 && lane == 0) *qw = __hip_atomic_fetch_add(qctr, 1u, __ATOMIC_RELAXED, __HIP_MEMORY_SCOPE_AGENT);
        __syncthreads();
        const int unit = (int)*qw;
        __syncthreads();
        if (unit >= NB * 8 * 8) break;
        const int qb = 7 - (unit >> 7), b = (unit >> 3) & 15, h = unit & 7;
        const size_t row0 = (size_t)b * SEQ + 256 * qb;
        ab::body(QALL + row0 * NQ + h * 128, CKV + (size_t)b * SEQ * 128, AOUT + row0 * KOUT + h * 64, (const h16*)(ws + wofs(l) + WT_VUP) + h * 64 * 128, MASKG + row0 * 32, 4 * (qb + 1), c.lds, wave, lane);
        __syncthreads();
    }
}

DI int sw128(int row, int boff) { return row * 128 + ((((boff >> 4) ^ ((row >> 1) & 7)) << 4) | (boff & 15)); }
DI int sw64(int row, int boff)  { return row * 64 + ((((boff >> 4) ^ ((row >> 2) & 3)) << 4) | (boff & 15)); }
DI int sw32(int row, int boff)  { return row * 32 + ((((boff >> 4) ^ ((row >> 3) & 1)) << 4) | (boff & 15)); }
constexpr int SL_A1 = 0, SL_A4 = 4096, SL_WY = 8192, SL_VT = 12288, SL_A23 = 14336, SL_A5 = 15360, SL_P16 = 16384, SLOT = 16640;
DI float rl(float x, int l) { return __builtin_bit_cast(float, __builtin_amdgcn_readlane(__builtin_bit_cast(int, x), l)); }
template <int CTRL, int RM> DI float dppf_rm(float x) { return __builtin_bit_cast(float, __builtin_amdgcn_update_dpp(0, __builtin_bit_cast(int, x), CTRL, RM, 0xf, false)); }
DI float sum64u(float x) { x = sum16(x);
    asm("s_nop 1\n\tv_add_f32_dpp %0, %0, %0 row_bcast:15 row_mask:0xa bank_mask:0xf\n\ts_nop 1\n\tv_add_f32_dpp %0, %0, %0 row_bcast:31 row_mask:0xc bank_mask:0xf\n\ts_nop 0" : "+v"(x));
    return rl(x, 63); }
DI void sum64u2(float x, float y, float& rx, float& ry) {
#define S2_STEP(ctl) "v_add_f32_dpp %0, %0, %0 " ctl "\n\tv_add_f32_dpp %1, %1, %1 " ctl "\n\ts_nop 0\n\t"
    asm("s_nop 1\n\t"
        S2_STEP("quad_perm:[1,0,3,2] row_mask:0xf bank_mask:0xf bound_ctrl:1")
        S2_STEP("quad_perm:[2,3,0,1] row_mask:0xf bank_mask:0xf bound_ctrl:1")
        S2_STEP("row_half_mirror row_mask:0xf bank_mask:0xf bound_ctrl:1")
        S2_STEP("row_mirror row_mask:0xf bank_mask:0xf bound_ctrl:1")
        S2_STEP("row_bcast:15 row_mask:0xa bank_mask:0xf")
        S2_STEP("row_bcast:31 row_mask:0xc bank_mask:0xf")
        : "+v"(x), "+v"(y));
#undef S2_STEP
    rx = rl(x, 63); ry = rl(y, 63);
}
DI u32x4 pk8(float a, float b, float c, float d, float e, float f, float g, float h) { u32x4 w; w.x = pkh(a, b); w.y = pkh(c, d); w.z = pkh(e, f); w.w = pkh(g, h); return w; }

DI void phase_scan2(const Params& p, const Ctx& c, int l) {
    unsigned char* const ws = kws();
    const h16* RKV = (const h16*)(ws + WS_RKV); const h16* LO = (const h16*)(ws + WS_LORAO); h16* V1 = (h16*)(ws + WS_V1ST); h16* AOUT = (h16*)(ws + WS_AOUT);
    const int wave = c.wave;
    LAS unsigned char* const slot = c.lds + wave * SLOT;
    for (int u = blockIdx.x; u < NB * 8; u += c.G) {
        const int b = u >> 3, h = u & 7; const int col0 = h * 64 + lane_id();
        const float mur = kin<I_MU>()[l * 1824 + col0], muk = kin<I_MU>()[l * 1824 + 512 + col0], muv = kin<I_MU>()[l * 1824 + 1024 + col0];
        const float kkw = kin<I_KK>()[l * 512 + col0], kaw = kin<I_KA>()[l * 512 + col0], rkw = kin<I_RK>()[l * 512 + col0];
        const float lng = kin<I_LNXG>()[l * 512 + col0], lnb = kin<I_LNXB>()[l * 512 + col0];
        f32x16 Sg[2]; h16x8 sfrag[4];
#pragma unroll
        for (int i = 0; i < 16; ++i) { Sg[0][i] = 0.f; Sg[1][i] = 0.f; }
#pragma unroll
        for (int i = 0; i < 4; ++i) sfrag[i] = (h16x8){0, 0, 0, 0, 0, 0, 0, 0};
#pragma unroll 1
        for (int ss = 0; ss < SEQ / 128; ++ss) {
            const int lane = lane_id(), n = lane & 31, hh = lane >> 5, col = h * 64 + lane;
            const int t0 = 128 * ss + 16 * wave; const size_t m0 = (size_t)b * SEQ + t0;
            unsigned g12[16];
            {
                float Pin[16], vv[16];
                h16 wd[16], xr[2][8], xk[2][8], xv[2][8], xa[2][8], xg[2][8], xs[2][8], xf[2][8];
#define SC_LOAD_HALF(hb) { _Pragma("unroll") for (int tt = 0; tt < 8; ++tt) { const size_t m = m0 + 8 * (hb) + tt; const h16* q = RKV + m * NRKV + col; const h16* lp = LO + m * NLORA + col; \
                        xr[hb][tt] = q[0]; xk[hb][tt] = q[512]; xv[hb][tt] = q[1024]; xa[hb][tt] = lp[512]; xg[hb][tt] = lp[1024]; \
                        if (l != 0) { xs[hb][tt] = lp[1536]; xf[hb][tt] = V1[m * 512 + col]; } else { xs[hb][tt] = (h16)0.f; xf[hb][tt] = (h16)0.f; } } }
#pragma unroll
                for (int t = 0; t < 16; ++t) wd[t] = LO[(m0 + t) * NLORA + col];
                const h16* qprev = RKV + (m0 - (t0 > 0 ? 1 : 0)) * NRKV + col; const float zprev = (t0 > 0) ? 1.0f : 0.0f;
                const h16 pr_h = qprev[0], pk_h = qprev[512], pv_h = qprev[1024];
                SC_LOAD_HALF(0)
                asm volatile("" ::: "memory");
#pragma unroll
                for (int t = 0; t < 16; ++t) { const float wt = 1.0f - (float)wd[t]; Pin[t] = (t == 0) ? wt : Pin[t - 1] * wt; }
                const float P8 = Pin[7], iP8 = __builtin_amdgcn_rcpf(P8), P16 = Pin[15];
                const int q15 = lane & 15, pos = 16 * (lane >> 4) + 8 * ((q15 >> 2) & 1) + 4 * (q15 >> 3) + (q15 & 3);
                int xbL[8], xbP[8], xa4[4];
#pragma unroll
                for (int e = 0; e < 8; ++e) { xbL[e] = ((((2 * lane) >> 4) ^ e) << 4) | ((2 * lane) & 15); xbP[e] = ((((2 * pos) >> 4) ^ e) << 4) | ((2 * pos) & 15); }
#pragma unroll
                for (int e = 0; e < 4; ++e) xa4[e] = lane * 64 + ((e ^ ((lane >> 2) & 3)) << 4);
                {
                    float pr = (float)pr_h * zprev, pk = (float)pk_h * zprev, pv = (float)pv_h * zprev;
#pragma unroll
                    for (int hb = 0; hb < 2; ++hb) {
                    if (hb == 0) { SC_LOAD_HALF(1) asm volatile("" ::: "memory"); }
#pragma unroll
                    for (int tt = 0; tt < 8; ++tt) {
                        const int t = 8 * hb + tt; const size_t m = m0 + t;
                        const float r0 = (float)xr[hb][tt], k0 = (float)xk[hb][tt], v0 = (float)xv[hb][tt];
                        const float aa = (float)xa[hb][tt], gg = (float)xg[hb][tt], sg = (float)xs[hb][tt];
                        const float r = r0 + (pr - r0) * mur, k = k0 + (pk - k0) * muk; float v = v0 + (pv - v0) * muv;
                        pr = r0; pk = k0; pv = v0;
                        if (l == 0) V1[m * 512 + col] = (h16)v; else { const float vf = (float)xf[hb][tt]; v = v + (vf - v) * sg; }
                        const float kkr = k * kkw, kpv = k * (1.0f + (aa - 1.0f) * kaw);
                        float ssq, bon; sum64u2(kkr * kkr, r * kpv * rkw, ssq, bon);
                        const float kn = kkr * __builtin_amdgcn_rcpf(fmaxf(__builtin_amdgcn_sqrtf(ssq), 1e-12f)), bt = kn * aa;
                        vv[t] = v; g12[t] = pkh(lng * gg, (lnb + bon * v) * gg);
                        const float iPt = __builtin_amdgcn_rcpf(Pin[t]);
                        const float gin = Pin[t] * iP8, pex = (t == 0) ? 1.0f : Pin[t - 1], gex = pex * iP8, ig = P8 * iPt, sfx = P16 * iPt;
                        *(LAS h16*)(slot + SL_WY + t * 128 + xbL[(t >> 1) & 7]) = (h16)(bt * ig);
                        *(LAS h16*)(slot + SL_WY + (16 + t) * 128 + xbL[(t >> 1) & 7]) = (h16)(kpv * ig);
                        *(LAS h16*)(slot + SL_WY + 4096 + t * 128 + xbL[(t >> 1) & 7]) = (h16)(kn * gex);
                        *(LAS h16*)(slot + SL_WY + 4096 + (16 + t) * 128 + xbL[(t >> 1) & 7]) = (h16)(r * gin);
                        *(LAS h16*)(slot + SL_A1 + t * 128 + xbP[(t >> 1) & 7]) = (h16)(kn * pex);
                        *(LAS h16*)(slot + SL_A1 + (16 + t) * 128 + xbP[(t >> 1) & 7]) = (h16)(r * Pin[t]);
                        const int ps = 8 * ((t >> 2) & 1) + 4 * (t >> 3) + (t & 3);
                        *(LAS h16*)(slot + SL_A4 + xa4[(2 * ps) >> 4] + ((2 * ps) & 15)) = (h16)(bt * sfx);
                        *(LAS h16*)(slot + SL_A4 + xa4[2 + ((2 * ps) >> 4)] + ((2 * ps) & 15)) = (h16)(kpv * sfx);
                    }
                    }
                }
                *(LAS float*)(slot + SL_P16 + 4 * lane) = P16;
                asm volatile("s_waitcnt lgkmcnt(0)" ::: "memory");
                f32x16 G;
#pragma unroll
                for (int i = 0; i < 16; ++i) G[i] = 0.f;
#pragma unroll
                for (int ks = 0; ks < 4; ++ks) { const h16x8 af = *(const LAS h16x8*)(slot + SL_WY + sw128(n, (16 * ks + 8 * hh) * 2)), bf = *(const LAS h16x8*)(slot + SL_WY + 4096 + sw128(n, (16 * ks + 8 * hh) * 2));
                    G = __builtin_amdgcn_mfma_f32_32x32x16_f16(af, bf, G, 0, 0, 0); }
                {
                    const int t = n & 15; const bool isR = n >= 16;
                    float top[8], bot[8];
#pragma unroll
                    for (int i = 0; i < 8; ++i) { const int ip = (i & 3) + 8 * (i >> 2) + 4 * hh; const bool keep = isR ? (ip <= t) : (ip < t);
                        top[i] = keep ? G[i] : 0.f; bot[i] = keep ? (isR ? G[8 + i] : -G[8 + i]) : 0.f; }
                    asm volatile("s_waitcnt lgkmcnt(0)" ::: "memory");
                    if (isR) *(LAS u32x4*)(slot + SL_A23 + sw32(n, 16 * hh)) = pk8(top[0], top[1], top[2], top[3], top[4], top[5], top[6], top[7]);
                    *(LAS u32x4*)(slot + SL_A5 + sw32(n, 16 * hh)) = pk8(bot[0], bot[1], bot[2], bot[3], bot[4], bot[5], bot[6], bot[7]);
                    {
                        const int r16 = lane & 15; float Tr[16];
#pragma unroll
                        for (int j = 0; j < 16; ++j) { float acc = (j == r16) ? 1.0f : 0.0f;
#pragma unroll
                            for (int i = 0; i < j; ++i) acc -= rl(top[(i & 3) + 4 * (i >> 3)], j + 32 * ((i >> 2) & 1)) * Tr[i];
                            Tr[j] = acc; }
                        const int ps2 = 2 * (8 * ((r16 >> 2) & 1) + 4 * (r16 >> 3) + (r16 & 3));
                        if (lane < 16) {
#pragma unroll
                            for (int t2 = 0; t2 < 16; ++t2) *(LAS h16*)(slot + SL_A23 + sw32(t2, ps2)) = (h16)Tr[t2];
                        }
                    }
                }
                *(LAS u32x4*)(slot + SL_VT + sw32(lane, 0)) = pk8(vv[0], vv[1], vv[2], vv[3], vv[8], vv[9], vv[10], vv[11]);
                *(LAS u32x4*)(slot + SL_VT + sw32(lane, 16)) = pk8(vv[4], vv[5], vv[6], vv[7], vv[12], vv[13], vv[14], vv[15]);
                asm volatile("s_waitcnt lgkmcnt(0)" ::: "memory");
                {
                    const h16x8 a5 = *(const LAS h16x8*)(slot + SL_A5 + sw32(n, 16 * hh));
#pragma unroll
                    for (int vt = 0; vt < 2; ++vt) { const h16x8 vf = *(const LAS h16x8*)(slot + SL_VT + sw32(32 * vt + n, 16 * hh));
                        f32x16 Wm;
#pragma unroll
                        for (int i = 0; i < 16; ++i) Wm[i] = 0.f;
                        Wm = __builtin_amdgcn_mfma_f32_32x32x16_f16(a5, vf, Wm, 0, 0, 0);
                        *(LAS u32x4*)(slot + SL_WY + vt * 2048 + sw32(lane, 0)) = pk8(Wm[0], Wm[1], Wm[2], Wm[3], Wm[4], Wm[5], Wm[6], Wm[7]);
                        *(LAS u32x4*)(slot + SL_WY + vt * 2048 + sw32(lane, 16)) = pk8(Wm[8], Wm[9], Wm[10], Wm[11], Wm[12], Wm[13], Wm[14], Wm[15]); }
                }
            }
            __syncthreads();
            if (wave < 2) {
                const int vt = wave;
#pragma unroll 1
                for (int j = 0; j < 8; ++j) {
                    const LAS unsigned char* sb = c.lds + j * SLOT;
                    h16x8 a1[4], a4[2][2];
#pragma unroll
                    for (int ks = 0; ks < 4; ++ks) a1[ks] = *(const LAS h16x8*)(sb + SL_A1 + sw128(n, (16 * ks + 8 * hh) * 2));
                    const u32x4 wy0 = *(const LAS u32x4*)(sb + SL_WY + vt * 2048 + sw32(lane, 0)), wy1 = *(const LAS u32x4*)(sb + SL_WY + vt * 2048 + sw32(lane, 16));
                    const h16x8 a23 = *(const LAS h16x8*)(sb + SL_A23 + sw32(n, 16 * hh));
#pragma unroll
                    for (int kt = 0; kt < 2; ++kt)
#pragma unroll
                        for (int s2 = 0; s2 < 2; ++s2) a4[kt][s2] = *(const LAS h16x8*)(sb + SL_A4 + sw64(32 * kt + n, 32 * s2 + 16 * hh));
                    const h16x8 vf = *(const LAS h16x8*)(sb + SL_VT + sw32(32 * vt + n, 16 * hh));
                    f32x16 D1;
#pragma unroll
                    for (int i = 0; i < 16; ++i) D1[i] = 0.f;
#pragma unroll
                    for (int ks = 0; ks < 4; ++ks) D1 = __builtin_amdgcn_mfma_f32_32x32x16_f16(a1[ks], sfrag[ks], D1, 0, 0, 0);
                    const float w0v[8] = {hlo(wy0.x), hhi(wy0.x), hlo(wy0.y), hhi(wy0.y), hlo(wy0.z), hhi(wy0.z), hlo(wy0.w), hhi(wy0.w)};
                    const float y0v[8] = {hlo(wy1.x), hhi(wy1.x), hlo(wy1.y), hhi(wy1.y), hlo(wy1.z), hhi(wy1.z), hlo(wy1.w), hhi(wy1.w)};
                    const u32x4 ubw = pk8(w0v[0] - D1[0], w0v[1] - D1[1], w0v[2] - D1[2], w0v[3] - D1[3], w0v[4] - D1[4], w0v[5] - D1[5], w0v[6] - D1[6], w0v[7] - D1[7]);
                    f32x16 D2;
#pragma unroll
                    for (int i = 0; i < 16; ++i) D2[i] = 0.f;
                    D2 = __builtin_amdgcn_mfma_f32_32x32x16_f16(a23, __builtin_bit_cast(h16x8, ubw), D2, 0, 0, 0);
                    const h16x8 uf = __builtin_bit_cast(h16x8, pk8(D2[0], D2[1], D2[2], D2[3], D2[4], D2[5], D2[6], D2[7]));
                    D1 = __builtin_amdgcn_mfma_f32_32x32x16_f16(a23, uf, D1, 0, 0, 0);
#pragma unroll
                    for (int kt = 0; kt < 2; ++kt) {
                        f32x4 p16[4];
#pragma unroll
                        for (int g = 0; g < 4; ++g) p16[g] = *(const LAS f32x4*)(sb + SL_P16 + (32 * kt + 8 * g + 4 * hh) * 4);
#pragma unroll
                        for (int i = 0; i < 16; ++i) Sg[kt][i] *= p16[i >> 2][i & 3];
                        Sg[kt] = __builtin_amdgcn_mfma_f32_32x32x16_f16(a4[kt][0], uf, Sg[kt], 0, 0, 0);
                        Sg[kt] = __builtin_amdgcn_mfma_f32_32x32x16_f16(a4[kt][1], vf, Sg[kt], 0, 0, 0);
                    }
                    LAS float* yo = (LAS float*)(c.lds + j * SLOT + SL_WY + vt * 2048);
#pragma unroll
                    for (int i = 0; i < 8; ++i) { const int t = (i & 3) + 8 * (i >> 2) + 4 * hh; yo[t * 32 + n] = D1[8 + i] + y0v[i]; }
#pragma unroll
                    for (int kt = 0; kt < 2; ++kt)
#pragma unroll
                        for (int s = 0; s < 2; ++s) sfrag[2 * kt + s] = __builtin_bit_cast(h16x8, pk8(Sg[kt][8 * s], Sg[kt][8 * s + 1], Sg[kt][8 * s + 2], Sg[kt][8 * s + 3], Sg[kt][8 * s + 4], Sg[kt][8 * s + 5], Sg[kt][8 * s + 6], Sg[kt][8 * s + 7]));
                }
            }
            __syncthreads();
            {
                const LAS float* yi = (const LAS float*)(slot + SL_WY + hh * 2048);
                float yv[16];
#pragma unroll
                for (int t = 0; t < 16; ++t) yv[t] = yi[t * 32 + n];
#pragma unroll
                for (int t = 0; t < 16; t += 2) {
                    float s0, s1; sum64u2(yv[t], yv[t + 1], s0, s1);
                    const float dv0 = yv[t] - s0 * (1.0f / 64.0f), dv1 = yv[t + 1] - s1 * (1.0f / 64.0f);
                    float q0, q1; sum64u2(dv0 * dv0, dv1 * dv1, q0, q1);
                    const float o0 = dv0 * rsqrtf(q0 * (1.0f / 64.0f) + LNX_EPS) * hlo(g12[t]) + hhi(g12[t]);
                    const float o1 = dv1 * rsqrtf(q1 * (1.0f / 64.0f) + LNX_EPS) * hlo(g12[t + 1]) + hhi(g12[t + 1]);
                    AOUT[(m0 + t) * KOUT + 512 + col] = (h16)o0; AOUT[(m0 + t + 1) * KOUT + 512 + col] = (h16)o1;
                }
            }
            asm volatile("s_waitcnt lgkmcnt(0)" ::: "memory");
        }
        __syncthreads();
    }
}

constexpr int STEPS_PER_LAYER = 10, NSTEPS = 2 + NL * STEPS_PER_LAYER;
#define IN(k) (lo <= (k) && (k) < hi)
#define SEAM(k) do { if (IN(k) && IN((k) + 1)) xcd_barrier(bar, c.wave); } while (0)
template <int l>
DI void layer_steps(const Params& p, const Ctx& c, const XcdBarrier& bar, const int lo, const int hi) {
        const int s0 = 2 + l * STEPS_PER_LAYER;
        if (IN(s0 + 0)) { unsigned char* const ws = kws();
            {
              pg8::Gemm g{(const h16*)(ws + WS_H8IN), (const h16*)(ws + wofs(l) + WT_IN + (size_t)NIN16 * DM * 2), MT, NIN - NIN16, DM / 2, DM / 2, DM / 2}; pg8::StaticOrder S; S.init(MT, NIN - NIN16, c.G, (int)blockIdx.x);
              pg8::EpiH16I8 E{(h16*)(ws + WS_COLSA), NCA, 3, (h16*)(ws + WS_RKV), NRKV, (const float*)(ws + WS_RS), wmax_load(ws, l, 1) * (1.0f / 127.0f)};
              pg8::gemm_phase(c.lds, g, S, E, c.wave); }
            if (l + 1 < NL && c.G > NB * 8 && blockIdx.x >= NB * 8) { __syncthreads(); Ctx c2 = c; c2.gw = (blockIdx.x - NB * 8) * 8 + c.wave; c2.ngw = (c.G - NB * 8) * 8; phase_wmax(p, c2, l + 1); phase_wconv(p, c2, l + 1, 0, WC_P1, false); }
        }
        SEAM(s0 + 0);
        if (IN(s0 + 1)) phase_prep(p, c, l);
        SEAM(s0 + 1);
        if (IN(s0 + 2)) { unsigned char* const ws = kws();
            { pg8::Gemm g{(const h16*)(ws + WS_CQ), (const h16*)(ws + wofs(l) + WT_Q), MT, NQ, 256, 256, 256}; pg8::StaticOrder S; S.init(MT, NQ, c.G, (int)blockIdx.x);
              pg8::EpiQ E{(h16*)kout()};
              pg8::gemm_phase(c.lds, g, S, E, c.wave); }
            {
              pg8::Gemm g{(const h16*)(ws + WS_ALORA), (const h16*)(ws + wofs(l) + WT_LORA), MT, 1024, 128, KLORA, 128}; pg8::StaticOrder S; S.init(MT, 1024, c.G, (int)blockIdx.x);
              pg8::EpiLora E{(h16*)(ws + WS_LORAO), kin<I_W0>() + l * 512, kin<I_A0>() + l * 512, kin<I_V0>() + (l > 0 ? l - 1 : 0) * 512, l > 0 ? 1 : 0, 0};
              pg8::gemm_phase(c.lds, g, S, E, c.wave); }
            {
              constexpr int N2 = (l > 0) ? 1024 : 512;
              pg8::Gemm g{(const h16*)(ws + WS_ALORA) + 128, (const h16*)(ws + wofs(l) + WT_LORA) + 1024 * 128, MT, N2, 256, KLORA, 256}; pg8::StaticOrder S; S.init(MT, N2, c.G, (int)blockIdx.x);
              pg8::EpiLora E{(h16*)(ws + WS_LORAO), kin<I_W0>() + l * 512, kin<I_A0>() + l * 512, kin<I_V0>() + (l > 0 ? l - 1 : 0) * 512, l > 0 ? 1 : 0, 4};
              pg8::gemm_phase(c.lds, g, S, E, c.wave); }
        }
        SEAM(s0 + 2);
        if (IN(s0 + 3)) { unsigned char* const ws = kws(); if (blockIdx.x < NB * 8) { phase_scan2(p, c, l); __syncthreads(); }
            else if (l + 1 < NL) { Ctx c2 = c; c2.gw = (blockIdx.x - NB * 8) * 8 + c.wave; c2.ngw = (c.G - NB * 8) * 8; phase_wconv(p, c2, l + 1, WC_P1, WC_NIT, true); __syncthreads(); }
            phase_select(p, c, (unsigned*)(ws + WS_CTL) + 8192 + 64 * l); }
        SEAM(s0 + 3);
        if (IN(s0 + 4)) { unsigned char* const ws = kws(); phase_attn(p, c, (unsigned*)(ws + WS_CTL) + 8192 + 64 * l + 16, l); }
        SEAM(s0 + 4);
        if (IN(s0 + 5)) { unsigned char* const ws = kws();
            pg8::Gemm g{(const h16*)(ws + WS_AOUT), (const h16*)(ws + wofs(l) + WT_OUT), MT, DM, KOUT, KOUT, KOUT}; pg8::StaticOrder S; S.init(MT, DM, c.G, (int)blockIdx.x);
            pg8::EpiH16 E{(h16*)(ws + WS_Y), DM, 1000, nullptr, 0};
            pg8::gemm_phase(c.lds, g, S, E, c.wave);
        }
        SEAM(s0 + 5);
        if (IN(s0 + 6)) { phase_rows<1, true, false, 1>(p, c, (const h16*)(kws() + WS_Y), kin<I_POSTMIX>() + l * DM, 2048, l, kin<I_PREFFN>() + l * DM, 3072, 4096, l, -1);
                          if (l + 1 < NL && c.G <= NB * 8) phase_wmax(p, c, l + 1); }
        SEAM(s0 + 6);
        if (IN(s0 + 7)) { unsigned char* const ws = kws();
            pg8::Gemm g{(const h16*)(ws + WS_H), (const h16*)(ws + wofs(l) + WT_FC), MT, NFC, DM / 2, DM / 2, DM / 2}; pg8::StaticOrder S; S.init(MT, NFC, c.G, (int)blockIdx.x);
            pg8::EpiSwigluI8 E{(h16*)(ws + WS_HID), (const float*)(ws + WS_RS), wmax_load(ws, l, 0) * (1.0f / 127.0f)};
            pg8::gemm_phase(c.lds, g, S, E, c.wave);
        }
        SEAM(s0 + 7);
        if (IN(s0 + 8)) { unsigned char* const ws = kws();
            pg8::Gemm g{(const h16*)(ws + WS_HID), (const h16*)(ws + wofs(l) + WT_DOWN), MT, DM, DFF, DFF, DFF}; pg8::StaticOrder S; S.init(MT, DM, c.G, (int)blockIdx.x);
            pg8::EpiH16 E{(h16*)(ws + WS_Y2), DM, 1000, nullptr, 0};
            pg8::gemm_phase(c.lds, g, S, E, c.wave);
        }
        SEAM(s0 + 8);
        if (IN(s0 + 9)) { unsigned char* const ws = kws();
            if (l + 1 < NL) { phase_rows<1, true, true, 2>(p, c, (const h16*)(ws + WS_Y2), kin<I_POSTFFN>() + l * DM, 5120, l, kin<I_PREMIX>() + (l + 1) * DM, 0, 1024, l + 1, l + 1);
                              if (c.G <= NB * 8) { __syncthreads(); phase_wconv(p, c, l + 1, 0, WC_NIT, true); } }
            else phase_rows<1, false, false>(p, c, (const h16*)(ws + WS_Y2), kin<I_POSTFFN>() + l * DM, 5120, l, nullptr, 0, 0, 0, -1);
        }
        SEAM(s0 + 9);
    }
#undef IN
#undef SEAM

__global__ void __launch_bounds__(NTHR, 2) fwd_kernel(Params p) {
    extern __shared__ __attribute__((aligned(16))) unsigned char lds_raw[];
    Ctx c; c.lds = (LAS unsigned char*)lds_raw; c.wave = __builtin_amdgcn_readfirstlane((int)threadIdx.x >> 6);
    c.G = gridDim.x; c.gw = blockIdx.x * 8 + c.wave; c.ngw = c.G * 8;
    volatile LAS unsigned* misc = (volatile LAS unsigned*)(c.lds + LDS_MISC);
    if (c.wave == 0) misc[lane_id()] = 0u;
    __syncthreads();
    unsigned* ctl = (unsigned*)(kws() + WS_CTL);
    XcdBarrier bar; bar.bar = ctl; bar.x = 0; bar.st = nullptr;
    const bool multi = (p.step_hi - p.step_lo) > 1;
    if (multi) bar = xcd_barrier_post(ctl, misc + 8, c.wave);
    const int lo = p.step_lo, hi = p.step_hi;
#define IN(k) (lo <= (k) && (k) < hi)
#define SEAM(k) do { if (IN(k) && IN((k) + 1)) xcd_barrier(bar, c.wave); } while (0)

    if (IN(0)) { phase_mod(p, c); __syncthreads(); phase_wmax(p, c, 0); phase_wconv(p, c, 0, 0, WC_NOQ, true); }
    SEAM(0);
    if (IN(1)) { phase_rows<0, true, true, 2>(p, c, nullptr, nullptr, 0, 0, kin<I_PREMIX>(), 0, 1024, 0, 0); phase_wconv(p, c, 0, WC_NOQ, WC_NIT, false); }
    SEAM(1);
    layer_steps<0>(p, c, bar, lo, hi);
    layer_steps<1>(p, c, bar, lo, hi);
    layer_steps<2>(p, c, bar, lo, hi);
    layer_steps<3>(p, c, bar, lo, hi);
#undef IN
#undef SEAM
}

extern "C" void kernel_launch(void* const* d_in, const int* in_sizes, int n_in, void* d_out, int out_size, void* d_ws, size_t ws_size, hipStream_t stream) {
    static int grid = 0;
    if (grid == 0) {
        if (n_in != 35 || out_size != MT * DM || ws_size < WS_NEED) { fprintf(stderr, "kernel_launch: unexpected problem (n_in %d out %d ws %zu)\n", n_in, out_size, ws_size); grid = -1; return; }
        int dev = 0, cus = 0, per_cu = 0;
        if (hipGetDevice(&dev) != hipSuccess || hipDeviceGetAttribute(&cus, hipDeviceAttributeMultiprocessorCount, dev) != hipSuccess) { grid = -1; return; }
        if (hipFuncSetAttribute((const void*)fwd_kernel, hipFuncAttributeMaxDynamicSharedMemorySize, LDS_BYTES) != hipSuccess) { fprintf(stderr, "kernel_launch: hipFuncSetAttribute failed\n"); grid = -1; return; }
        if (hipOccupancyMaxActiveBlocksPerMultiprocessor(&per_cu, (const void*)fwd_kernel, NTHR, LDS_BYTES) != hipSuccess || per_cu < 1) { fprintf(stderr, "kernel_launch: occupancy query says %d\n", per_cu); (void)hipGetLastError(); per_cu = 1; }
        grid = cus;
        if (grid > 256) grid = 256;
    }
    if (grid < 0) return;
    (void)hipMemsetAsync((char*)d_ws + WS_CTL, 0, CTL_BYTES, stream);
    Params p{};
    for (int i = 0; i < 35; ++i) p.in[i] = (const float*)d_in[i];
    p.out = (float*)d_out; p.ws = (unsigned char*)d_ws;
#if MK_PER_STEP_LAUNCH
    for (int s = 0; s < NSTEPS; ++s) { p.step_lo = s; p.step_hi = s + 1; hipLaunchKernelGGL(fwd_kernel, dim3(grid), dim3(NTHR), LDS_BYTES, stream, p); }
#else
    p.step_lo = 0; p.step_hi = NSTEPS;
    hipLaunchKernelGGL(fwd_kernel, dim3(grid), dim3(NTHR), LDS_BYTES, stream, p);
#endif
}
```
